# Optimizing an MI355X kernel written in HIP

```python
import jax, jax.numpy as jnp
from jax import lax
import numpy as np

D_MODEL = 1024
BATCH = 2
SEQ = 8192
DEPTH = 4

GRID_W = 64
CTX_LEN = 256
HEAD_DIM = 64
N_Q_HEADS = 8
N_KV_HEADS = 2
GROUP = N_Q_HEADS // N_KV_HEADS
ATTN_WIDTH = N_Q_HEADS * HEAD_DIM
KV_WIDTH = N_KV_HEADS * HEAD_DIM
AXIS_DIM = HEAD_DIM // 2
ROPE_THETA = 10000.0
Q_BLOCK = 128
CONV_WIDTH = D_MODEL // 4
CONV_GROUPS = 4
CONV_K = 3
CHUNK = 128
SG_GROUPS = 4
SG_WIDTH = D_MODEL // 4
N_BRANCH = 3
D_FF = -(-8 * D_MODEL // (3 * 256)) * 256
N_MOD = 6
EPS = 1e-6

OFF_Q = 3 * CONV_WIDTH
OFF_K = OFF_Q + ATTN_WIDTH
OFF_V = OFF_K + KV_WIDTH
OFF_U = OFF_V + KV_WIDTH
OFF_SV = OFF_U + SG_WIDTH
OFF_G = OFF_SV + SG_WIDTH
IN_WIDTH = OFF_G + N_BRANCH * D_MODEL

kernel_name = 'hybrid_conv_gqa_gmlp_dit_block'


def rms_norm(x, g):
    xf = x.astype(jnp.float32)
    y = xf * lax.rsqrt(jnp.mean(xf * xf, axis=-1, keepdims=True) + EPS)
    return (y * g.astype(jnp.float32)).astype(x.dtype)


def modulate(h, shift, scale):
    return h * (1 + scale) + shift


def adaln(cond, w_mod, b_mod):
    return jnp.split(jax.nn.silu(cond) @ w_mod + b_mod, N_MOD, axis=-1)


def axial_rope_tables(n):
    rows = n // GRID_W
    row = jnp.repeat(jnp.arange(rows, dtype=jnp.float32), GRID_W)
    col = jnp.tile(jnp.arange(GRID_W, dtype=jnp.float32), rows)
    inv_freq = ROPE_THETA ** (-jnp.arange(0, AXIS_DIM, 2, dtype=jnp.float32) / AXIS_DIM)
    ang = jnp.stack([row[:, None] * inv_freq, col[:, None] * inv_freq], axis=1)
    return jnp.cos(ang), jnp.sin(ang)


def apply_rope(x, cos, sin):
    xr = x.astype(jnp.float32).reshape(*x.shape[:-1], 2, 2, AXIS_DIM // 2)
    x1, x2 = xr[..., 0, :], xr[..., 1, :]
    cs, sn = cos[:, None], sin[:, None]
    out = jnp.stack([x1 * cs - x2 * sn, x2 * cs + x1 * sn], axis=-2)
    return out.reshape(x.shape).astype(x.dtype)


def short_conv(z, w):
    zp = jnp.pad(z, ((0, 0), (1, 1), (0, 0)))
    return zp[:, :-2] * w[0] + zp[:, 1:-1] * w[1] + zp[:, 2:] * w[2]


def spatial_gate(u, v, sg_norm, w_s, b_s):
    v = rms_norm(v, sg_norm)
    B, S, _ = v.shape
    vc = v.reshape(B, S // CHUNK, CHUNK, SG_GROUPS, SG_WIDTH // SG_GROUPS)
    mixed = jnp.einsum('gts,bcsgd->bctgd', w_s, vc) + b_s.T[None, None, :, :, None]
    return u * mixed.reshape(B, S, SG_WIDTH)


def gqa_attend(q, k, v):
    s = jnp.einsum('bqhgd,bkhd->bhgqk', q, k).astype(jnp.float32) * (HEAD_DIM ** -0.5)
    p = jax.nn.softmax(s, axis=-1).astype(v.dtype)
    return jnp.einsum('bhgqk,bkhd->bqhgd', p, v)


def attend_blocks(q, k, v):
    B, S = q.shape[:2]
    nb = S // Q_BLOCK
    qb = jnp.moveaxis(q.reshape(B, nb, Q_BLOCK, N_KV_HEADS, GROUP, HEAD_DIM), 1, 0)
    out = lax.map(lambda qi: gqa_attend(qi, k, v), qb)
    return jnp.moveaxis(out, 0, 1).reshape(B, S, ATTN_WIDTH)


def project(h, w_in, q_gain, k_gain):
    p = h @ w_in
    a_b, a_c, a_x, q, k, v, u, sv, g = jnp.split(
        p, (CONV_WIDTH, 2 * CONV_WIDTH, OFF_Q, OFF_K, OFF_V, OFF_U, OFF_SV, OFF_G), axis=-1)
    q = rms_norm(q.reshape(*q.shape[:-1], N_Q_HEADS, HEAD_DIM), q_gain)
    k = rms_norm(k.reshape(*k.shape[:-1], N_KV_HEADS, HEAD_DIM), k_gain)
    v = v.reshape(*v.shape[:-1], N_KV_HEADS, HEAD_DIM)
    return a_b, a_c, a_x, q, k, v, u, sv, g


def project_kv(h, w_in, k_gain):
    k, v = jnp.split(h @ w_in[:, OFF_K:OFF_U], 2, axis=-1)
    k = rms_norm(k.reshape(*k.shape[:-1], N_KV_HEADS, HEAD_DIM), k_gain)
    return k, v.reshape(*v.shape[:-1], N_KV_HEADS, HEAD_DIM)


def merge_branches(a_b, a_c, a_x, attn, u, sv, g, conv_w, sg_norm, w_s, b_s, w_a, w_b, w_c, w_o):
    y_a = (a_b * short_conv(a_c * a_x, conv_w)) @ w_a
    y_b = attn @ w_b
    y_c = spatial_gate(jax.nn.gelu(u), jax.nn.gelu(sv), sg_norm, w_s, b_s) @ w_c
    g_a, g_b, g_c = jnp.split(jax.nn.sigmoid(g), N_BRANCH, axis=-1)
    return (g_a * y_a + g_b * y_b + g_c * y_c) @ w_o


def swiglu(h, w1, w3, w2):
    return (jax.nn.silu(h @ w1) * (h @ w3)) @ w2


def setup_inputs(seed: int = 0) -> dict:
    key = jax.random.key(seed)
    ks = jax.random.split(key, 24)
    f = jnp.float32
    D = D_MODEL

    def nrm(k, shape, scale):
        return jax.random.normal(k, shape, f) * scale

    return {
        'x': nrm(ks[0], (BATCH, SEQ, D), 1.0),
        'c': nrm(ks[1], (BATCH, D), 1.0),
        'ctx': nrm(ks[2], (BATCH, CTX_LEN, D), 1.0),
        'c_ctx': nrm(ks[3], (D,), 1.0),
        'w_mod': nrm(ks[4], (DEPTH, D, N_MOD * D), 0.5 * D ** -0.5),
        'b_mod': nrm(ks[5], (DEPTH, N_MOD * D), 0.02),
        'norm1': 1.0 + nrm(ks[6], (DEPTH, D), 0.02),
        'w_in': nrm(ks[7], (DEPTH, D, IN_WIDTH), D ** -0.5),
        'q_gain': 1.0 + nrm(ks[8], (DEPTH, HEAD_DIM), 0.02),
        'k_gain': 1.0 + nrm(ks[9], (DEPTH, HEAD_DIM), 0.02),
        'conv_w': nrm(ks[10], (DEPTH, CONV_K, CONV_WIDTH), CONV_K ** -0.5),
        'sg_norm': 1.0 + nrm(ks[11], (DEPTH, SG_WIDTH), 0.02),
        'w_s': nrm(ks[12], (DEPTH, SG_GROUPS, CHUNK, CHUNK), CHUNK ** -0.5),
        'b_s': 1.0 + nrm(ks[13], (DEPTH, SG_GROUPS, CHUNK), 0.02),
        'w_a': nrm(ks[14], (DEPTH, CONV_WIDTH, D), CONV_WIDTH ** -0.5),
        'w_b': nrm(ks[15], (DEPTH, ATTN_WIDTH, D), ATTN_WIDTH ** -0.5),
        'w_c': nrm(ks[16], (DEPTH, SG_WIDTH, D), SG_WIDTH ** -0.5),
        'w_o': nrm(ks[17], (DEPTH, D, D), D ** -0.5),
        'norm2': 1.0 + nrm(ks[18], (DEPTH, D), 0.02),
        'w_ff1': nrm(ks[19], (DEPTH, D, D_FF), D ** -0.5),
        'w_ff3': nrm(ks[20], (DEPTH, D, D_FF), D ** -0.5),
        'w_ff2': nrm(ks[21], (DEPTH, D_FF, D), D_FF ** -0.5),
    }


def reference(x, c, ctx, c_ctx, w_mod, b_mod, norm1, w_in, q_gain, k_gain, conv_w, sg_norm,
              w_s, b_s, w_a, w_b, w_c, w_o, norm2, w_ff1, w_ff3, w_ff2):
    n = x.shape[1]
    cos, sin = axial_rope_tables(n)
    B, L = ctx.shape[:2]
    for l in range(DEPTH):
        last = l == DEPTH - 1
        sh1, sc1, gt1, sh2, sc2, gt2 = [m[:, None, :] for m in adaln(c, w_mod[l], b_mod[l])]
        csh1, csc1, cgt1, csh2, csc2, cgt2 = adaln(c_ctx, w_mod[l], b_mod[l])

        h_ctx = modulate(rms_norm(ctx, norm1[l]), csh1, csc1)
        if last:
            k_c, v_c = project_kv(h_ctx, w_in[l], k_gain[l])
        else:
            ca_b, ca_c, ca_x, q_c, k_c, v_c, cu, csv, cg = project(h_ctx, w_in[l], q_gain[l], k_gain[l])
            attn_c = gqa_attend(q_c.reshape(B, L, N_KV_HEADS, GROUP, HEAD_DIM), k_c, v_c)
            attn_c = attn_c.reshape(B, L, ATTN_WIDTH)

        h = modulate(rms_norm(x, norm1[l]), sh1, sc1)
        a_b, a_c, a_x, q, k, v, u, sv, g = project(h, w_in[l], q_gain[l], k_gain[l])
        q = apply_rope(q, cos, sin)
        k = apply_rope(k, cos, sin)
        k_all = jnp.concatenate([k, k_c], axis=1)
        v_all = jnp.concatenate([v, v_c], axis=1)
        attn = attend_blocks(q, k_all, v_all)
        x = x + gt1 * merge_branches(a_b, a_c, a_x, attn, u, sv, g, conv_w[l], sg_norm[l],
                                     w_s[l], b_s[l], w_a[l], w_b[l], w_c[l], w_o[l])
        x = x + gt2 * swiglu(modulate(rms_norm(x, norm2[l]), sh2, sc2), w_ff1[l], w_ff3[l], w_ff2[l])

        if not last:
            ctx = ctx + cgt1 * merge_branches(ca_b, ca_c, ca_x, attn_c, cu, csv, cg, conv_w[l],
                                              sg_norm[l], w_s[l], b_s[l], w_a[l], w_b[l],
                                              w_c[l], w_o[l])
            ctx = ctx + cgt2 * swiglu(modulate(rms_norm(ctx, norm2[l]), csh2, csc2),
                                      w_ff1[l], w_ff3[l], w_ff2[l])
    return x
```

```cpp
#include <hip/hip_runtime.h>
#include <hip/hip_cooperative_groups.h>
#include <hip/hip_bf16.h>
#include <cstdio>
#include <cstdint>
#include <cmath>
namespace cg = cooperative_groups;
namespace pg8 {
#define PG8_LAS __attribute__((address_space(3)))
typedef unsigned short bf16_t;
typedef short bf16x8 __attribute__((ext_vector_type(8)));
typedef float f32x4 __attribute__((ext_vector_type(4)));
typedef unsigned u32x4 __attribute__((ext_vector_type(4)));
constexpr int BM = 256, BK = 64, HALF = 128, HTB = HALF * BK * 2  , STAGE_BYTES = 8 * HTB, NXCD = 8, WGM = 8;

__host__ __device__ __forceinline__ int lds_byte(int r, int c) { const int st = (r >> 4) * 2 + (c >> 5), rr = r & 15, cc = c & 31, ob = rr * 64 + cc * 2; return st * 1024 + (ob ^ (((ob >> 9) & 1) << 5)); }
__host__ __device__ __forceinline__ void stage_rc(int b, int& R, int& C) { const int st = b / 1024, sb = b % 1024, swz = sb ^ (((sb >> 9) & 1) << 5); R = (st >> 1) * 16 + swz / 64; C = (st & 1) * 32 + (swz % 64) / 2; }
__host__ __device__ __forceinline__ int perm32(int rho) { const int n = rho >> 4, i = rho & 15; return 8 * (i >> 2) + 4 * n + (i & 3); }

struct Unit { int pm, pn; };
struct Gemm { const bf16_t* A; const bf16_t* Bt; int M, N, K; };

struct StaticOrder {
    int nM, nN, nwg, G, c;
    __host__ __device__ void init(int M, int N, int G_, int c_) { nM = M / BM; nN = N / BM; nwg = nM * nN; G = G_; c = c_; }
    __host__ __device__ bool next(int i, Unit& u) const {
        const long L = (long)i * G + c; if (L >= nwg) return false;
        int wgid = (int)L; { const int q = nwg / NXCD, r = nwg % NXCD, xcd = wgid % NXCD, off = wgid / NXCD; wgid = (xcd < r ? xcd * (q + 1) : r * (q + 1) + (xcd - r) * q) + off; }
        const int nig = WGM * nN, gid = wgid / nig, fm = gid * WGM, gsz = (nM - fm) < WGM ? (nM - fm) : WGM;
        u.pm = fm + ((wgid % nig) % gsz); u.pn = (wgid % nig) / gsz; return true;
    }
    __device__ __forceinline__ void a_ready(const Unit&) const {}
    __device__ __forceinline__ void done(const Unit&) const {}
};

__device__ __forceinline__ unsigned cvt_pk_bf16(float lo, float hi) { unsigned r; asm volatile("v_cvt_pk_bf16_f32 %0, %1, %2" : "=v"(r) : "v"(lo), "v"(hi)); return r; }
typedef float f32x2 __attribute__((ext_vector_type(2)));
__device__ __forceinline__ float bf_lo(unsigned w) { return __uint_as_float(w << 16); }
__device__ __forceinline__ float bf_hi(unsigned w) { return __uint_as_float(w & 0xffff0000u); }
__device__ __forceinline__ float sigmoid_f(float x) { return __builtin_amdgcn_rcpf(1.0f + __builtin_amdgcn_exp2f(-1.4426950408889634f * x)); }
__device__ __forceinline__ float gelu_tanh_f(float x) { const float in2 = 1.5957691216057308f * (x + 0.044715f * x * x * x); return x * sigmoid_f(in2); }
__device__ __forceinline__ f32x4 act4(f32x4 v, int act) {
    if (act == 1) return (f32x4){gelu_tanh_f(v[0]), gelu_tanh_f(v[1]), gelu_tanh_f(v[2]), gelu_tanh_f(v[3])};
    if (act == 2) return (f32x4){sigmoid_f(v[0]), sigmoid_f(v[1]), sigmoid_f(v[2]), sigmoid_f(v[3])};
    return v;
}
constexpr float ATT_C2 = 0.125f * 1.4426950408889634f;
typedef unsigned u32x2 __attribute__((ext_vector_type(2)));
struct EpiInProj {
    static constexpr bool PERM = true, AFTER_DRAIN = false;
    bf16_t *PCONV, *Q, *Kb, *Vb, *PSG, *PG; const float *qg, *kg, *cosT, *sinT;
    __device__ __forceinline__ void operator()(const f32x4 (&acc)[2][2][4][2], const Unit& u, int wr, int wc, int fr, int fq) const {
        const int row0 = u.pm * BM + wr * 64 + fr, pn = u.pn;
        if (pn >= 3 && pn < 6) {
            const bool isq = pn < 5, isv = (pn == 5) && (wc >= 2), latent = u.pm < 64;
            const float* gp = isq ? qg : kg;
            f32x4 gn[2][2];
#pragma unroll
            for (int bj = 0; bj < 2; ++bj)
#pragma unroll
                for (int n = 0; n < 2; ++n) gn[bj][n] = *(const f32x4*)(gp + 32 * bj + 16 * n + 4 * fq);
#pragma unroll
            for (int ai = 0; ai < 2; ++ai)
#pragma unroll
                for (int m = 0; m < 4; ++m) {
                    const int row = row0 + ai * HALF + m * 16;
                    f32x4 v[2][2];
#pragma unroll
                    for (int bj = 0; bj < 2; ++bj)
#pragma unroll
                        for (int n = 0; n < 2; ++n) v[bj][n] = acc[ai][bj][m][n];
                    if (!isv) {
                        float ss = 0.f;
#pragma unroll
                        for (int bj = 0; bj < 2; ++bj)
#pragma unroll
                            for (int n = 0; n < 2; ++n) { const f32x4 x = v[bj][n]; ss += (x[0] * x[0] + x[1] * x[1]) + (x[2] * x[2] + x[3] * x[3]); }
                        ss += __shfl_xor(ss, 16); ss += __shfl_xor(ss, 32);
                        const float r = (1.0f / sqrtf(ss * (1.0f / 64.0f) + 1e-6f)) * (isq ? ATT_C2 : 1.0f);
#pragma unroll
                        for (int bj = 0; bj < 2; ++bj)
#pragma unroll
                            for (int n = 0; n < 2; ++n) v[bj][n] = v[bj][n] * gn[bj][n] * r;
                        if (latent) {
                            const int t = row & 8191;
#pragma unroll
                            for (int bj = 0; bj < 2; ++bj) {
                                const f32x4 c = *(const f32x4*)(cosT + t * 32 + bj * 16 + 4 * fq), s = *(const f32x4*)(sinT + t * 32 + bj * 16 + 4 * fq);
                                const f32x4 x1 = v[bj][0], x2 = v[bj][1];
                                v[bj][0] = x1 * c - x2 * s; v[bj][1] = x2 * c + x1 * s;
                            }
                        }
                    }
                    bf16_t* dst;
                    if (isq) dst = Q + (size_t)row * 512 + (pn - 3) * 256 + wc * 64;
                    else {
                        const int rc = row - 16384;
                        const size_t kvrow = latent ? (size_t)((row >> 13) * 8448 + (row & 8191)) : (size_t)((rc >> 8) * 8448 + 8192 + (rc & 255));
                        dst = isv ? Vb + kvrow * 128 + (wc - 2) * 64 : Kb + kvrow * 128 + wc * 64;
                    }
#pragma unroll
                    for (int bj = 0; bj < 2; ++bj)
#pragma unroll
                        for (int n = 0; n < 2; ++n) { u32x2 w; w.x = cvt_pk_bf16(v[bj][n][0], v[bj][n][1]); w.y = cvt_pk_bf16(v[bj][n][2], v[bj][n][3]);
                            *(u32x2*)(dst + 32 * bj + 16 * n + 4 * fq) = w; }
                }
        } else {
            bf16_t* base; int ld, colt, act;
            if (pn < 3) { base = PCONV; ld = 768; colt = pn * 256; act = 0; }
            else if (pn < 8) { base = PSG; ld = 512; colt = (pn - 6) * 256; act = 1; }
            else { base = PG; ld = 3072; colt = (pn - 8) * 256; act = 2; }
            const int col0 = colt + wc * 32 + 8 * fq;
#pragma unroll
            for (int ai = 0; ai < 2; ++ai)
#pragma unroll
                for (int m = 0; m < 4; ++m) { bf16_t* rowp = base + (size_t)(row0 + ai * HALF + m * 16) * ld + col0;
#pragma unroll
                    for (int bj = 0; bj < 2; ++bj) { const f32x4 v0 = act4(acc[ai][bj][m][0], act), v1 = act4(acc[ai][bj][m][1], act);
                        u32x4 w; w.x = cvt_pk_bf16(v0[0], v0[1]); w.y = cvt_pk_bf16(v0[2], v0[3]); w.z = cvt_pk_bf16(v1[0], v1[1]); w.w = cvt_pk_bf16(v1[2], v1[3]);
                        *(u32x4*)(rowp + bj * HALF) = w; } }
        }
    }
};
template <int MODE> struct EpiMerge {
    static constexpr bool PERM = true, AFTER_DRAIN = false;
    const bf16_t* PG; int goff; float* zf; bf16_t* z;
    __device__ __forceinline__ void operator()(const f32x4 (&acc)[2][2][4][2], const Unit& u, int wr, int wc, int fr, int fq) const {
        const int row0 = u.pm * BM + wr * 64 + fr, col0 = u.pn * BM + wc * 32 + 8 * fq;
#pragma unroll
        for (int ai = 0; ai < 2; ++ai)
#pragma unroll
            for (int m = 0; m < 4; ++m) { const size_t row = (size_t)(row0 + ai * HALF + m * 16);
#pragma unroll
                for (int bj = 0; bj < 2; ++bj) { const int col = col0 + bj * HALF;
                    const u32x4 gw = *(const u32x4*)(PG + row * 3072 + goff + col);
                    f32x4 v0 = acc[ai][bj][m][0] * (f32x4){bf_lo(gw.x), bf_hi(gw.x), bf_lo(gw.y), bf_hi(gw.y)};
                    f32x4 v1 = acc[ai][bj][m][1] * (f32x4){bf_lo(gw.z), bf_hi(gw.z), bf_lo(gw.w), bf_hi(gw.w)};
                    float* zp = zf + row * 1024 + col;
                    if (MODE >= 1) { v0 = v0 + *(const f32x4*)zp; v1 = v1 + *(const f32x4*)(zp + 4); }
                    if (MODE <= 1) { *(f32x4*)zp = v0; *(f32x4*)(zp + 4) = v1; }
                    else { u32x4 w; w.x = cvt_pk_bf16(v0[0], v0[1]); w.y = cvt_pk_bf16(v0[2], v0[3]); w.z = cvt_pk_bf16(v1[0], v1[1]); w.w = cvt_pk_bf16(v1[2], v1[3]);
                        *(u32x4*)(z + row * 1024 + col) = w; } } }
    }
};
struct EpiResid {
    static constexpr bool PERM = false, AFTER_DRAIN = false;
    float* xlat; float* xctx; const float* modl; int gidx;
    __device__ __forceinline__ void operator()(const f32x4 (&acc)[2][2][4][2], const Unit& u, int wr, int wc, int fr, int fq) const {
        const int row0 = u.pm * BM + wr * 64 + fr, col0 = u.pn * BM + wc * 32 + 4 * fq;
        const bool latent = u.pm < 64; const int src = latent ? (u.pm >> 5) : 2;
        f32x4 gt[2][2];
#pragma unroll
        for (int bj = 0; bj < 2; ++bj)
#pragma unroll
            for (int n = 0; n < 2; ++n) gt[bj][n] = *(const f32x4*)(modl + src * 6144 + gidx * 1024 + col0 + bj * HALF + n * 16);
#pragma unroll
        for (int ai = 0; ai < 2; ++ai)
#pragma unroll
            for (int m = 0; m < 4; ++m) { const int row = row0 + ai * HALF + m * 16;
                float* xp = (latent ? xlat + (size_t)row * 1024 : xctx + (size_t)(row - 16384) * 1024) + col0;
#pragma unroll
                for (int bj = 0; bj < 2; ++bj)
#pragma unroll
                    for (int n = 0; n < 2; ++n) { float* p = xp + bj * HALF + n * 16; *(f32x4*)p = *(const f32x4*)p + gt[bj][n] * acc[ai][bj][m][n]; } }
    }
};
struct EpiSwiGLU {
    static constexpr bool PERM = true, AFTER_DRAIN = false;
    bf16_t* HFF;
    __device__ __forceinline__ void operator()(const f32x4 (&acc)[2][2][4][2], const Unit& u, int wr, int wc, int fr, int fq) const {
        const int row0 = u.pm * BM + wr * 64 + fr, col0 = u.pn * HALF + wc * 32 + 8 * fq;
#pragma unroll
        for (int ai = 0; ai < 2; ++ai)
#pragma unroll
            for (int m = 0; m < 4; ++m) { const size_t row = (size_t)(row0 + ai * HALF + m * 16);
                const f32x4 a0 = acc[ai][0][m][0], a1 = acc[ai][0][m][1], b0 = acc[ai][1][m][0], b1 = acc[ai][1][m][1];
                f32x4 h0, h1;
#pragma unroll
                for (int j = 0; j < 4; ++j) { h0[j] = a0[j] * sigmoid_f(a0[j]) * b0[j]; h1[j] = a1[j] * sigmoid_f(a1[j]) * b1[j]; }
                u32x4 w; w.x = cvt_pk_bf16(h0[0], h0[1]); w.y = cvt_pk_bf16(h0[2], h0[3]); w.z = cvt_pk_bf16(h1[0], h1[1]); w.w = cvt_pk_bf16(h1[2], h1[3]);
                *(u32x4*)(HFF + row * 2816 + col0) = w; }
    }
};
template <class Epi, class Sched, bool ALIGN_EPI = false, bool SP2 = false>
__device__ __forceinline__ void gemm_phase(PG8_LAS unsigned char* lds, const Gemm g, const Sched& S, const Epi& E) {
    int tid_ = threadIdx.x; asm volatile("" : "+v"(tid_)); const int tid = tid_, wid = __builtin_amdgcn_readfirstlane(tid >> 6), lane = tid & 63, wr = wid >> 2, wc = wid & 3, fr = lane & 15, fq = lane >> 4;
    int K_ = g.K; asm volatile("" : "+s"(K_)); const int K = K_, nt = K / BK;
    unsigned voffA[2], voffB[2];
#pragma unroll
    for (int i = 0; i < 2; ++i) { int R, C; stage_rc(tid * 16 + i * 8192, R, C); const int Rb = Epi::PERM ? ((R & ~31) + perm32(R & 31)) : R;
        voffA[i] = (unsigned)(R * K + C) * 2u; voffB[i] = (unsigned)(Rb * K + C) * 2u; }
    const size_t kstep = (size_t)(BK * 2);
    const size_t hstep = (size_t)HALF * K * 2;
    const size_t tstep = 2 * hstep;
    const unsigned ldsw = (unsigned)wid * 1024u;
    const int aoff = lds_byte(wr * 64 + fr, fq * 8), boff = lds_byte(wc * 32 + fr, fq * 8);
#define PG8_SA(b, h) (((b) * 2 + (h)) * HTB)
#define PG8_SB(b, h) ((4 + (b) * 2 + (h)) * HTB)
#define PG8_STAGE(bufoff, gbase, voff) do { _Pragma("unroll") for (int _i = 0; _i < 2; ++_i) \
        __builtin_amdgcn_global_load_lds((const unsigned*)((const char*)(gbase) + (voff)[_i]), (PG8_LAS unsigned*)(lds + (bufoff) + ldsw + _i * 8192), 16, 0, 0); } while (0)
#define PG8_LDA(dst, b, h) do { _Pragma("unroll") for (int m = 0; m < 4; ++m) _Pragma("unroll") for (int k = 0; k < 2; ++k) dst[m][k] = *(const PG8_LAS bf16x8*)(lds + PG8_SA(b, h) + aoff + m * 2048 + k * 1024); } while (0)
#define PG8_LDB(dst, b, h) do { _Pragma("unroll") for (int n = 0; n < 2; ++n) _Pragma("unroll") for (int k = 0; k < 2; ++k) dst[n][k] = *(const PG8_LAS bf16x8*)(lds + PG8_SB(b, h) + boff + n * 2048 + k * 1024); } while (0)
#define PG8_MMA(ai, bj, At, Bt) do { __builtin_amdgcn_s_setprio(1); _Pragma("unroll") for (int m = 0; m < 4; ++m) _Pragma("unroll") for (int n = 0; n < 2; ++n) _Pragma("unroll") for (int k = 0; k < 2; ++k) \
        acc[ai][bj][m][n] = __builtin_amdgcn_mfma_f32_16x16x32_bf16(Bt[n][k], At[m][k], acc[ai][bj][m][n], 0, 0, 0); __builtin_amdgcn_s_setprio(0); } while (0)
#define PG8_WAIT_V(n) asm volatile("s_waitcnt vmcnt(" #n ")" ::: "memory")
#define PG8_WAIT_L(n) asm volatile("s_waitcnt lgkmcnt(" #n ")" ::: "memory")
#define PG8_BAR __builtin_amdgcn_s_barrier()
#define PG8_SCHED __builtin_amdgcn_sched_barrier(0)
    Unit cur, nxt; int ui = 0;
    if (!S.next(0, cur)) return;
    f32x4 acc[2][2][4][2];
#pragma unroll
    for (int a = 0; a < 2; ++a)
#pragma unroll
        for (int b = 0; b < 2; ++b)
#pragma unroll
            for (int m = 0; m < 4; ++m)
#pragma unroll
                for (int n = 0; n < 2; ++n) acc[a][b][m][n] = (f32x4){0.f, 0.f, 0.f, 0.f};
    bf16x8 At[4][2], B0[2][2], B1[2][2];
    const char* cA = (const char*)g.A + (size_t)cur.pm * tstep; const char* cB = (const char*)g.Bt + (size_t)cur.pn * tstep;
    S.a_ready(cur);
    if constexpr (SP2) {
        PG8_STAGE(PG8_SB(0, 0), cB, voffB); PG8_STAGE(PG8_SB(0, 1), cB + hstep, voffB); PG8_STAGE(PG8_SA(0, 0), cA, voffA); PG8_STAGE(PG8_SA(0, 1), cA + hstep, voffA);
        if (wr == 1) PG8_BAR;
        PG8_WAIT_V(2); PG8_BAR;
        PG8_STAGE(PG8_SB(1, 0), cB + kstep, voffB); PG8_STAGE(PG8_SA(1, 0), cA + kstep, voffA); PG8_STAGE(PG8_SB(1, 1), cB + hstep + kstep, voffB);
        PG8_WAIT_V(6); PG8_BAR;
    } else {
        PG8_STAGE(PG8_SB(0, 0), cB, voffB); PG8_STAGE(PG8_SA(0, 0), cA, voffA); PG8_STAGE(PG8_SB(0, 1), cB + hstep, voffB); PG8_STAGE(PG8_SA(0, 1), cA + hstep, voffA);
        if (wr == 1) PG8_BAR;
        PG8_WAIT_V(4); PG8_BAR;
        PG8_STAGE(PG8_SB(1, 0), cB + kstep, voffB); PG8_STAGE(PG8_SA(1, 0), cA + kstep, voffA); PG8_STAGE(PG8_SB(1, 1), cB + hstep + kstep, voffB);
        PG8_WAIT_V(6); PG8_BAR;
    }
    for (;;) {
        const bool has_next = S.next(ui + 1, nxt);
        const char* nA = has_next ? (const char*)g.A + (size_t)nxt.pm * tstep : cA; const char* nB = has_next ? (const char*)g.Bt + (size_t)nxt.pn * tstep : cB;
        for (int t = 0; t < nt; t += 2) {
            const bool last = (t == nt - 2);
            const char* a1 = cA + (size_t)(t + 1) * kstep;
            const char* a2 = last ? nA : cA + (size_t)(t + 2) * kstep; const char* b2 = last ? nB : cB + (size_t)(t + 2) * kstep;
            const char* a3 = a2 + kstep; const char* b3 = b2 + kstep;
            if (last && has_next) S.a_ready(nxt);
            if constexpr (SP2) {
            PG8_LDB(B0, 0, 0); PG8_LDB(B1, 0, 1); PG8_SCHED; PG8_LDA(At, 0, 0); PG8_STAGE(PG8_SA(1, 1), a1 + hstep, voffA);
            PG8_WAIT_V(8); PG8_WAIT_L(0); PG8_BAR; PG8_MMA(0, 0, At, B0); PG8_MMA(0, 1, At, B1); PG8_BAR; PG8_SCHED;
            PG8_LDA(At, 0, 1); PG8_STAGE(PG8_SB(0, 0), b2, voffB); PG8_STAGE(PG8_SB(0, 1), b2 + hstep, voffB); PG8_STAGE(PG8_SA(0, 0), a2, voffA);
            PG8_WAIT_V(8); PG8_WAIT_L(0); PG8_BAR; PG8_MMA(1, 0, At, B0); PG8_MMA(1, 1, At, B1); PG8_BAR; PG8_SCHED;
            PG8_LDB(B0, 1, 0); PG8_LDB(B1, 1, 1); PG8_SCHED; PG8_LDA(At, 1, 0); PG8_STAGE(PG8_SA(0, 1), a2 + hstep, voffA);
            PG8_WAIT_V(8); PG8_WAIT_L(0); PG8_BAR; PG8_MMA(0, 0, At, B0); PG8_MMA(0, 1, At, B1); PG8_BAR; PG8_SCHED;
            PG8_LDA(At, 1, 1); PG8_STAGE(PG8_SB(1, 0), b3, voffB); PG8_STAGE(PG8_SB(1, 1), b3 + hstep, voffB); PG8_STAGE(PG8_SA(1, 0), a3, voffA);
            PG8_WAIT_V(8); PG8_WAIT_L(0); PG8_BAR; PG8_MMA(1, 0, At, B0); PG8_MMA(1, 1, At, B1); PG8_BAR; PG8_SCHED;
            } else {
            PG8_LDB(B0, 0, 0); PG8_SCHED; PG8_LDA(At, 0, 0); PG8_STAGE(PG8_SA(1, 1), a1 + hstep, voffA);
            PG8_WAIT_L(8); PG8_BAR; PG8_WAIT_L(0); PG8_MMA(0, 0, At, B0); PG8_BAR; PG8_SCHED;
            PG8_LDB(B1, 0, 1); PG8_STAGE(PG8_SB(0, 0), b2, voffB);
            PG8_BAR; PG8_WAIT_L(0); PG8_MMA(0, 1, At, B1); PG8_BAR;
            PG8_LDA(At, 0, 1); PG8_STAGE(PG8_SA(0, 0), a2, voffA);
            PG8_BAR; PG8_WAIT_L(0); PG8_MMA(1, 0, At, B0); PG8_BAR; PG8_SCHED;
            PG8_STAGE(PG8_SB(0, 1), b2 + hstep, voffB);
            PG8_WAIT_V(6); PG8_BAR; PG8_MMA(1, 1, At, B1); PG8_BAR;
            PG8_LDB(B0, 1, 0); PG8_SCHED; PG8_LDA(At, 1, 0); PG8_STAGE(PG8_SA(0, 1), a2 + hstep, voffA);
            PG8_WAIT_L(8); PG8_BAR; PG8_WAIT_L(0); PG8_MMA(0, 0, At, B0); PG8_BAR; PG8_SCHED;
            PG8_LDB(B1, 1, 1); PG8_STAGE(PG8_SB(1, 0), b3, voffB);
            PG8_BAR; PG8_WAIT_L(0); PG8_MMA(0, 1, At, B1); PG8_BAR;
            PG8_LDA(At, 1, 1); PG8_STAGE(PG8_SA(1, 0), a3, voffA);
            PG8_BAR; PG8_WAIT_L(0); PG8_MMA(1, 0, At, B0); PG8_BAR; PG8_SCHED;
            PG8_STAGE(PG8_SB(1, 1), b3 + hstep, voffB);
            PG8_WAIT_V(6); PG8_BAR; PG8_MMA(1, 1, At, B1); PG8_BAR;
            }
        }
        if constexpr (ALIGN_EPI) { if (wr == 0) PG8_BAR; }
        if constexpr (!Epi::AFTER_DRAIN) { E(acc, cur, wr, wc, fr, fq); S.done(cur); }
        if (!has_next) break;
#pragma unroll
        for (int a = 0; a < 2; ++a)
#pragma unroll
            for (int b = 0; b < 2; ++b)
#pragma unroll
                for (int m = 0; m < 4; ++m)
#pragma unroll
                    for (int n = 0; n < 2; ++n) acc[a][b][m][n] = (f32x4){0.f, 0.f, 0.f, 0.f};
        cur = nxt; cA = nA; cB = nB; ++ui;
        if constexpr (ALIGN_EPI) { if (wr == 1) PG8_BAR; }
    }
    PG8_WAIT_V(0);
    if constexpr (!ALIGN_EPI) { if (wr == 0) PG8_BAR; }
    PG8_BAR;
    if constexpr (Epi::AFTER_DRAIN) { E.fused(acc, cur, wr, wc, fr, fq, lds, wid, lane); S.done(cur); }
#undef PG8_SA
#undef PG8_SB
#undef PG8_STAGE
#undef PG8_LDA
#undef PG8_LDB
#undef PG8_MMA
#undef PG8_WAIT_V
#undef PG8_WAIT_L
#undef PG8_BAR
#undef PG8_SCHED
}
}
#include <hip/hip_bf16.h>
#include <cmath>
namespace attn_body {
using bf16=__hip_bfloat16;
using bf16x8=__attribute__((ext_vector_type(8)))short;
using s16x4=__attribute__((ext_vector_type(4)))short;
using f32x16=__attribute__((ext_vector_type(16)))float;
using u32x4=__attribute__((ext_vector_type(4)))unsigned;
constexpr int D=64,QP=512,KP=128;
constexpr int NW=8,QBLK=32,QB=QBLK*NW,KVBLK=64;
constexpr int ATTN_UNIT_ROWS=QB;
__device__ __forceinline__ int crow(int r,int hi){return (r&3)+8*(r>>2)+4*hi;}
#define SBAR() __builtin_amdgcn_sched_barrier(0)
__device__ __forceinline__ void cmask(f32x16&p0,f32x16&p1,int jb,int qrel,int hi){
  const float NEG=-INFINITY; int kb=64*jb+4*hi;
  #pragma unroll
  for(int r=0;r<16;++r){int kv=kb+(r&3)+8*(r>>2); if(kv>qrel)p0[r]=NEG; if(kv+32>qrel)p1[r]=NEG;}
}

constexpr int NSLOT=3, SLOTB=8192;
constexpr int LDS_K=0, LDS_V=NSLOT*SLOTB, LDS_WS=2*NSLOT*SLOTB, LDS_OST=LDS_WS+NW*64*4, LDS_BYTES=LDS_OST+NW*4096;
constexpr float C2=0.125f*1.4426950408889634f;
__device__ __forceinline__ void glds16(const void*gsrc,unsigned lds_dst){unsigned keep;
  asm volatile("s_mov_b32 %0, m0\n\ts_mov_b32 m0, %2\n\ts_nop 0\n\tglobal_load_lds_dwordx4 %1, off\n\ts_mov_b32 m0, %0":"=&s"(keep):"v"(gsrc),"s"(lds_dst):"memory");}
__device__ __forceinline__ float max3f(float a,float b,float c){float r;asm("v_max3_f32 %0, %1, %2, %3":"=v"(r):"v"(a),"v"(b),"v"(c));return r;}
__device__ __forceinline__ float max2f(float a,float b){float r;asm("v_max_f32_e32 %0, %1, %2":"=v"(r):"v"(a),"v"(b));return r;}
__device__ __forceinline__ float fadd_s(float a,float b){float r;asm("v_add_f32_e32 %0, %1, %2":"=v"(r):"v"(a),"v"(b));return r;}
__device__ __forceinline__ float fsub_s(float a,float b){float r;asm("v_sub_f32_e32 %0, %1, %2":"=v"(r):"v"(a),"v"(b));return r;}
typedef float f32x2_t __attribute__((ext_vector_type(2))); typedef __bf16 bf16x2_t __attribute__((ext_vector_type(2)));
__device__ __forceinline__ unsigned cvtpk_s(float lo,float hi){f32x2_t v={lo,hi};bf16x2_t b=__builtin_convertvector(v,bf16x2_t);return __builtin_bit_cast(unsigned,b);}
#define WAIT_BAR(N) asm volatile("s_waitcnt vmcnt(" #N ") lgkmcnt(0)\n\ts_barrier":::"memory")

__device__ __forceinline__ void qkt(f32x16&p0,f32x16&p1,const char*Kslot,const bf16x8*qr,const f32x16&negm,int r32,int hi){
  const char*kb=Kslot+hi*1024+r32*16;
  #pragma unroll
  for(int d0=0;d0<4;++d0){
    const bf16x8 b0=*reinterpret_cast<const bf16x8*>(kb+d0*2048);
    const bf16x8 b1=*reinterpret_cast<const bf16x8*>(kb+d0*2048+512);
    if(d0==0){p0=__builtin_amdgcn_mfma_f32_32x32x16_bf16(b0,qr[0],negm,0,0,0);p1=__builtin_amdgcn_mfma_f32_32x32x16_bf16(b1,qr[0],negm,0,0,0);}
    else{p0=__builtin_amdgcn_mfma_f32_32x32x16_bf16(b0,qr[d0],p0,0,0,0);p1=__builtin_amdgcn_mfma_f32_32x32x16_bf16(b1,qr[d0],p1,0,0,0);}}
}
typedef __attribute__((address_space(3))) const char* lds_cptr;
typedef short v4i16_t __attribute__((ext_vector_type(4)));
__device__ __forceinline__ void kload8(bf16x8*kf,lds_cptr kp){
  kf[0]=*(const __attribute__((address_space(3))) bf16x8*)(kp);      kf[1]=*(const __attribute__((address_space(3))) bf16x8*)(kp+512);
  kf[2]=*(const __attribute__((address_space(3))) bf16x8*)(kp+2048); kf[3]=*(const __attribute__((address_space(3))) bf16x8*)(kp+2560);
  kf[4]=*(const __attribute__((address_space(3))) bf16x8*)(kp+4096); kf[5]=*(const __attribute__((address_space(3))) bf16x8*)(kp+4608);
  kf[6]=*(const __attribute__((address_space(3))) bf16x8*)(kp+6144); kf[7]=*(const __attribute__((address_space(3))) bf16x8*)(kp+6656);
}
__device__ __forceinline__ void kload2(bf16x8*kf,lds_cptr kp,int j){ kf[2*j]=*(const __attribute__((address_space(3))) bf16x8*)(kp+j*2048); kf[2*j+1]=*(const __attribute__((address_space(3))) bf16x8*)(kp+j*2048+512); }
__device__ __forceinline__ s16x4 vtr(lds_cptr p){ return __builtin_bit_cast(s16x4,__builtin_amdgcn_ds_read_tr16_b64_v4i16((__attribute__((address_space(3))) v4i16_t*)p)); }
__device__ __forceinline__ float rowmax(const f32x16&p0,const f32x16&p1){
  float a=max3f(p0[0],p0[1],p1[0]),b=max3f(p0[2],p0[3],p1[1]);a=max3f(a,p1[2],p1[3]);
  #pragma unroll
  for(int r=4;r<16;r+=4){a=max3f(a,p0[r],p0[r+1]);b=max3f(b,p0[r+2],p0[r+3]);a=max3f(a,p1[r],p1[r+1]);b=max3f(b,p1[r+2],p1[r+3]);}
  const float m=max2f(a,b);
  auto rr=__builtin_amdgcn_permlane32_swap(__float_as_uint(m),__float_as_uint(m),false,false);
  return max2f(__uint_as_float(rr[0]),__uint_as_float(rr[1]));
}
__device__ __forceinline__ void pv(f32x16*o,int vb,bf16x8 pa0,bf16x8 pa1,bf16x8 pa2,bf16x8 pa3){
  #pragma unroll
  for(int d0=0;d0<2;++d0){s16x4 lo[4],hi[4];
    #pragma unroll
    for(int ks=0;ks<4;++ks){
      asm volatile("ds_read_b64_tr_b16 %0,%1 offset:%c2":"=&v"(lo[ks]):"v"(vb),"i"(d0*4096+ks*1024):"memory");
      asm volatile("ds_read_b64_tr_b16 %0,%1 offset:%c2":"=&v"(hi[ks]):"v"(vb),"i"(d0*4096+ks*1024+512):"memory");}
    asm volatile("s_waitcnt lgkmcnt(0)":::"memory");SBAR();
    #define PK(k) (bf16x8){lo[k][0],lo[k][1],lo[k][2],lo[k][3],hi[k][0],hi[k][1],hi[k][2],hi[k][3]}
    o[d0]=__builtin_amdgcn_mfma_f32_32x32x16_bf16(pa0,PK(0),o[d0],0,0,0);
    o[d0]=__builtin_amdgcn_mfma_f32_32x32x16_bf16(pa1,PK(1),o[d0],0,0,0);
    o[d0]=__builtin_amdgcn_mfma_f32_32x32x16_bf16(pa2,PK(2),o[d0],0,0,0);
    o[d0]=__builtin_amdgcn_mfma_f32_32x32x16_bf16(pa3,PK(3),o[d0],0,0,0);
    #undef PK
  }
}

#ifndef ATTN_STORE16
#define ATTN_STORE16(p,v) (*(u32x4*)(p)=(v))
#endif
template<int THRL> __device__ __forceinline__ void attn_unit(long qrow0,int h,long kvrow0,int NT,const bf16*Q,const bf16*__restrict__ K,const bf16*__restrict__ V,bf16*O,char*shm){
  int tid_=threadIdx.x; asm volatile("":"+v"(tid_)); const int tid=tid_,lane=tid&63,r32=lane&31,hi=lane>>5; const int wid=__builtin_amdgcn_readfirstlane(tid>>6);
  const bf16*Qw=Q+(qrow0+wid*QBLK)*QP+h*D;
  const bf16*Kh=K+kvrow0*KP+(h>>2)*D,*Vh=V+kvrow0*KP+(h>>2)*D;
  const unsigned lds0=(unsigned)(uintptr_t)shm;
  float*wsf=(float*)(shm+LDS_WS)+wid*64;
  const bf16*ksrc=Kh+(long)lane*KP+wid*8;
  const bf16*vsrc=Vh+(long)(16*(wid&3)+(lane>>2))*KP+(wid>>2)*32+(lane&3)*8;
  const unsigned kdst=lds0+LDS_K+wid*1024, vdst=lds0+LDS_V+wid*1024;
  #define DMA_K(t,slot) glds16(ksrc+(long)(t)*KVBLK*KP,(unsigned)__builtin_amdgcn_readfirstlane(kdst+(slot)))
  #define DMA_V(t,slot) glds16(vsrc+(long)(t)*KVBLK*KP,(unsigned)__builtin_amdgcn_readfirstlane(vdst+(slot)))
  const int vb0=(int)(lds0+LDS_V)+((lane>>4)&1)*32+(lane&3)*8+(4*hi+((lane&15)>>2))*64;
  const char*Kbase=shm+LDS_K; bf16x8 kf[8];
  const lds_cptr shm3=(lds_cptr)shm; const lds_cptr kp0=shm3+LDS_K+hi*1024+r32*16; const lds_cptr vp0=shm3+LDS_V+((lane>>4)&1)*32+(lane&3)*8+(4*hi+((lane&15)>>2))*64;
  DMA_K(0,0);DMA_V(0,0);DMA_K(1,SLOTB);
  bf16x8 qr[4];
  #pragma unroll
  for(int d0=0;d0<4;++d0)qr[d0]=*reinterpret_cast<const bf16x8*>(&Qw[(long)r32*QP+d0*16+hi*8]);
  float mhat=0.f,l_reg=0.f;f32x16 o[2];o[0]=f32x16{};o[1]=f32x16{};f32x16 negm=f32x16{};asm volatile("":"+v"(negm));
  #define CMASK(P0,P1,t) do{}while(0)
  bool resc=false;
  #define START(P0,P1) do{ const float rm=rowmax(P0,P1); resc=false; \
    { const float dl=rm; mhat=fadd_s(mhat,dl); \
      _Pragma("unroll") for(int r=0;r<16;++r){P0[r]=fsub_s(P0[r],dl);P1[r]=fsub_s(P1[r],dl);} \
      _Pragma("unroll") for(int r=0;r<16;++r)negm[r]=-mhat; asm volatile("":"+v"(negm)); } \
    _Pragma("unroll") for(int r=0;r<16;++r)P0[r]=__builtin_amdgcn_exp2f(P0[r]); }while(0)
  #define RESC() do{ if(resc){ asm volatile("s_waitcnt lgkmcnt(0)":::"memory"); \
      _Pragma("unroll") for(int d_=0;d_<2;++d_) _Pragma("unroll") for(int r=0;r<16;++r)o[d_][r]*=wsf[crow(r,hi)]; } }while(0)
  f32x16 pA0,pA1,pB0,pB1;
  int sl_prev=0,sl_cur=0,sl_next=SLOTB;
  #define ROT() do{sl_prev=sl_cur;sl_cur=sl_next;sl_next=(sl_next==(NSLOT-1)*SLOTB)?0:sl_next+SLOTB;}while(0)
  DMA_K(2,2*SLOTB);
  WAIT_BAR(3);
  qkt(pA0,pA1,Kbase,qr,negm,r32,hi);asm volatile("s_nop 15\n\ts_nop 7":"+v"(pA0),"+v"(pA1));CMASK(pA0,pA1,0);
  START(pA0,pA1);
  _Pragma("unroll") for(int r=0;r<16;++r)pA1[r]=__builtin_amdgcn_exp2f(pA1[r]);
  WAIT_BAR(0);
  DMA_K(3,0);DMA_V(1,SLOTB);
  ROT();
  kload8(kf,kp0+sl_cur);
  WAIT_BAR(2);
  s16x4 vlo[8],vhi[8]; u32x4 pw0,pw1,pw2,pw3;
  #define PKW(P,B) cvtpk_s(P[B],P[B+1])
  #define PAF(k) __builtin_bit_cast(bf16x8,pw##k)
  #define VFR(i) (bf16x8){vlo[i][0],vlo[i][1],vlo[i][2],vlo[i][3],vhi[i][0],vhi[i][1],vhi[i][2],vhi[i][3]}
  #define PIN(x) asm volatile("":"+v"(x))
  #define MX3(a,b,c) __builtin_fmaxf(__builtin_fmaxf((a),(b)),(c))
  #define GAPA(MF,A0,A1,A2,A3,W0,W1,PW) do{ MF; sacc+=A0; sacc+=A1; sacc+=A2; sacc+=A3; PIN(sacc); W0; W1; PIN(PW); SBAR(); }while(0)
  #define EX(v) __builtin_amdgcn_exp2f(v)
  #define GAPB(MF,X,B) do{ MF; X[B]=EX(X[B]); X[B+1]=EX(X[B+1]); X[B+2]=EX(X[B+2]); X[B+3]=EX(X[B+3]); PIN(X); SBAR(); }while(0)
  #define VRD(i) do{ vlo[i]=vtr(vp_+(((i)>>2)*4096+((i)&3)*1024)); vhi[i]=vtr(vp_+(((i)>>2)*4096+((i)&3)*1024+512)); }while(0)
  #define KRD(G,j) do{ if(G){ kload2(kf,kp0+sl_next,j); SBAR(); } }while(0)
  #define STEP(C0,C1,P0,P1,t,GK,GV,GL) do{ SBAR(); \
    const lds_cptr vp_=vp0+sl_prev; \
    VRD(0); SBAR(); float sacc=(P0[0]+P0[1]); \
    GAPA(C0=__builtin_amdgcn_mfma_f32_32x32x16_bf16(kf[0],qr[0],negm,0,0,0), P0[2],P0[3],P0[4],P0[5],     pw0[0]=PKW(P0,0), pw0[1]=PKW(P0,2), pw0); \
    VRD(4); SBAR(); GAPA(C1=__builtin_amdgcn_mfma_f32_32x32x16_bf16(kf[1],qr[0],negm,0,0,0), P0[6],P0[7],P0[8],P0[9],     pw0[2]=PKW(P0,4), pw0[3]=PKW(P0,6), pw0); \
    VRD(1); SBAR(); GAPA(C0=__builtin_amdgcn_mfma_f32_32x32x16_bf16(kf[2],qr[1],C0,0,0,0),   P0[10],P0[11],P0[12],P0[13], pw1[0]=PKW(P0,8), pw1[1]=PKW(P0,10), pw1); \
    VRD(5); SBAR(); GAPA(C1=__builtin_amdgcn_mfma_f32_32x32x16_bf16(kf[3],qr[1],C1,0,0,0),   P0[14],P0[15],P1[0],P1[1],   pw1[2]=PKW(P0,12),pw1[3]=PKW(P0,14), pw1); \
    VRD(2); SBAR(); GAPA(C0=__builtin_amdgcn_mfma_f32_32x32x16_bf16(kf[4],qr[2],C0,0,0,0),   P1[2],P1[3],P1[4],P1[5],     pw2[0]=PKW(P1,0), pw2[1]=PKW(P1,2), pw2); \
    VRD(6); SBAR(); GAPA(C1=__builtin_amdgcn_mfma_f32_32x32x16_bf16(kf[5],qr[2],C1,0,0,0),   P1[6],P1[7],P1[8],P1[9],     pw2[2]=PKW(P1,4), pw2[3]=PKW(P1,6), pw2); \
    VRD(3); SBAR(); GAPA(C0=__builtin_amdgcn_mfma_f32_32x32x16_bf16(kf[6],qr[3],C0,0,0,0),   P1[10],P1[11],P1[12],P1[13], pw3[0]=PKW(P1,8), pw3[1]=PKW(P1,10), pw3); \
    VRD(7); SBAR(); GAPA(C1=__builtin_amdgcn_mfma_f32_32x32x16_bf16(kf[7],qr[3],C1,0,0,0),   P1[14],P1[15],0.f,0.f,       pw3[2]=PKW(P1,12),pw3[3]=PKW(P1,14), pw3); \
    l_reg+=sacc; \
    if(GK){DMA_K((t)+3,sl_cur);} if(GV){DMA_V((t)+1,sl_next);} \
    CMASK(C0,C1,t); \
    { float a=MX3(C0[0],C0[1],C1[0]),b=MX3(C0[2],C0[3],C1[1]); a=MX3(a,C1[2],C1[3]); \
      _Pragma("unroll") for(int r=4;r<16;r+=4){a=MX3(a,C0[r],C0[r+1]);b=MX3(b,C0[r+2],C0[r+3]);a=MX3(a,C1[r],C1[r+1]);b=MX3(b,C1[r+2],C1[r+3]);} \
      float rm=__builtin_fmaxf(a,b); { auto rr=__builtin_amdgcn_permlane32_swap(__float_as_uint(rm),__float_as_uint(rm),false,false); rm=__builtin_fmaxf(__uint_as_float(rr[0]),__uint_as_float(rr[1])); } \
      resc=false; \
      if(__builtin_expect(__any(rm>(float)THRL),0)){ const float dl=__builtin_fmaxf(rm,0.f); mhat+=dl; \
        _Pragma("unroll") for(int r=0;r<16;++r){C0[r]-=dl;C1[r]-=dl;} \
        _Pragma("unroll") for(int r=0;r<16;++r)negm[r]=-mhat; asm volatile("":"+v"(negm)); \
        const float f=__builtin_amdgcn_exp2f(-dl); l_reg*=f; if(hi==0)wsf[r32]=f; resc=true; } } \
    SBAR(); \
    GAPB(o[0]=__builtin_amdgcn_mfma_f32_32x32x16_bf16(PAF(0),VFR(0),o[0],0,0,0), C0,0); \
    GAPB(o[1]=__builtin_amdgcn_mfma_f32_32x32x16_bf16(PAF(0),VFR(4),o[1],0,0,0), C0,4); \
    KRD(GL,0); GAPB(o[0]=__builtin_amdgcn_mfma_f32_32x32x16_bf16(PAF(1),VFR(1),o[0],0,0,0), C0,8); \
    KRD(GL,1); GAPB(o[1]=__builtin_amdgcn_mfma_f32_32x32x16_bf16(PAF(1),VFR(5),o[1],0,0,0), C0,12); \
    KRD(GL,2); GAPB(o[0]=__builtin_amdgcn_mfma_f32_32x32x16_bf16(PAF(2),VFR(2),o[0],0,0,0), C1,0); \
    KRD(GL,3); GAPB(o[1]=__builtin_amdgcn_mfma_f32_32x32x16_bf16(PAF(2),VFR(6),o[1],0,0,0), C1,4); \
    GAPB(o[0]=__builtin_amdgcn_mfma_f32_32x32x16_bf16(PAF(3),VFR(3),o[0],0,0,0), C1,8); \
    GAPB(o[1]=__builtin_amdgcn_mfma_f32_32x32x16_bf16(PAF(3),VFR(7),o[1],0,0,0), C1,12); \
    }while(0)
  int t=1;
  #undef CMASK
  #define CMASK(P0,P1,t) do{}while(0)
  for(;t+5<NT;t+=2){
    STEP(pB0,pB1,pA0,pA1,t,true,true,true);     WAIT_BAR(2); RESC(); ROT();
    STEP(pA0,pA1,pB0,pB1,t+1,true,true,true);   WAIT_BAR(2); RESC(); ROT();
  }
  #undef CMASK
  #define CMASK(P0,P1,t) do{}while(0)
  #define ENDW(tt) do{ if((tt)+3<NT){WAIT_BAR(2);} else if((tt)+2<NT){WAIT_BAR(1);} else {WAIT_BAR(0);} }while(0)
  for(;t+1<NT;t+=2){
    STEP(pB0,pB1,pA0,pA1,t,(t+3<NT),(t+1<NT),(t+1<NT));       ENDW(t);   RESC(); ROT();
    STEP(pA0,pA1,pB0,pB1,t+1,(t+4<NT),(t+2<NT),(t+2<NT));     ENDW(t+1); RESC(); ROT();
  }
  STEP(pB0,pB1,pA0,pA1,NT-1,false,false,false); RESC();
  { float sacc=pB0[0]+pB0[1]; _Pragma("unroll") for(int r=2;r<16;++r)sacc+=pB0[r]; _Pragma("unroll") for(int r=0;r<16;++r)sacc+=pB1[r]; l_reg+=sacc;
    pw0=(u32x4){PKW(pB0,0),PKW(pB0,2),PKW(pB0,4),PKW(pB0,6)};pw1=(u32x4){PKW(pB0,8),PKW(pB0,10),PKW(pB0,12),PKW(pB0,14)};pw2=(u32x4){PKW(pB1,0),PKW(pB1,2),PKW(pB1,4),PKW(pB1,6)};pw3=(u32x4){PKW(pB1,8),PKW(pB1,10),PKW(pB1,12),PKW(pB1,14)};
    SBAR(); pv(o,vb0+sl_cur,PAF(0),PAF(1),PAF(2),PAF(3)); }
  #undef PKW
  #undef PAF
  #undef VFR
  #undef PIN
  #undef MX3
  #undef GAPA
  #undef GAPB
  #undef EX
  #undef VRD
  #undef KRD
  #undef STEP
  #undef ENDW
  {auto rr=__builtin_amdgcn_permlane32_swap(__float_as_uint(l_reg),__float_as_uint(l_reg),false,false);l_reg=__uint_as_float(rr[0])+__uint_as_float(rr[1]);}
  if(hi==0)wsf[32+r32]=l_reg;asm volatile("s_waitcnt lgkmcnt(0)":::"memory");
  float rli[16];
  #pragma unroll
  for(int r=0;r<16;++r)rli[r]=__builtin_amdgcn_rcpf(wsf[32+crow(r,hi)]);
  bf16*Ow=O+(qrow0+wid*QBLK)*QP+h*D;
  { bf16*stg=(bf16*)(shm+LDS_OST)+wid*2048;
    #pragma unroll
    for(int r=0;r<16;++r){const int orow=crow(r,hi);
      #pragma unroll
      for(int d0=0;d0<2;++d0)stg[orow*64+d0*32+r32]=__float2bfloat16(o[d0][r]*rli[r]);}
    asm volatile("s_waitcnt lgkmcnt(0)":::"memory");
    #pragma unroll
    for(int i=0;i<4;++i){const int row=i*8+(lane>>3),ch=lane&7; const u32x4 v=*(const u32x4*)(stg+row*64+ch*8); ATTN_STORE16(Ow+(long)row*QP+ch*8,v);} }
  asm volatile("s_waitcnt lgkmcnt(0)\n\ts_barrier":::"memory");
  #undef DMA_K
  #undef DMA_V
  #undef CMASK
  #undef START
  #undef RESC
  #undef ROT
}
constexpr int ATTN_LDS_BYTES=LDS_BYTES;
#undef SBAR
#undef WAIT_BAR
}
#define LAS __attribute__((address_space(3)))
typedef unsigned short bf16;
typedef unsigned v4u __attribute__((ext_vector_type(4)));
typedef unsigned v2u __attribute__((ext_vector_type(2)));
typedef float f32x4 __attribute__((ext_vector_type(4)));
#ifndef MK_MULTI
#define MK_MULTI 0
#endif
constexpr int NWAVES = 8, NTHREADS = 512;
constexpr int DMODEL = 1024, DEPTH = 4, ML = 16384, MC = 512, MT = ML + MC;
constexpr int INW = 5120, DFF = 2816, NMODW = 6144;
constexpr int NPHASE = 1 + 8 * DEPTH;
constexpr size_t MiB = 1u << 20;
constexpr size_t WS_MOD = 0, WS_COS = 1 * MiB, WS_SIN = 2 * MiB, WS_CTX = 3 * MiB, WS_W = 6 * MiB, WS_H = 38 * MiB, WS_Q = 72 * MiB, WS_K = 89 * MiB, WS_V = 94 * MiB,
                 WS_ZA = 99 * MiB, WS_ZB = 108 * MiB, WS_ZC = 125 * MiB, WS_ZF = 134 * MiB, WS_P = 200 * MiB;
constexpr size_t P_CONV = 0, P_SG = (size_t)MT * 768 * 2, P_G = P_SG + (size_t)MT * 512 * 2, WS_END = WS_P + P_G + (size_t)MT * 3072 * 2;
constexpr size_t WO_IN = 0, WO_A = WO_IN + 5120 * 1024, WO_B = WO_A + 1024 * 256, WO_C = WO_B + 1024 * 512, WO_O = WO_C + 1024 * 256, WO_13 = WO_O + 1024 * 1024,
                 WO_2 = WO_13 + 5632 * 1024, WO_END = WO_2 + 1024 * 2816;
static_assert(WO_END * 2 <= 32 * MiB && (size_t)MT * 1024 * 2 <= 34 * MiB && (size_t)MT * 1024 * 4 <= 66 * MiB && (size_t)MT * 2816 * 2 <= WS_END - WS_P, "ws map");
constexpr int LDS_BYTES = 147456;

__device__ __forceinline__ unsigned f2bf(float f) { unsigned u = __builtin_bit_cast(unsigned, f); return (u + 0x7fffu + ((u >> 16) & 1u)) >> 16; }
__device__ __forceinline__ unsigned pk2(float lo, float hi) { return f2bf(lo) | (f2bf(hi) << 16); }
__device__ __forceinline__ float bflo(unsigned w) { return __uint_as_float(w << 16); }
__device__ __forceinline__ float bfhi(unsigned w) { return __uint_as_float(w & 0xffff0000u); }
__device__ __forceinline__ float wave_sum(float v) {
#pragma unroll
    for (int o = 1; o < 64; o <<= 1) v += __shfl_xor(v, o);
    return v;
}
__device__ __forceinline__ int inproj_src_col(int nn) {
    if (nn < 768 || nn >= 1536) return nn;
    const int q = nn - 768, tile = q >> 8, p = q & 255, bj = p >> 7, wc = (p >> 5) & 3, fq = (p >> 3) & 3, n = (p >> 2) & 1, j = p & 3;
    return 768 + tile * 256 + wc * 64 + 32 * bj + 16 * n + 4 * fq + j;
}
template <int MODE> __device__ __forceinline__ void transpose_item(const float* W, const float* W3, int K, int N, bf16* WT, LAS float* scr, int item, int nblk, int lane) {
    const int kb = item / nblk, nb = item % nblk, k0 = 64 * kb, n0 = 32 * nb, nn = n0 + (lane & 31);
    const float* src;
    if (MODE == 0) src = W + nn;
    else if (MODE == 1) src = W + inproj_src_col(nn);
    else { const int tile = nn >> 8, p = nn & 255; src = ((p >> 7) ? W3 : W) + 128 * tile + (p & 127); }
#pragma unroll 8
    for (int i = 0; i < 32; ++i) { const int kk = 2 * i + (lane >> 5); scr[kk * 33 + (lane & 31)] = src[(size_t)(k0 + kk) * N]; }
    asm volatile("s_waitcnt lgkmcnt(0)" ::: "memory");
    const int c = lane & 7;
#pragma unroll
    for (int j = 0; j < 4; ++j) { const int n = (lane >> 3) + 8 * j; const LAS float* s = scr + (8 * c) * 33 + n;
        v4u o; o.x = pk2(s[0 * 33], s[1 * 33]); o.y = pk2(s[2 * 33], s[3 * 33]); o.z = pk2(s[4 * 33], s[5 * 33]); o.w = pk2(s[6 * 33], s[7 * 33]);
        *(v4u*)(WT + (size_t)(n0 + n) * K + k0 + 8 * c) = o; }
    asm volatile("s_waitcnt lgkmcnt(0)" ::: "memory");
}
struct Args { const float* in[22]; float* out; unsigned char* ws; int ph_lo, ph_hi; };

__global__ void __launch_bounds__(NTHREADS, 2) fwd_kernel(Args a) {
    extern __shared__ __attribute__((aligned(16))) unsigned char lds[];
#define PTRS() \
    int tid_ = threadIdx.x; asm volatile("" : "+v"(tid_)); const int tid = tid_, lane = tid & 63, wave = __builtin_amdgcn_readfirstlane(tid >> 6); \
    int bx = blockIdx.x, G = gridDim.x; asm volatile("" : "+s"(bx), "+s"(G)); const int vcu = (G % 8 == 0) ? (bx % 8) * (G / 8) + bx / 8 : bx; (void)vcu; (void)tid; \
    const int gw = bx * NWAVES + wave, NGW = G * NWAVES; (void)gw; (void)NGW; (void)lane; \
    unsigned char* ws = a.ws; asm volatile("" : "+s"(ws)); \
    float* const modv = (float*)(ws + WS_MOD); float* const cosT = (float*)(ws + WS_COS); float* const sinT = (float*)(ws + WS_SIN); float* const xctx = (float*)(ws + WS_CTX); \
    bf16* const Wb = (bf16*)(ws + WS_W); bf16* const H = (bf16*)(ws + WS_H); bf16* const Qb = (bf16*)(ws + WS_Q); bf16* const Kb = (bf16*)(ws + WS_K); bf16* const Vb = (bf16*)(ws + WS_V); \
    bf16* const ZA = (bf16*)(ws + WS_ZA); bf16* const ZB = (bf16*)(ws + WS_ZB); bf16* const ZC = (bf16*)(ws + WS_ZC); float* const ZF = (float*)(ws + WS_ZF); \
    bf16* const PCONV = (bf16*)(ws + WS_P + P_CONV); bf16* const PSG = (bf16*)(ws + WS_P + P_SG); bf16* const PG = (bf16*)(ws + WS_P + P_G); bf16* const HFF = (bf16*)(ws + WS_P); \
    bf16* const Zb = H; float* const xlat = a.out; LAS unsigned char* const ldsl = (LAS unsigned char*)lds; \
    (void)modv; (void)cosT; (void)sinT; (void)xctx; (void)Wb; (void)Qb; (void)Kb; (void)Vb; (void)ZA; (void)ZB; (void)ZC; (void)ZF; (void)PCONV; (void)PSG; (void)PG; (void)HFF; (void)Zb; (void)xlat; (void)ldsl; \
    const int l = (ph - 1) >> 3; const bool last = (l == DEPTH - 1); const float* const modl = modv + (size_t)l * 3 * NMODW; const int Mrows = last ? ML : MT; (void)modl; (void)Mrows; (void)last;

#define CONVERT_WEIGHTS(l) do { \
        LAS float* scr = (LAS float*)ldsl + wave * (64 * 33); \
        for (int it = gw; it < 7808; it += NGW) { int r = it; \
            if (r < 2560) { transpose_item<1>(a.in[7] + (size_t)(l) * 1024 * INW, nullptr, 1024, INW, Wb + WO_IN, scr, r, 160, lane); continue; } r -= 2560; \
            if (r < 128) { transpose_item<0>(a.in[14] + (size_t)(l) * 256 * 1024, nullptr, 256, 1024, Wb + WO_A, scr, r, 32, lane); continue; } r -= 128; \
            if (r < 256) { transpose_item<0>(a.in[15] + (size_t)(l) * 512 * 1024, nullptr, 512, 1024, Wb + WO_B, scr, r, 32, lane); continue; } r -= 256; \
            if (r < 128) { transpose_item<0>(a.in[16] + (size_t)(l) * 256 * 1024, nullptr, 256, 1024, Wb + WO_C, scr, r, 32, lane); continue; } r -= 128; \
            if (r < 512) { transpose_item<0>(a.in[17] + (size_t)(l) * 1024 * 1024, nullptr, 1024, 1024, Wb + WO_O, scr, r, 32, lane); continue; } r -= 512; \
            if (r < 2816) { transpose_item<2>(a.in[19] + (size_t)(l) * 1024 * DFF, a.in[20] + (size_t)(l) * 1024 * DFF, 1024, DFF, Wb + WO_13, scr, r, 176, lane); continue; } r -= 2816; \
            transpose_item<0>(a.in[21] + (size_t)(l) * DFF * 1024, nullptr, DFF, 1024, Wb + WO_2, scr, r, 32, lane); } \
        __syncthreads(); } while (0)

#define NORM_ROWS(normw, modl, shidx, scidx, nrows) do { \
        for (int r = gw; r < (nrows); r += NGW) { const bool latent = r < ML; const float* xrow = latent ? xlat + (size_t)r * 1024 : xctx + (size_t)(r - ML) * 1024; \
            const int src = latent ? (r >> 13) : 2; const float* shp = (modl) + src * NMODW + (shidx) * 1024; const float* scp = (modl) + src * NMODW + (scidx) * 1024; \
            f32x4 v[4]; float ss = 0.f; \
            _Pragma("unroll") for (int j = 0; j < 4; ++j) { v[j] = *((const f32x4*)xrow + lane + 64 * j); ss += (v[j][0] * v[j][0] + v[j][1] * v[j][1]) + (v[j][2] * v[j][2] + v[j][3] * v[j][3]); } \
            const float rinv = 1.0f / sqrtf(wave_sum(ss) * (1.0f / 1024.0f) + 1e-6f); \
            _Pragma("unroll") for (int j = 0; j < 4; ++j) { const f32x4 gg = *((const f32x4*)(normw) + lane + 64 * j), s4 = *((const f32x4*)scp + lane + 64 * j), h4 = *((const f32x4*)shp + lane + 64 * j); \
                const f32x4 o = v[j] * rinv * gg * (s4 + 1.0f) + h4; v2u w; w.x = pk2(o[0], o[1]); w.y = pk2(o[2], o[3]); *((v2u*)(H + (size_t)r * 1024) + lane + 64 * j) = w; } } } while (0)

    for (int ph = a.ph_lo; ph < a.ph_hi; ++ph) {
        if (ph == 0) { PTRS();
            if (bx < 96) {
                LAS float* sil = (LAS float*)ldsl + 8 * 64 * 33; LAS float* red = sil + 3072;
                for (int i = tid; i < 3072; i += NTHREADS) { const int src = i >> 10, k = i & 1023; const float v = src < 2 ? a.in[1][src * 1024 + k] : a.in[3][k]; sil[i] = v / (1.0f + expf(-v)); }
                __syncthreads();
                const int j0 = bx * 256, l = j0 / NMODW, jj = j0 % NMODW;
                const float* Wm = a.in[4] + (size_t)l * 1024 * NMODW + jj + 4 * lane;
                f32x4 a0 = {0.f, 0.f, 0.f, 0.f}, a1 = a0, a2 = a0;
#pragma unroll 8
                for (int k = wave * 128; k < wave * 128 + 128; ++k) { const f32x4 w = *(const f32x4*)(Wm + (size_t)k * NMODW); a0 += w * sil[k]; a1 += w * sil[1024 + k]; a2 += w * sil[2048 + k]; }
#pragma unroll
                for (int j = 0; j < 4; ++j) { red[(wave * 3 + 0) * 256 + 4 * lane + j] = a0[j]; red[(wave * 3 + 1) * 256 + 4 * lane + j] = a1[j]; red[(wave * 3 + 2) * 256 + 4 * lane + j] = a2[j]; }
                __syncthreads();
                for (int i = tid; i < 768; i += NTHREADS) { const int src = i >> 8, ci = i & 255; float s = a.in[5][l * NMODW + jj + ci];
#pragma unroll
                    for (int w = 0; w < 8; ++w) s += red[(w * 3 + src) * 256 + ci];
                    modv[(l * 3 + src) * NMODW + jj + ci] = s; }
                __syncthreads();
            }
            CONVERT_WEIGHTS(0);
            { const int gt = bx * NTHREADS + tid, NT_ = G * NTHREADS;
              const f32x4* x4 = (const f32x4*)a.in[0]; f32x4* o4 = (f32x4*)xlat;
              for (int i = gt; i < ML * 1024 / 4; i += NT_) o4[i] = x4[i];
              const f32x4* c4 = (const f32x4*)a.in[2]; f32x4* oc4 = (f32x4*)xctx;
              for (int i = gt; i < MC * 1024 / 4; i += NT_) oc4[i] = c4[i];
              for (int i = gt; i < 8192 * 32; i += NT_) { const int t = i >> 5, ax = (i >> 4) & 1, f = i & 15; const float pos = (float)(ax ? (t & 63) : (t >> 6));
                  const float invf = powf(10000.0f, -(float)(2 * f) / 32.0f); const float ang = pos * invf; cosT[i] = cosf(ang); sinT[i] = sinf(ang); } }
        } else {
            const int s = (ph - 1) & 7;
            if (s == 0) { PTRS();
                if (l > 0) CONVERT_WEIGHTS(l);
                NORM_ROWS(a.in[6] + l * 1024, modl, 0, 1, MT);
            } else if (s == 1) { PTRS();
                pg8::Gemm g{H, Wb + WO_IN, MT, INW, 1024}; pg8::StaticOrder S; S.init(MT, INW, G, bx);
                pg8::EpiInProj E{PCONV, Qb, Kb, Vb, PSG, PG, a.in[8] + l * 64, a.in[9] + l * 64, cosT, sinT};
                pg8::gemm_phase<pg8::EpiInProj, pg8::StaticOrder, true, true>(ldsl, g, S, E);
            } else if (s == 2) { PTRS();
                const int upb = (512 + G - 1) / G;
                for (int i = 0; i < upb; ++i) { const int uid = vcu * upb + i; if (uid >= 512) break;
                    const int bhk = uid >> 7, rem = uid & 127, hg = rem >> 5, qb = rem & 31, b = bhk >> 1, h = (bhk & 1) * 4 + hg;
                    attn_body::attn_unit<8>((long)b * 8192 + qb * 256, h, (long)b * 8448, 132, (const attn_body::bf16*)Qb, (const attn_body::bf16*)Kb, (const attn_body::bf16*)Vb, (attn_body::bf16*)ZB, (char*)lds); }
                if (!last) for (int uid = vcu; uid < 16; uid += G) { const int b = uid >> 3, h = uid & 7;
                    attn_body::attn_unit<8>((long)ML + b * 256, h, (long)b * 8448 + 8192, 4, (const attn_body::bf16*)Qb, (const attn_body::bf16*)Kb, (const attn_body::bf16*)Vb, (attn_body::bf16*)ZB, (char*)lds); }
                __syncthreads();
                { const float* cw = a.in[10] + l * 768 + 4 * lane; const f32x4 w0 = *(const f32x4*)cw, w1 = *(const f32x4*)(cw + 256), w2 = *(const f32x4*)(cw + 512);
                  for (int r = gw; r < Mrows; r += NGW) { const bool latent = r < ML; const int pos = latent ? (r & 8191) : ((r - ML) & 255), len = latent ? 8192 : 256;
                      const bf16* p = PCONV + (size_t)r * 768 + 4 * lane;
                      const v2u ab = *(const v2u*)p, c0 = *(const v2u*)(p + 256), x0 = *(const v2u*)(p + 512);
                      v2u cm = {0u, 0u}, xm = cm, cp = cm, xp = cm;
                      if (pos > 0) { cm = *(const v2u*)(p - 768 + 256); xm = *(const v2u*)(p - 768 + 512); }
                      if (pos < len - 1) { cp = *(const v2u*)(p + 768 + 256); xp = *(const v2u*)(p + 768 + 512); }
                      const f32x4 pm = {bflo(cm.x) * bflo(xm.x), bfhi(cm.x) * bfhi(xm.x), bflo(cm.y) * bflo(xm.y), bfhi(cm.y) * bfhi(xm.y)};
                      const f32x4 p0 = {bflo(c0.x) * bflo(x0.x), bfhi(c0.x) * bfhi(x0.x), bflo(c0.y) * bflo(x0.y), bfhi(c0.y) * bfhi(x0.y)};
                      const f32x4 pp = {bflo(cp.x) * bflo(xp.x), bfhi(cp.x) * bfhi(xp.x), bflo(cp.y) * bflo(xp.y), bfhi(cp.y) * bfhi(xp.y)};
                      const f32x4 av = {bflo(ab.x), bfhi(ab.x), bflo(ab.y), bfhi(ab.y)};
                      const f32x4 o = av * (w0 * pm + w1 * p0 + w2 * pp);
                      v2u w; w.x = pk2(o[0], o[1]); w.y = pk2(o[2], o[3]); *(v2u*)(ZA + (size_t)r * 256 + 4 * lane) = w; } }
                { LAS float* Wl = (LAS float*)ldsl; LAS float* Vl = Wl + 128 * 129;
                  const int nitems = (Mrows / 128) * 4;
                  for (int item = bx; item < nitems; item += G) { const int chunk = item >> 2, g = item & 3, rb = chunk * 128;
                      for (int i = 0; i < 16; ++i) { const int srow = 16 * wave + i; const v2u raw = *(const v2u*)(PSG + (size_t)(rb + srow) * 512 + 256 + 4 * lane);
                          const f32x4 f = {bflo(raw.x), bfhi(raw.x), bflo(raw.y), bfhi(raw.y)};
                          const float ss = wave_sum((f[0] * f[0] + f[1] * f[1]) + (f[2] * f[2] + f[3] * f[3])); const float rinv = 1.0f / sqrtf(ss * (1.0f / 256.0f) + 1e-6f);
                          if ((lane >> 4) == g) { const int d = 4 * (lane & 15); const f32x4 gn = *(const f32x4*)(a.in[11] + l * 256 + g * 64 + d);
                              *(LAS f32x4*)(Vl + srow * 64 + d) = f * rinv * gn; } }
                      const float* Wg = a.in[12] + (size_t)(l * 4 + g) * 128 * 128;
#pragma unroll
                      for (int i = 0; i < 8; ++i) { const int idx = tid * 4 + i * 2048, t = idx >> 7, s0 = idx & 127; const f32x4 w = *(const f32x4*)(Wg + idx);
                          Wl[t * 129 + s0] = w[0]; Wl[t * 129 + s0 + 1] = w[1]; Wl[t * 129 + s0 + 2] = w[2]; Wl[t * 129 + s0 + 3] = w[3]; }
                      __syncthreads();
                      const int t = tid >> 2, dq = tid & 3;
                      f32x4 ac[4]; ac[0] = (f32x4){0.f, 0.f, 0.f, 0.f}; ac[1] = ac[0]; ac[2] = ac[0]; ac[3] = ac[0];
#pragma unroll 4
                      for (int s2 = 0; s2 < 128; ++s2) { const float w = Wl[t * 129 + s2];
#pragma unroll
                          for (int q = 0; q < 4; ++q) ac[q] += w * *(const LAS f32x4*)(Vl + s2 * 64 + dq * 16 + 4 * q); }
                      const float bias = a.in[13][(l * 4 + g) * 128 + t];
                      const size_t row = (size_t)(rb + t);
                      const v4u u0 = *(const v4u*)(PSG + row * 512 + g * 64 + dq * 16), u1 = *(const v4u*)(PSG + row * 512 + g * 64 + dq * 16 + 8);
                      v4u o0, o1;
                      o0.x = pk2(bflo(u0.x) * (ac[0][0] + bias), bfhi(u0.x) * (ac[0][1] + bias)); o0.y = pk2(bflo(u0.y) * (ac[0][2] + bias), bfhi(u0.y) * (ac[0][3] + bias));
                      o0.z = pk2(bflo(u0.z) * (ac[1][0] + bias), bfhi(u0.z) * (ac[1][1] + bias)); o0.w = pk2(bflo(u0.w) * (ac[1][2] + bias), bfhi(u0.w) * (ac[1][3] + bias));
                      o1.x = pk2(bflo(u1.x) * (ac[2][0] + bias), bfhi(u1.x) * (ac[2][1] + bias)); o1.y = pk2(bflo(u1.y) * (ac[2][2] + bias), bfhi(u1.y) * (ac[2][3] + bias));
                      o1.z = pk2(bflo(u1.z) * (ac[3][0] + bias), bfhi(u1.z) * (ac[3][1] + bias)); o1.w = pk2(bflo(u1.w) * (ac[3][2] + bias), bfhi(u1.w) * (ac[3][3] + bias));
                      *(v4u*)(ZC + row * 256 + g * 64 + dq * 16) = o0; *(v4u*)(ZC + row * 256 + g * 64 + dq * 16 + 8) = o1;
                      __syncthreads(); } }
            } else if (s == 3) { PTRS();
                pg8::StaticOrder S; S.init(Mrows, 1024, G, bx);
                { pg8::Gemm g{ZA, Wb + WO_A, Mrows, 1024, 256}; pg8::EpiMerge<0> E{PG, 0, ZF, Zb}; pg8::gemm_phase<pg8::EpiMerge<0>, pg8::StaticOrder, true, true>(ldsl, g, S, E); }
                { pg8::Gemm g{ZB, Wb + WO_B, Mrows, 1024, 512}; pg8::EpiMerge<1> E{PG, 1024, ZF, Zb}; pg8::gemm_phase<pg8::EpiMerge<1>, pg8::StaticOrder, true, true>(ldsl, g, S, E); }
                { pg8::Gemm g{ZC, Wb + WO_C, Mrows, 1024, 256}; pg8::EpiMerge<2> E{PG, 2048, ZF, Zb}; pg8::gemm_phase<pg8::EpiMerge<2>, pg8::StaticOrder, true, true>(ldsl, g, S, E); }
            } else if (s == 4) { PTRS();
                pg8::Gemm g{Zb, Wb + WO_O, Mrows, 1024, 1024}; pg8::StaticOrder S; S.init(Mrows, 1024, G, bx);
                pg8::EpiResid E{xlat, xctx, modl, 2}; pg8::gemm_phase<pg8::EpiResid, pg8::StaticOrder, true, true>(ldsl, g, S, E);
            } else if (s == 5) { PTRS();
                NORM_ROWS(a.in[18] + l * 1024, modl, 3, 4, Mrows);
            } else if (s == 6) { PTRS();
                pg8::Gemm g{H, Wb + WO_13, Mrows, 2 * DFF, 1024}; pg8::StaticOrder S; S.init(Mrows, 2 * DFF, G, bx);
                pg8::EpiSwiGLU E{HFF}; pg8::gemm_phase<pg8::EpiSwiGLU, pg8::StaticOrder, true, true>(ldsl, g, S, E);
            } else { PTRS();
                pg8::Gemm g{HFF, Wb + WO_2, Mrows, 1024, DFF}; pg8::StaticOrder S; S.init(Mrows, 1024, G, bx);
                pg8::EpiResid E{xlat, xctx, modl, 5}; pg8::gemm_phase<pg8::EpiResid, pg8::StaticOrder, true, true>(ldsl, g, S, E);
            }
        }
        if (ph + 1 < a.ph_hi) { asm volatile("s_waitcnt vmcnt(0)" ::: "memory"); cg::this_grid().sync(); }
    }
}

extern "C" void kernel_launch(void* const* d_in, const int* in_sizes, int n_in, void* d_out, int out_size, void* d_ws, size_t ws_size, hipStream_t stream) {
    static int grid = 0;
    if (grid == 0) {
        if (n_in != 22 || ws_size < WS_END) { fprintf(stderr, "kernel_launch: unexpected n_in %d / ws %zu (need %zu)\n", n_in, ws_size, (size_t)WS_END); grid = -1; return; }
        int dev = 0, cus = 0, per_cu = 0;
        (void)hipGetDevice(&dev); (void)hipDeviceGetAttribute(&cus, hipDeviceAttributeMultiprocessorCount, dev);
        if (hipFuncSetAttribute((const void*)fwd_kernel, hipFuncAttributeMaxDynamicSharedMemorySize, LDS_BYTES) != hipSuccess) { fprintf(stderr, "kernel_launch: hipFuncSetAttribute failed\n"); grid = -1; return; }
        if (hipOccupancyMaxActiveBlocksPerMultiprocessor(&per_cu, (const void*)fwd_kernel, NTHREADS, LDS_BYTES) != hipSuccess || per_cu < 1) { (void)hipGetLastError(); per_cu = 1; }
        grid = cus * per_cu; if (grid <= 0) grid = 256;
    }
    if (grid < 0) return;
    Args a{};
    for (int i = 0; i < 22; ++i) a.in[i] = (const float*)d_in[i];
    a.out = (float*)d_out; a.ws = (unsigned char*)d_ws;
#if MK_MULTI
    for (int ph = 0; ph < NPHASE; ++ph) { a.ph_lo = ph; a.ph_hi = ph + 1; hipLaunchKernelGGL(fwd_kernel, dim3(grid), dim3(NTHREADS), LDS_BYTES, stream, a); }
#else
    a.ph_lo = 0; a.ph_hi = NPHASE;
    void* args[] = {&a};
    hipError_t e = hipLaunchCooperativeKernel((const void*)fwd_kernel, dim3(grid), dim3(NTHREADS), args, LDS_BYTES, stream);
    if (e != hipSuccess) fprintf(stderr, "cooperative launch failed: %s (grid %d)\n", hipGetErrorString(e), grid);
#endif
}
```

```cpp
#include <hip/hip_runtime.h>
#include <hip/hip_cooperative_groups.h>
#include <hip/hip_bf16.h>
#include <cstdio>
#include <cstdint>
#include <cmath>
namespace cg = cooperative_groups;

namespace pg8 {
#define PG8_LAS __attribute__((address_space(3)))
typedef unsigned short bf16_t;
typedef short bf16x8 __attribute__((ext_vector_type(8)));
typedef float f32x4 __attribute__((ext_vector_type(4)));
typedef unsigned u32x4 __attribute__((ext_vector_type(4)));
constexpr int BM = 256, BK = 64, HALF = 128, HTB = HALF * BK * 2  , STAGE_BYTES = 8 * HTB, NXCD = 8, WGM = 8;

__host__ __device__ __forceinline__ int lds_byte(int r, int c) { const int st = (r >> 4) * 2 + (c >> 5), rr = r & 15, cc = c & 31, ob = rr * 64 + cc * 2; return st * 1024 + (ob ^ (((ob >> 9) & 1) << 5)); }
__host__ __device__ __forceinline__ void stage_rc(int b, int& R, int& C) { const int st = b / 1024, sb = b % 1024, swz = sb ^ (((sb >> 9) & 1) << 5); R = (st >> 1) * 16 + swz / 64; C = (st & 1) * 32 + (swz % 64) / 2; }
__host__ __device__ __forceinline__ int perm32(int rho) { const int n = rho >> 4, i = rho & 15; return 8 * (i >> 2) + 4 * n + (i & 3); }

struct Unit { int pm, pn; };
struct Gemm { const bf16_t* A; const bf16_t* Bt; int M, N, K; };

struct StaticOrder {
    int nM, nN, nwg, G, c;
    __host__ __device__ void init(int M, int N, int G_, int c_) { nM = M / BM; nN = N / BM; nwg = nM * nN; G = G_; c = c_; }
    __host__ __device__ bool next(int i, Unit& u) const {
        const long L = (long)i * G + c; if (L >= nwg) return false;
        int wgid = (int)L; { const int q = nwg / NXCD, r = nwg % NXCD, xcd = wgid % NXCD, off = wgid / NXCD; wgid = (xcd < r ? xcd * (q + 1) : r * (q + 1) + (xcd - r) * q) + off; }
        const int nig = WGM * nN, gid = wgid / nig, fm = gid * WGM, gsz = (nM - fm) < WGM ? (nM - fm) : WGM;
        u.pm = fm + ((wgid % nig) % gsz); u.pn = (wgid % nig) / gsz; return true;
    }
    __device__ __forceinline__ void a_ready(const Unit&) const {}
    __device__ __forceinline__ void done(const Unit&) const {}
};

__device__ __forceinline__ unsigned cvt_pk_bf16(float lo, float hi) { unsigned r; asm volatile("v_cvt_pk_bf16_f32 %0, %1, %2" : "=v"(r) : "v"(lo), "v"(hi)); return r; }
typedef float f32x2 __attribute__((ext_vector_type(2)));
__device__ __forceinline__ float bf_lo(unsigned w) { return __uint_as_float(w << 16); }
__device__ __forceinline__ float bf_hi(unsigned w) { return __uint_as_float(w & 0xffff0000u); }
__device__ __forceinline__ float sigmoid_f(float x) { return __builtin_amdgcn_rcpf(1.0f + __builtin_amdgcn_exp2f(-1.4426950408889634f * x)); }
__device__ __forceinline__ float gelu_tanh_f(float x) { const float in2 = 1.5957691216057308f * (x + 0.044715f * x * x * x); return x * sigmoid_f(in2); }
__device__ __forceinline__ f32x4 act4(f32x4 v, int act) {
    if (act == 1) return (f32x4){gelu_tanh_f(v[0]), gelu_tanh_f(v[1]), gelu_tanh_f(v[2]), gelu_tanh_f(v[3])};
    if (act == 2) return (f32x4){sigmoid_f(v[0]), sigmoid_f(v[1]), sigmoid_f(v[2]), sigmoid_f(v[3])};
    return v;
}
constexpr float ATT_C2 = 0.125f * 1.4426950408889634f;
typedef unsigned u32x2 __attribute__((ext_vector_type(2)));
#define GAS __attribute__((address_space(1)))
struct EpiInProj {
    static constexpr bool PERM = true, AFTER_DRAIN = false;
    GAS bf16_t *PCONV, *Q, *Kb, *Vb, *PSG, *PG; const GAS float *qg, *kg, *cosT, *sinT;
    __device__ __forceinline__ void operator()(const f32x4 (&acc)[2][2][4][2], const Unit& u, int wr, int wc, int fr, int fq) const {
        const int row0 = u.pm * BM + wr * 64 + fr, pn = u.pn;
        if (pn >= 3 && pn < 6) {
            const bool isq = pn < 5, isv = (pn == 5) && (wc >= 2), latent = u.pm < 64;
            const GAS float* gp = isq ? qg : kg;
            f32x4 gn[2][2];
#pragma unroll
            for (int bj = 0; bj < 2; ++bj)
#pragma unroll
                for (int n = 0; n < 2; ++n) gn[bj][n] = *(const GAS f32x4*)(gp + 32 * bj + 16 * n + 4 * fq);
#pragma unroll
            for (int ai = 0; ai < 2; ++ai)
#pragma unroll
                for (int m = 0; m < 4; ++m) {
                    const int row = row0 + ai * HALF + m * 16;
                    f32x4 v[2][2];
#pragma unroll
                    for (int bj = 0; bj < 2; ++bj)
#pragma unroll
                        for (int n = 0; n < 2; ++n) v[bj][n] = acc[ai][bj][m][n];
                    if (!isv) {
                        float ss = 0.f;
#pragma unroll
                        for (int bj = 0; bj < 2; ++bj)
#pragma unroll
                            for (int n = 0; n < 2; ++n) { const f32x4 x = v[bj][n]; ss += (x[0] * x[0] + x[1] * x[1]) + (x[2] * x[2] + x[3] * x[3]); }
                        ss += __shfl_xor(ss, 16); ss += __shfl_xor(ss, 32);
                        const float r = (1.0f / sqrtf(ss * (1.0f / 64.0f) + 1e-6f)) * (isq ? ATT_C2 : 1.0f);
#pragma unroll
                        for (int bj = 0; bj < 2; ++bj)
#pragma unroll
                            for (int n = 0; n < 2; ++n) v[bj][n] = v[bj][n] * gn[bj][n] * r;
                        if (latent) {
                            const int t = row & 8191;
#pragma unroll
                            for (int bj = 0; bj < 2; ++bj) {
                                const f32x4 c = *(const GAS f32x4*)(cosT + t * 32 + bj * 16 + 4 * fq), s = *(const GAS f32x4*)(sinT + t * 32 + bj * 16 + 4 * fq);
                                const f32x4 x1 = v[bj][0], x2 = v[bj][1];
                                v[bj][0] = x1 * c - x2 * s; v[bj][1] = x2 * c + x1 * s;
                            }
                        }
                    }
                    GAS bf16_t* dst;
                    if (isq) dst = Q + (size_t)row * 512 + (pn - 3) * 256 + wc * 64;
                    else {
                        const int rc = row - 16384;
                        const size_t kvrow = latent ? (size_t)((row >> 13) * 8448 + (row & 8191)) : (size_t)((rc >> 8) * 8448 + 8192 + (rc & 255));
                        dst = isv ? Vb + kvrow * 128 + (wc - 2) * 64 : Kb + kvrow * 128 + wc * 64;
                    }
#pragma unroll
                    for (int bj = 0; bj < 2; ++bj)
#pragma unroll
                        for (int n = 0; n < 2; ++n) { u32x2 w; w.x = cvt_pk_bf16(v[bj][n][0], v[bj][n][1]); w.y = cvt_pk_bf16(v[bj][n][2], v[bj][n][3]);
                            *(GAS u32x2*)(dst + 32 * bj + 16 * n + 4 * fq) = w; }
                }
        } else {
            GAS bf16_t* base; int ld, colt, act;
            if (pn < 3) { base = PCONV; ld = 768; colt = pn * 256; act = 0; }
            else if (pn < 8) { base = PSG; ld = 512; colt = (pn - 6) * 256; act = 1; }
            else { base = PG; ld = 3072; colt = (pn - 8) * 256; act = 2; }
            const int col0 = colt + wc * 32 + 8 * fq;
#pragma unroll
            for (int ai = 0; ai < 2; ++ai)
#pragma unroll
                for (int m = 0; m < 4; ++m) { GAS bf16_t* rowp = base + (size_t)(row0 + ai * HALF + m * 16) * ld + col0;
#pragma unroll
                    for (int bj = 0; bj < 2; ++bj) { const f32x4 v0 = act4(acc[ai][bj][m][0], act), v1 = act4(acc[ai][bj][m][1], act);
                        u32x4 w; w.x = cvt_pk_bf16(v0[0], v0[1]); w.y = cvt_pk_bf16(v0[2], v0[3]); w.z = cvt_pk_bf16(v1[0], v1[1]); w.w = cvt_pk_bf16(v1[2], v1[3]);
                        *(GAS u32x4*)(rowp + bj * HALF) = w; } }
        }
    }
};
template <int MODE> struct EpiMerge {
    static constexpr bool PERM = true, AFTER_DRAIN = false;
    const GAS bf16_t* PG; int goff; GAS float* zf; GAS bf16_t* z;
    __device__ __forceinline__ void operator()(const f32x4 (&acc)[2][2][4][2], const Unit& u, int wr, int wc, int fr, int fq) const {
        const int row0 = u.pm * BM + wr * 64 + fr, col0 = u.pn * BM + wc * 32 + 8 * fq;
#pragma unroll
        for (int ai = 0; ai < 2; ++ai)
#pragma unroll
            for (int m = 0; m < 4; ++m) { const size_t row = (size_t)(row0 + ai * HALF + m * 16);
#pragma unroll
                for (int bj = 0; bj < 2; ++bj) { const int col = col0 + bj * HALF;
                    const u32x4 gw = *(const GAS u32x4*)(PG + row * 3072 + goff + col);
                    f32x4 v0 = acc[ai][bj][m][0] * (f32x4){bf_lo(gw.x), bf_hi(gw.x), bf_lo(gw.y), bf_hi(gw.y)};
                    f32x4 v1 = acc[ai][bj][m][1] * (f32x4){bf_lo(gw.z), bf_hi(gw.z), bf_lo(gw.w), bf_hi(gw.w)};
                    GAS float* zp = zf + row * 1024 + col;
                    if (MODE >= 1) { v0 = v0 + *(const GAS f32x4*)zp; v1 = v1 + *(const GAS f32x4*)(zp + 4); }
                    if (MODE <= 1) { *(GAS f32x4*)zp = v0; *(GAS f32x4*)(zp + 4) = v1; }
                    else { u32x4 w; w.x = cvt_pk_bf16(v0[0], v0[1]); w.y = cvt_pk_bf16(v0[2], v0[3]); w.z = cvt_pk_bf16(v1[0], v1[1]); w.w = cvt_pk_bf16(v1[2], v1[3]);
                        *(GAS u32x4*)(z + row * 1024 + col) = w; } } }
    }
};
struct EpiResid {
    static constexpr bool PERM = false, AFTER_DRAIN = false;
    GAS float* xlat; GAS float* xctx; const GAS float* modl; int gidx;
    __device__ __forceinline__ void operator()(const f32x4 (&acc)[2][2][4][2], const Unit& u, int wr, int wc, int fr, int fq) const {
        const int row0 = u.pm * BM + wr * 64 + fr, col0 = u.pn * BM + wc * 32 + 4 * fq;
        const bool latent = u.pm < 64; const int src = latent ? (u.pm >> 5) : 2;
        f32x4 gt[2][2];
#pragma unroll
        for (int bj = 0; bj < 2; ++bj)
#pragma unroll
            for (int n = 0; n < 2; ++n) gt[bj][n] = *(const GAS f32x4*)(modl + src * 6144 + gidx * 1024 + col0 + bj * HALF + n * 16);
#pragma unroll
        for (int ai = 0; ai < 2; ++ai)
#pragma unroll
            for (int m = 0; m < 4; ++m) { const int row = row0 + ai * HALF + m * 16;
                GAS float* xp = (latent ? xlat + (size_t)row * 1024 : xctx + (size_t)(row - 16384) * 1024) + col0;
#pragma unroll
                for (int bj = 0; bj < 2; ++bj)
#pragma unroll
                    for (int n = 0; n < 2; ++n) { GAS float* p = xp + bj * HALF + n * 16; *(GAS f32x4*)p = *(const GAS f32x4*)p + gt[bj][n] * acc[ai][bj][m][n]; } }
    }
};
struct EpiSwiGLU {
    static constexpr bool PERM = true, AFTER_DRAIN = false;
    GAS bf16_t* HFF;
    __device__ __forceinline__ void operator()(const f32x4 (&acc)[2][2][4][2], const Unit& u, int wr, int wc, int fr, int fq) const {
        const int row0 = u.pm * BM + wr * 64 + fr, col0 = u.pn * HALF + wc * 32 + 8 * fq;
#pragma unroll
        for (int ai = 0; ai < 2; ++ai)
#pragma unroll
            for (int m = 0; m < 4; ++m) { const size_t row = (size_t)(row0 + ai * HALF + m * 16);
                const f32x4 a0 = acc[ai][0][m][0], a1 = acc[ai][0][m][1], b0 = acc[ai][1][m][0], b1 = acc[ai][1][m][1];
                f32x4 h0, h1;
#pragma unroll
                for (int j = 0; j < 4; ++j) { h0[j] = a0[j] * sigmoid_f(a0[j]) * b0[j]; h1[j] = a1[j] * sigmoid_f(a1[j]) * b1[j]; }
                u32x4 w; w.x = cvt_pk_bf16(h0[0], h0[1]); w.y = cvt_pk_bf16(h0[2], h0[3]); w.z = cvt_pk_bf16(h1[0], h1[1]); w.w = cvt_pk_bf16(h1[2], h1[3]);
                *(GAS u32x4*)(HFF + row * 2816 + col0) = w; }
    }
};
template <class Epi, class Sched, bool ALIGN_EPI = false, bool SP2 = false>
__device__ __forceinline__ void gemm_phase(PG8_LAS unsigned char* lds, const Gemm g, const Sched& S, const Epi& E) {
    int tid_ = threadIdx.x; asm volatile("" : "+v"(tid_)); const int tid = tid_, wid = __builtin_amdgcn_readfirstlane(tid >> 6), lane = tid & 63, wr = wid >> 2, wc = wid & 3, fr = lane & 15, fq = lane >> 4;
    int K_ = g.K; asm volatile("" : "+s"(K_)); const int K = K_, nt = K / BK;
    unsigned voffA[2], voffB[2];
#pragma unroll
    for (int i = 0; i < 2; ++i) { int R, C; stage_rc(tid * 16 + i * 8192, R, C); const int Rb = Epi::PERM ? ((R & ~31) + perm32(R & 31)) : R;
        voffA[i] = (unsigned)(R * K + C) * 2u; voffB[i] = (unsigned)(Rb * K + C) * 2u; }
    const size_t kstep = (size_t)(BK * 2);
    const size_t hstep = (size_t)HALF * K * 2;
    const size_t tstep = 2 * hstep;
    const unsigned ldsw = (unsigned)wid * 1024u;
    const int aoff = lds_byte(wr * 64 + fr, fq * 8), boff = lds_byte(wc * 32 + fr, fq * 8);
#define PG8_SA(b, h) (((b) * 2 + (h)) * HTB)
#define PG8_SB(b, h) ((4 + (b) * 2 + (h)) * HTB)
#define PG8_STAGE(bufoff, gbase, voff) do { _Pragma("unroll") for (int _i = 0; _i < 2; ++_i) \
        __builtin_amdgcn_global_load_lds((const unsigned*)((const char*)(gbase) + (voff)[_i]), (PG8_LAS unsigned*)(lds + (bufoff) + ldsw + _i * 8192), 16, 0, 0); } while (0)
#define PG8_LDA(dst, b, h) do { _Pragma("unroll") for (int m = 0; m < 4; ++m) _Pragma("unroll") for (int k = 0; k < 2; ++k) dst[m][k] = *(const PG8_LAS bf16x8*)(lds + PG8_SA(b, h) + aoff + m * 2048 + k * 1024); } while (0)
#define PG8_LDB(dst, b, h) do { _Pragma("unroll") for (int n = 0; n < 2; ++n) _Pragma("unroll") for (int k = 0; k < 2; ++k) dst[n][k] = *(const PG8_LAS bf16x8*)(lds + PG8_SB(b, h) + boff + n * 2048 + k * 1024); } while (0)
#define PG8_MMA(ai, bj, At, Bt) do { __builtin_amdgcn_s_setprio(1); _Pragma("unroll") for (int m = 0; m < 4; ++m) _Pragma("unroll") for (int n = 0; n < 2; ++n) _Pragma("unroll") for (int k = 0; k < 2; ++k) \
        acc[ai][bj][m][n] = __builtin_amdgcn_mfma_f32_16x16x32_bf16(Bt[n][k], At[m][k], acc[ai][bj][m][n], 0, 0, 0); __builtin_amdgcn_s_setprio(0); } while (0)
#define PG8_WAIT_V(n) asm volatile("s_waitcnt vmcnt(" #n ")" ::: "memory")
#define PG8_WAIT_L(n) asm volatile("s_waitcnt lgkmcnt(" #n ")" ::: "memory")
#define PG8_BAR __builtin_amdgcn_s_barrier()
#define PG8_SCHED __builtin_amdgcn_sched_barrier(0)
    Unit cur, nxt; int ui = 0;
    if (!S.next(0, cur)) return;
    f32x4 acc[2][2][4][2];
#pragma unroll
    for (int a = 0; a < 2; ++a)
#pragma unroll
        for (int b = 0; b < 2; ++b)
#pragma unroll
            for (int m = 0; m < 4; ++m)
#pragma unroll
                for (int n = 0; n < 2; ++n) acc[a][b][m][n] = (f32x4){0.f, 0.f, 0.f, 0.f};
    bf16x8 At[4][2], B0[2][2], B1[2][2];
    const char* cA = (const char*)g.A + (size_t)cur.pm * tstep; const char* cB = (const char*)g.Bt + (size_t)cur.pn * tstep;
    S.a_ready(cur);
    if constexpr (SP2) {
        PG8_STAGE(PG8_SB(0, 0), cB, voffB); PG8_STAGE(PG8_SB(0, 1), cB + hstep, voffB); PG8_STAGE(PG8_SA(0, 0), cA, voffA); PG8_STAGE(PG8_SA(0, 1), cA + hstep, voffA);
        if (wr == 1) PG8_BAR;
        PG8_WAIT_V(2); PG8_BAR;
        PG8_STAGE(PG8_SB(1, 0), cB + kstep, voffB); PG8_STAGE(PG8_SA(1, 0), cA + kstep, voffA); PG8_STAGE(PG8_SB(1, 1), cB + hstep + kstep, voffB);
        PG8_WAIT_V(6); PG8_BAR;
    } else {
        PG8_STAGE(PG8_SB(0, 0), cB, voffB); PG8_STAGE(PG8_SA(0, 0), cA, voffA); PG8_STAGE(PG8_SB(0, 1), cB + hstep, voffB); PG8_STAGE(PG8_SA(0, 1), cA + hstep, voffA);
        if (wr == 1) PG8_BAR;
        PG8_WAIT_V(4); PG8_BAR;
        PG8_STAGE(PG8_SB(1, 0), cB + kstep, voffB); PG8_STAGE(PG8_SA(1, 0), cA + kstep, voffA); PG8_STAGE(PG8_SB(1, 1), cB + hstep + kstep, voffB);
        PG8_WAIT_V(6); PG8_BAR;
    }
    for (;;) {
        const bool has_next = S.next(ui + 1, nxt);
        const char* nA = has_next ? (const char*)g.A + (size_t)nxt.pm * tstep : cA; const char* nB = has_next ? (const char*)g.Bt + (size_t)nxt.pn * tstep : cB;
        for (int t = 0; t < nt; t += 2) {
            const bool last = (t == nt - 2);
            const char* a1 = cA + (size_t)(t + 1) * kstep;
            const char* a2 = last ? nA : cA + (size_t)(t + 2) * kstep; const char* b2 = last ? nB : cB + (size_t)(t + 2) * kstep;
            const char* a3 = a2 + kstep; const char* b3 = b2 + kstep;
            if (last && has_next) S.a_ready(nxt);
            if constexpr (SP2) {
            PG8_LDB(B0, 0, 0); PG8_LDB(B1, 0, 1); PG8_SCHED; PG8_LDA(At, 0, 0); PG8_STAGE(PG8_SA(1, 1), a1 + hstep, voffA);
            PG8_WAIT_V(8); PG8_WAIT_L(0); PG8_BAR; PG8_MMA(0, 0, At, B0); PG8_MMA(0, 1, At, B1); PG8_BAR; PG8_SCHED;
            PG8_LDA(At, 0, 1); PG8_STAGE(PG8_SB(0, 0), b2, voffB); PG8_STAGE(PG8_SB(0, 1), b2 + hstep, voffB); PG8_STAGE(PG8_SA(0, 0), a2, voffA);
            PG8_WAIT_V(8); PG8_WAIT_L(0); PG8_BAR; PG8_MMA(1, 0, At, B0); PG8_MMA(1, 1, At, B1); PG8_BAR; PG8_SCHED;
            PG8_LDB(B0, 1, 0); PG8_LDB(B1, 1, 1); PG8_SCHED; PG8_LDA(At, 1, 0); PG8_STAGE(PG8_SA(0, 1), a2 + hstep, voffA);
            PG8_WAIT_V(8); PG8_WAIT_L(0); PG8_BAR; PG8_MMA(0, 0, At, B0); PG8_MMA(0, 1, At, B1); PG8_BAR; PG8_SCHED;
            PG8_LDA(At, 1, 1); PG8_STAGE(PG8_SB(1, 0), b3, voffB); PG8_STAGE(PG8_SB(1, 1), b3 + hstep, voffB); PG8_STAGE(PG8_SA(1, 0), a3, voffA);
            PG8_WAIT_V(8); PG8_WAIT_L(0); PG8_BAR; PG8_MMA(1, 0, At, B0); PG8_MMA(1, 1, At, B1); PG8_BAR; PG8_SCHED;
            } else {
            PG8_LDB(B0, 0, 0); PG8_SCHED; PG8_LDA(At, 0, 0); PG8_STAGE(PG8_SA(1, 1), a1 + hstep, voffA);
            PG8_WAIT_L(8); PG8_BAR; PG8_WAIT_L(0); PG8_MMA(0, 0, At, B0); PG8_BAR; PG8_SCHED;
            PG8_LDB(B1, 0, 1); PG8_STAGE(PG8_SB(0, 0), b2, voffB);
            PG8_BAR; PG8_WAIT_L(0); PG8_MMA(0, 1, At, B1); PG8_BAR;
            PG8_LDA(At, 0, 1); PG8_STAGE(PG8_SA(0, 0), a2, voffA);
            PG8_BAR; PG8_WAIT_L(0); PG8_MMA(1, 0, At, B0); PG8_BAR; PG8_SCHED;
            PG8_STAGE(PG8_SB(0, 1), b2 + hstep, voffB);
            PG8_WAIT_V(6); PG8_BAR; PG8_MMA(1, 1, At, B1); PG8_BAR;
            PG8_LDB(B0, 1, 0); PG8_SCHED; PG8_LDA(At, 1, 0); PG8_STAGE(PG8_SA(0, 1), a2 + hstep, voffA);
            PG8_WAIT_L(8); PG8_BAR; PG8_WAIT_L(0); PG8_MMA(0, 0, At, B0); PG8_BAR; PG8_SCHED;
            PG8_LDB(B1, 1, 1); PG8_STAGE(PG8_SB(1, 0), b3, voffB);
            PG8_BAR; PG8_WAIT_L(0); PG8_MMA(0, 1, At, B1); PG8_BAR;
            PG8_LDA(At, 1, 1); PG8_STAGE(PG8_SA(1, 0), a3, voffA);
            PG8_BAR; PG8_WAIT_L(0); PG8_MMA(1, 0, At, B0); PG8_BAR; PG8_SCHED;
            PG8_STAGE(PG8_SB(1, 1), b3 + hstep, voffB);
            PG8_WAIT_V(6); PG8_BAR; PG8_MMA(1, 1, At, B1); PG8_BAR;
            }
        }
        if constexpr (ALIGN_EPI) { if (wr == 0) PG8_BAR; }
        if constexpr (!Epi::AFTER_DRAIN) { E(acc, cur, wr, wc, fr, fq); S.done(cur); }
        if (!has_next) break;
#pragma unroll
        for (int a = 0; a < 2; ++a)
#pragma unroll
            for (int b = 0; b < 2; ++b)
#pragma unroll
                for (int m = 0; m < 4; ++m)
#pragma unroll
                    for (int n = 0; n < 2; ++n) acc[a][b][m][n] = (f32x4){0.f, 0.f, 0.f, 0.f};
        cur = nxt; cA = nA; cB = nB; ++ui;
        if constexpr (ALIGN_EPI) { if (wr == 1) PG8_BAR; }
    }
    PG8_WAIT_V(0);
    if constexpr (!ALIGN_EPI) { if (wr == 0) PG8_BAR; }
    PG8_BAR;
    if constexpr (Epi::AFTER_DRAIN) { E.fused(acc, cur, wr, wc, fr, fq, lds, wid, lane); S.done(cur); }
#undef PG8_SA
#undef PG8_SB
#undef PG8_STAGE
#undef PG8_LDA
#undef PG8_LDB
#undef PG8_MMA
#undef PG8_WAIT_V
#undef PG8_WAIT_L
#undef PG8_BAR
#undef PG8_SCHED
}
}
#include <hip/hip_bf16.h>
#include <cmath>
namespace attn_body {
using bf16=__hip_bfloat16;
using bf16x8=__attribute__((ext_vector_type(8)))short;
using s16x4=__attribute__((ext_vector_type(4)))short;
using f32x16=__attribute__((ext_vector_type(16)))float;
using u32x4=__attribute__((ext_vector_type(4)))unsigned;
constexpr int D=64,QP=512,KP=128;
constexpr int NW=8,QBLK=32,QB=QBLK*NW,KVBLK=64;
constexpr int ATTN_UNIT_ROWS=QB;
__device__ __forceinline__ int crow(int r,int hi){return (r&3)+8*(r>>2)+4*hi;}
#define SBAR() __builtin_amdgcn_sched_barrier(0)
__device__ __forceinline__ void cmask(f32x16&p0,f32x16&p1,int jb,int qrel,int hi){
  const float NEG=-INFINITY; int kb=64*jb+4*hi;
  #pragma unroll
  for(int r=0;r<16;++r){int kv=kb+(r&3)+8*(r>>2); if(kv>qrel)p0[r]=NEG; if(kv+32>qrel)p1[r]=NEG;}
}

constexpr int NSLOT=3, SLOTB=8192;
constexpr int LDS_K=0, LDS_V=NSLOT*SLOTB, LDS_WS=2*NSLOT*SLOTB, LDS_OST=LDS_WS+NW*64*4, LDS_BYTES=LDS_OST+NW*4096;
constexpr float C2=0.125f*1.4426950408889634f;
__device__ __forceinline__ void glds16(const void*gsrc,unsigned lds_dst){unsigned keep;
  asm volatile("s_mov_b32 %0, m0\n\ts_mov_b32 m0, %2\n\ts_nop 0\n\tglobal_load_lds_dwordx4 %1, off\n\ts_mov_b32 m0, %0":"=&s"(keep):"v"(gsrc),"s"(lds_dst):"memory");}
__device__ __forceinline__ float max3f(float a,float b,float c){float r;asm("v_max3_f32 %0, %1, %2, %3":"=v"(r):"v"(a),"v"(b),"v"(c));return r;}
__device__ __forceinline__ float max2f(float a,float b){float r;asm("v_max_f32_e32 %0, %1, %2":"=v"(r):"v"(a),"v"(b));return r;}
__device__ __forceinline__ float fadd_s(float a,float b){float r;asm("v_add_f32_e32 %0, %1, %2":"=v"(r):"v"(a),"v"(b));return r;}
__device__ __forceinline__ float fsub_s(float a,float b){float r;asm("v_sub_f32_e32 %0, %1, %2":"=v"(r):"v"(a),"v"(b));return r;}
typedef float f32x2_t __attribute__((ext_vector_type(2))); typedef __bf16 bf16x2_t __attribute__((ext_vector_type(2)));
__device__ __forceinline__ unsigned cvtpk_s(float lo,float hi){f32x2_t v={lo,hi};bf16x2_t b=__builtin_convertvector(v,bf16x2_t);return __builtin_bit_cast(unsigned,b);}
#define WAIT_BAR(N) asm volatile("s_waitcnt vmcnt(" #N ") lgkmcnt(0)\n\ts_barrier":::"memory")

__device__ __forceinline__ void qkt(f32x16&p0,f32x16&p1,const char*Kslot,const bf16x8*qr,const f32x16&negm,int r32,int hi){
  const char*kb=Kslot+hi*1024+r32*16;
  #pragma unroll
  for(int d0=0;d0<4;++d0){
    const bf16x8 b0=*reinterpret_cast<const bf16x8*>(kb+d0*2048);
    const bf16x8 b1=*reinterpret_cast<const bf16x8*>(kb+d0*2048+512);
    if(d0==0){p0=__builtin_amdgcn_mfma_f32_32x32x16_bf16(b0,qr[0],negm,0,0,0);p1=__builtin_amdgcn_mfma_f32_32x32x16_bf16(b1,qr[0],negm,0,0,0);}
    else{p0=__builtin_amdgcn_mfma_f32_32x32x16_bf16(b0,qr[d0],p0,0,0,0);p1=__builtin_amdgcn_mfma_f32_32x32x16_bf16(b1,qr[d0],p1,0,0,0);}}
}
typedef __attribute__((address_space(3))) const char* lds_cptr;
typedef short v4i16_t __attribute__((ext_vector_type(4)));
__device__ __forceinline__ void kload8(bf16x8*kf,lds_cptr kp){
  kf[0]=*(const __attribute__((address_space(3))) bf16x8*)(kp);      kf[1]=*(const __attribute__((address_space(3))) bf16x8*)(kp+512);
  kf[2]=*(const __attribute__((address_space(3))) bf16x8*)(kp+2048); kf[3]=*(const __attribute__((address_space(3))) bf16x8*)(kp+2560);
  kf[4]=*(const __attribute__((address_space(3))) bf16x8*)(kp+4096); kf[5]=*(const __attribute__((address_space(3))) bf16x8*)(kp+4608);
  kf[6]=*(const __attribute__((address_space(3))) bf16x8*)(kp+6144); kf[7]=*(const __attribute__((address_space(3))) bf16x8*)(kp+6656);
}
__device__ __forceinline__ void kload2(bf16x8*kf,lds_cptr kp,int j){ kf[2*j]=*(const __attribute__((address_space(3))) bf16x8*)(kp+j*2048); kf[2*j+1]=*(const __attribute__((address_space(3))) bf16x8*)(kp+j*2048+512); }
__device__ __forceinline__ s16x4 vtr(lds_cptr p){ return __builtin_bit_cast(s16x4,__builtin_amdgcn_ds_read_tr16_b64_v4i16((__attribute__((address_space(3))) v4i16_t*)p)); }
__device__ __forceinline__ float rowmax(const f32x16&p0,const f32x16&p1){
  float a=max3f(p0[0],p0[1],p1[0]),b=max3f(p0[2],p0[3],p1[1]);a=max3f(a,p1[2],p1[3]);
  #pragma unroll
  for(int r=4;r<16;r+=4){a=max3f(a,p0[r],p0[r+1]);b=max3f(b,p0[r+2],p0[r+3]);a=max3f(a,p1[r],p1[r+1]);b=max3f(b,p1[r+2],p1[r+3]);}
  const float m=max2f(a,b);
  auto rr=__builtin_amdgcn_permlane32_swap(__float_as_uint(m),__float_as_uint(m),false,false);
  return max2f(__uint_as_float(rr[0]),__uint_as_float(rr[1]));
}
__device__ __forceinline__ void pv(f32x16*o,int vb,bf16x8 pa0,bf16x8 pa1,bf16x8 pa2,bf16x8 pa3){
  #pragma unroll
  for(int d0=0;d0<2;++d0){s16x4 lo[4],hi[4];
    #pragma unroll
    for(int ks=0;ks<4;++ks){
      asm volatile("ds_read_b64_tr_b16 %0,%1 offset:%c2":"=&v"(lo[ks]):"v"(vb),"i"(d0*4096+ks*1024):"memory");
      asm volatile("ds_read_b64_tr_b16 %0,%1 offset:%c2":"=&v"(hi[ks]):"v"(vb),"i"(d0*4096+ks*1024+512):"memory");}
    asm volatile("s_waitcnt lgkmcnt(0)":::"memory");SBAR();
    #define PK(k) (bf16x8){lo[k][0],lo[k][1],lo[k][2],lo[k][3],hi[k][0],hi[k][1],hi[k][2],hi[k][3]}
    o[d0]=__builtin_amdgcn_mfma_f32_32x32x16_bf16(pa0,PK(0),o[d0],0,0,0);
    o[d0]=__builtin_amdgcn_mfma_f32_32x32x16_bf16(pa1,PK(1),o[d0],0,0,0);
    o[d0]=__builtin_amdgcn_mfma_f32_32x32x16_bf16(pa2,PK(2),o[d0],0,0,0);
    o[d0]=__builtin_amdgcn_mfma_f32_32x32x16_bf16(pa3,PK(3),o[d0],0,0,0);
    #undef PK
  }
}

#ifndef ATTN_STORE16
#define ATTN_STORE16(p,v) (*(u32x4*)(p)=(v))
#endif
template<int THRL> __device__ __forceinline__ void attn_unit(long qrow0,int h,long kvrow0,int NT,const bf16*Q,const bf16*__restrict__ K,const bf16*__restrict__ V,bf16*O,char*shm){
  int tid_=threadIdx.x; asm volatile("":"+v"(tid_)); const int tid=tid_,lane=tid&63,r32=lane&31,hi=lane>>5; const int wid=__builtin_amdgcn_readfirstlane(tid>>6);
  const bf16*Qw=Q+(qrow0+wid*QBLK)*QP+h*D;
  const bf16*Kh=K+kvrow0*KP+(h>>2)*D,*Vh=V+kvrow0*KP+(h>>2)*D;
  const unsigned lds0=(unsigned)(uintptr_t)shm;
  float*wsf=(float*)(shm+LDS_WS)+wid*64;
  const bf16*ksrc=Kh+(long)lane*KP+wid*8;
  const bf16*vsrc=Vh+(long)(16*(wid&3)+(lane>>2))*KP+(wid>>2)*32+(lane&3)*8;
  const unsigned kdst=lds0+LDS_K+wid*1024, vdst=lds0+LDS_V+wid*1024;
  #define DMA_K(t,slot) glds16(ksrc+(long)(t)*KVBLK*KP,(unsigned)__builtin_amdgcn_readfirstlane(kdst+(slot)))
  #define DMA_V(t,slot) glds16(vsrc+(long)(t)*KVBLK*KP,(unsigned)__builtin_amdgcn_readfirstlane(vdst+(slot)))
  const int vb0=(int)(lds0+LDS_V)+((lane>>4)&1)*32+(lane&3)*8+(4*hi+((lane&15)>>2))*64;
  const char*Kbase=shm+LDS_K; bf16x8 kf[8];
  const lds_cptr shm3=(lds_cptr)shm; const lds_cptr kp0=shm3+LDS_K+hi*1024+r32*16; const lds_cptr vp0=shm3+LDS_V+((lane>>4)&1)*32+(lane&3)*8+(4*hi+((lane&15)>>2))*64;
  DMA_K(0,0);DMA_V(0,0);DMA_K(1,SLOTB);
  bf16x8 qr[4];
  #pragma unroll
  for(int d0=0;d0<4;++d0)qr[d0]=*reinterpret_cast<const bf16x8*>(&Qw[(long)r32*QP+d0*16+hi*8]);
  float mhat=0.f,l_reg=0.f;f32x16 o[2];o[0]=f32x16{};o[1]=f32x16{};f32x16 negm=f32x16{};asm volatile("":"+v"(negm));
  #define CMASK(P0,P1,t) do{}while(0)
  bool resc=false;
  #define START(P0,P1) do{ const float rm=rowmax(P0,P1); resc=false; \
    { const float dl=rm; mhat=fadd_s(mhat,dl); \
      _Pragma("unroll") for(int r=0;r<16;++r){P0[r]=fsub_s(P0[r],dl);P1[r]=fsub_s(P1[r],dl);} \
      _Pragma("unroll") for(int r=0;r<16;++r)negm[r]=-mhat; asm volatile("":"+v"(negm)); } \
    _Pragma("unroll") for(int r=0;r<16;++r)P0[r]=__builtin_amdgcn_exp2f(P0[r]); }while(0)
  #define RESC() do{ if(resc){ asm volatile("s_waitcnt lgkmcnt(0)":::"memory"); \
      _Pragma("unroll") for(int d_=0;d_<2;++d_) _Pragma("unroll") for(int r=0;r<16;++r)o[d_][r]*=wsf[crow(r,hi)]; } }while(0)
  f32x16 pA0,pA1,pB0,pB1;
  int sl_prev=0,sl_cur=0,sl_next=SLOTB;
  #define ROT() do{sl_prev=sl_cur;sl_cur=sl_next;sl_next=(sl_next==(NSLOT-1)*SLOTB)?0:sl_next+SLOTB;}while(0)
  DMA_K(2,2*SLOTB);
  WAIT_BAR(3);
  qkt(pA0,pA1,Kbase,qr,negm,r32,hi);asm volatile("s_nop 15\n\ts_nop 7":"+v"(pA0),"+v"(pA1));CMASK(pA0,pA1,0);
  START(pA0,pA1);
  _Pragma("unroll") for(int r=0;r<16;++r)pA1[r]=__builtin_amdgcn_exp2f(pA1[r]);
  WAIT_BAR(0);
  DMA_K(3,0);DMA_V(1,SLOTB);
  ROT();
  kload8(kf,kp0+sl_cur);
  WAIT_BAR(2);
  s16x4 vlo[8],vhi[8]; u32x4 pw0,pw1,pw2,pw3;
  #define PKW(P,B) cvtpk_s(P[B],P[B+1])
  #define PAF(k) __builtin_bit_cast(bf16x8,pw##k)
  #define VFR(i) (bf16x8){vlo[i][0],vlo[i][1],vlo[i][2],vlo[i][3],vhi[i][0],vhi[i][1],vhi[i][2],vhi[i][3]}
  #define PIN(x) asm volatile("":"+v"(x))
  #define MX3(a,b,c) __builtin_fmaxf(__builtin_fmaxf((a),(b)),(c))
  #define GAPA(MF,A0,A1,A2,A3,W0,W1,PW) do{ MF; sacc+=A0; sacc+=A1; sacc+=A2; sacc+=A3; PIN(sacc); W0; W1; PIN(PW); SBAR(); }while(0)
  #define EX(v) __builtin_amdgcn_exp2f(v)
  #define GAPB(MF,X,B) do{ MF; X[B]=EX(X[B]); X[B+1]=EX(X[B+1]); X[B+2]=EX(X[B+2]); X[B+3]=EX(X[B+3]); PIN(X); SBAR(); }while(0)
  #define VRD(i) do{ vlo[i]=vtr(vp_+(((i)>>2)*4096+((i)&3)*1024)); vhi[i]=vtr(vp_+(((i)>>2)*4096+((i)&3)*1024+512)); }while(0)
  #define KRD(G,j) do{ if(G){ kload2(kf,kp0+sl_next,j); SBAR(); } }while(0)
  #define STEP(C0,C1,P0,P1,t,GK,GV,GL) do{ SBAR(); \
    const lds_cptr vp_=vp0+sl_prev; \
    VRD(0); SBAR(); float sacc=(P0[0]+P0[1]); \
    GAPA(C0=__builtin_amdgcn_mfma_f32_32x32x16_bf16(kf[0],qr[0],negm,0,0,0), P0[2],P0[3],P0[4],P0[5],     pw0[0]=PKW(P0,0), pw0[1]=PKW(P0,2), pw0); \
    VRD(4); SBAR(); GAPA(C1=__builtin_amdgcn_mfma_f32_32x32x16_bf16(kf[1],qr[0],negm,0,0,0), P0[6],P0[7],P0[8],P0[9],     pw0[2]=PKW(P0,4), pw0[3]=PKW(P0,6), pw0); \
    VRD(1); SBAR(); GAPA(C0=__builtin_amdgcn_mfma_f32_32x32x16_bf16(kf[2],qr[1],C0,0,0,0),   P0[10],P0[11],P0[12],P0[13], pw1[0]=PKW(P0,8), pw1[1]=PKW(P0,10), pw1); \
    VRD(5); SBAR(); GAPA(C1=__builtin_amdgcn_mfma_f32_32x32x16_bf16(kf[3],qr[1],C1,0,0,0),   P0[14],P0[15],P1[0],P1[1],   pw1[2]=PKW(P0,12),pw1[3]=PKW(P0,14), pw1); \
    VRD(2); SBAR(); GAPA(C0=__builtin_amdgcn_mfma_f32_32x32x16_bf16(kf[4],qr[2],C0,0,0,0),   P1[2],P1[3],P1[4],P1[5],     pw2[0]=PKW(P1,0), pw2[1]=PKW(P1,2), pw2); \
    VRD(6); SBAR(); GAPA(C1=__builtin_amdgcn_mfma_f32_32x32x16_bf16(kf[5],qr[2],C1,0,0,0),   P1[6],P1[7],P1[8],P1[9],     pw2[2]=PKW(P1,4), pw2[3]=PKW(P1,6), pw2); \
    VRD(3); SBAR(); GAPA(C0=__builtin_amdgcn_mfma_f32_32x32x16_bf16(kf[6],qr[3],C0,0,0,0),   P1[10],P1[11],P1[12],P1[13], pw3[0]=PKW(P1,8), pw3[1]=PKW(P1,10), pw3); \
    VRD(7); SBAR(); GAPA(C1=__builtin_amdgcn_mfma_f32_32x32x16_bf16(kf[7],qr[3],C1,0,0,0),   P1[14],P1[15],0.f,0.f,       pw3[2]=PKW(P1,12),pw3[3]=PKW(P1,14), pw3); \
    l_reg+=sacc; \
    if(GK){DMA_K((t)+3,sl_cur);} if(GV){DMA_V((t)+1,sl_next);} \
    CMASK(C0,C1,t); \
    { float a=MX3(C0[0],C0[1],C1[0]),b=MX3(C0[2],C0[3],C1[1]); a=MX3(a,C1[2],C1[3]); \
      _Pragma("unroll") for(int r=4;r<16;r+=4){a=MX3(a,C0[r],C0[r+1]);b=MX3(b,C0[r+2],C0[r+3]);a=MX3(a,C1[r],C1[r+1]);b=MX3(b,C1[r+2],C1[r+3]);} \
      float rm=__builtin_fmaxf(a,b); { auto rr=__builtin_amdgcn_permlane32_swap(__float_as_uint(rm),__float_as_uint(rm),false,false); rm=__builtin_fmaxf(__uint_as_float(rr[0]),__uint_as_float(rr[1])); } \
      resc=false; \
      if(__builtin_expect(__any(rm>(float)THRL),0)){ const float dl=__builtin_fmaxf(rm,0.f); mhat+=dl; \
        _Pragma("unroll") for(int r=0;r<16;++r){C0[r]-=dl;C1[r]-=dl;} \
        _Pragma("unroll") for(int r=0;r<16;++r)negm[r]=-mhat; asm volatile("":"+v"(negm)); \
        const float f=__builtin_amdgcn_exp2f(-dl); l_reg*=f; if(hi==0)wsf[r32]=f; resc=true; } } \
    SBAR(); \
    GAPB(o[0]=__builtin_amdgcn_mfma_f32_32x32x16_bf16(PAF(0),VFR(0),o[0],0,0,0), C0,0); \
    GAPB(o[1]=__builtin_amdgcn_mfma_f32_32x32x16_bf16(PAF(0),VFR(4),o[1],0,0,0), C0,4); \
    KRD(GL,0); GAPB(o[0]=__builtin_amdgcn_mfma_f32_32x32x16_bf16(PAF(1),VFR(1),o[0],0,0,0), C0,8); \
    KRD(GL,1); GAPB(o[1]=__builtin_amdgcn_mfma_f32_32x32x16_bf16(PAF(1),VFR(5),o[1],0,0,0), C0,12); \
    KRD(GL,2); GAPB(o[0]=__builtin_amdgcn_mfma_f32_32x32x16_bf16(PAF(2),VFR(2),o[0],0,0,0), C1,0); \
    KRD(GL,3); GAPB(o[1]=__builtin_amdgcn_mfma_f32_32x32x16_bf16(PAF(2),VFR(6),o[1],0,0,0), C1,4); \
    GAPB(o[0]=__builtin_amdgcn_mfma_f32_32x32x16_bf16(PAF(3),VFR(3),o[0],0,0,0), C1,8); \
    GAPB(o[1]=__builtin_amdgcn_mfma_f32_32x32x16_bf16(PAF(3),VFR(7),o[1],0,0,0), C1,12); \
    }while(0)
  int t=1;
  #undef CMASK
  #define CMASK(P0,P1,t) do{}while(0)
  for(;t+5<NT;t+=2){
    STEP(pB0,pB1,pA0,pA1,t,true,true,true);     WAIT_BAR(2); RESC(); ROT();
    STEP(pA0,pA1,pB0,pB1,t+1,true,true,true);   WAIT_BAR(2); RESC(); ROT();
  }
  #undef CMASK
  #define CMASK(P0,P1,t) do{}while(0)
  #define ENDW(tt) do{ if((tt)+3<NT){WAIT_BAR(2);} else if((tt)+2<NT){WAIT_BAR(1);} else {WAIT_BAR(0);} }while(0)
  for(;t+1<NT;t+=2){
    STEP(pB0,pB1,pA0,pA1,t,(t+3<NT),(t+1<NT),(t+1<NT));       ENDW(t);   RESC(); ROT();
    STEP(pA0,pA1,pB0,pB1,t+1,(t+4<NT),(t+2<NT),(t+2<NT));     ENDW(t+1); RESC(); ROT();
  }
  STEP(pB0,pB1,pA0,pA1,NT-1,false,false,false); RESC();
  { float sacc=pB0[0]+pB0[1]; _Pragma("unroll") for(int r=2;r<16;++r)sacc+=pB0[r]; _Pragma("unroll") for(int r=0;r<16;++r)sacc+=pB1[r]; l_reg+=sacc;
    pw0=(u32x4){PKW(pB0,0),PKW(pB0,2),PKW(pB0,4),PKW(pB0,6)};pw1=(u32x4){PKW(pB0,8),PKW(pB0,10),PKW(pB0,12),PKW(pB0,14)};pw2=(u32x4){PKW(pB1,0),PKW(pB1,2),PKW(pB1,4),PKW(pB1,6)};pw3=(u32x4){PKW(pB1,8),PKW(pB1,10),PKW(pB1,12),PKW(pB1,14)};
    SBAR(); pv(o,vb0+sl_cur,PAF(0),PAF(1),PAF(2),PAF(3)); }
  #undef PKW
  #undef PAF
  #undef VFR
  #undef PIN
  #undef MX3
  #undef GAPA
  #undef GAPB
  #undef EX
  #undef VRD
  #undef KRD
  #undef STEP
  #undef ENDW
  {auto rr=__builtin_amdgcn_permlane32_swap(__float_as_uint(l_reg),__float_as_uint(l_reg),false,false);l_reg=__uint_as_float(rr[0])+__uint_as_float(rr[1]);}
  if(hi==0)wsf[32+r32]=l_reg;asm volatile("s_waitcnt lgkmcnt(0)":::"memory");
  float rli[16];
  #pragma unroll
  for(int r=0;r<16;++r)rli[r]=__builtin_amdgcn_rcpf(wsf[32+crow(r,hi)]);
  bf16*Ow=O+(qrow0+wid*QBLK)*QP+h*D;
  { bf16*stg=(bf16*)(shm+LDS_OST)+wid*2048;
    #pragma unroll
    for(int r=0;r<16;++r){const int orow=crow(r,hi);
      #pragma unroll
      for(int d0=0;d0<2;++d0)stg[orow*64+d0*32+r32]=__float2bfloat16(o[d0][r]*rli[r]);}
    asm volatile("s_waitcnt lgkmcnt(0)":::"memory");
    #pragma unroll
    for(int i=0;i<4;++i){const int row=i*8+(lane>>3),ch=lane&7; const u32x4 v=*(const u32x4*)(stg+row*64+ch*8); ATTN_STORE16(Ow+(long)row*QP+ch*8,v);} }
  asm volatile("s_waitcnt lgkmcnt(0)\n\ts_barrier":::"memory");
  #undef DMA_K
  #undef DMA_V
  #undef CMASK
  #undef START
  #undef RESC
  #undef ROT
}
constexpr int ATTN_LDS_BYTES=LDS_BYTES;
#undef SBAR
#undef WAIT_BAR
}
#define LAS __attribute__((address_space(3)))
#define INP(i) ((const GAS float*)a.in[i])
typedef unsigned short bf16;
typedef unsigned v4u __attribute__((ext_vector_type(4)));
typedef unsigned v2u __attribute__((ext_vector_type(2)));
typedef float f32x4 __attribute__((ext_vector_type(4)));
#ifndef DUP_S
#define DUP_S -1
#endif
#ifndef DUP_ATT
#define DUP_ATT 1
#endif
#ifndef DUP_SG
#define DUP_SG 1
#endif
#ifndef MK_MULTI
#define MK_MULTI 0
#endif
constexpr int NWAVES = 8, NTHREADS = 512;
constexpr int DMODEL = 1024, DEPTH = 4, ML = 16384, MC = 512, MT = ML + MC;
constexpr int INW = 5120, DFF = 2816, NMODW = 6144;
constexpr int NPHASE = 1 + 8 * DEPTH;
constexpr size_t MiB = 1u << 20;
constexpr size_t WS_MOD = 0, WS_COS = 1 * MiB, WS_SIN = 2 * MiB, WS_CTX = 3 * MiB, WS_W = 6 * MiB, WS_H = 38 * MiB, WS_Q = 72 * MiB, WS_K = 89 * MiB, WS_V = 94 * MiB,
                 WS_ZA = 99 * MiB, WS_ZB = 108 * MiB, WS_ZC = 125 * MiB, WS_ZF = 134 * MiB, WS_P = 200 * MiB;
constexpr size_t P_CONV = 0, P_SG = (size_t)MT * 768 * 2, P_G = P_SG + (size_t)MT * 512 * 2, WS_END = WS_P + P_G + (size_t)MT * 3072 * 2;
constexpr size_t WO_IN = 0, WO_A = WO_IN + 5120 * 1024, WO_B = WO_A + 1024 * 256, WO_C = WO_B + 1024 * 512, WO_O = WO_C + 1024 * 256, WO_13 = WO_O + 1024 * 1024,
                 WO_2 = WO_13 + 5632 * 1024, WO_END = WO_2 + 1024 * 2816;
static_assert(WO_END * 2 <= 32 * MiB && (size_t)MT * 1024 * 2 <= 34 * MiB && (size_t)MT * 1024 * 4 <= 66 * MiB && (size_t)MT * 2816 * 2 <= WS_END - WS_P, "ws map");
constexpr int LDS_BYTES = 147456;

__device__ __forceinline__ unsigned f2bf(float f) { unsigned u = __builtin_bit_cast(unsigned, f); return (u + 0x7fffu + ((u >> 16) & 1u)) >> 16; }
__device__ __forceinline__ unsigned pk2(float lo, float hi) { return f2bf(lo) | (f2bf(hi) << 16); }
__device__ __forceinline__ float bflo(unsigned w) { return __uint_as_float(w << 16); }
__device__ __forceinline__ float bfhi(unsigned w) { return __uint_as_float(w & 0xffff0000u); }
__device__ __forceinline__ float wave_sum(float v) {
#pragma unroll
    for (int o = 1; o < 64; o <<= 1) v += __shfl_xor(v, o);
    return v;
}
__device__ __forceinline__ int inproj_src_col(int nn) {
    if (nn < 768 || nn >= 1536) return nn;
    const int q = nn - 768, tile = q >> 8, p = q & 255, bj = p >> 7, wc = (p >> 5) & 3, fq = (p >> 3) & 3, n = (p >> 2) & 1, j = p & 3;
    return 768 + tile * 256 + wc * 64 + 32 * bj + 16 * n + 4 * fq + j;
}
template <int MODE> __device__ __forceinline__ void transpose_item(const GAS float* W, const GAS float* W3, int K, int N, GAS bf16* WT, LAS float* scr, int item, int nblk, int lane) {
    const int kb = item / nblk, nb = item % nblk, k0 = 64 * kb, n0 = 32 * nb, nn = n0 + (lane & 31);
    const GAS float* src;
    if (MODE == 0) src = W + nn;
    else if (MODE == 1) src = W + inproj_src_col(nn);
    else { const int tile = nn >> 8, p = nn & 255; src = ((p >> 7) ? W3 : W) + 128 * tile + (p & 127); }
#pragma unroll 8
    for (int i = 0; i < 32; ++i) { const int kk = 2 * i + (lane >> 5); scr[kk * 33 + (lane & 31)] = src[(size_t)(k0 + kk) * N]; }
    asm volatile("s_waitcnt lgkmcnt(0)" ::: "memory");
    const int c = lane & 7;
#pragma unroll
    for (int j = 0; j < 4; ++j) { const int n = (lane >> 3) + 8 * j; const LAS float* s = scr + (8 * c) * 33 + n;
        v4u o; o.x = pk2(s[0 * 33], s[1 * 33]); o.y = pk2(s[2 * 33], s[3 * 33]); o.z = pk2(s[4 * 33], s[5 * 33]); o.w = pk2(s[6 * 33], s[7 * 33]);
        *(GAS v4u*)(WT + (size_t)(n0 + n) * K + k0 + 8 * c) = o; }
    asm volatile("s_waitcnt lgkmcnt(0)" ::: "memory");
}
typedef GAS unsigned gu32;
#define RLX_AGENT __ATOMIC_RELAXED, __HIP_MEMORY_SCOPE_AGENT
#define XB_TMO      128
#define XB_XCNT(j)  (256  + 64 * (j))
#define XB_XSUB(j)  (1280 + 64 * (j))
#define XB_XGEN(j)  (2304 + 64 * (j))
#define XB_TOP      3328
#define XB_TOPGEN   3392
#define XCD_BAR_WORDS 3456
#define XB_SPIN_CAP (1u << 18)

__device__ __forceinline__ unsigned xb_ld(unsigned* p)              { return __hip_atomic_load(p, __ATOMIC_RELAXED, __HIP_MEMORY_SCOPE_AGENT); }
__device__ __forceinline__ unsigned xb_add(unsigned* p, unsigned v) { return __hip_atomic_fetch_add(p, v, __ATOMIC_RELAXED, __HIP_MEMORY_SCOPE_AGENT); }
__device__ __forceinline__ unsigned xb_xcc_id() { return (unsigned)__builtin_amdgcn_s_getreg((3 << 11) | 20) & 0xFu; }
#define XB_SPIN(cond, bar) do { unsigned _sp = 0; while (cond) { __builtin_amdgcn_s_sleep(1); \
    if ((++_sp & 255u) == 0u) { if (xb_ld(&(bar)[XB_TMO])) break; if (_sp > XB_SPIN_CAP) { atomicAdd(&(bar)[XB_TMO], 1u); break; } } } } while (0)

struct XcdBarrier {
    unsigned* bar; unsigned x;
    volatile LAS unsigned* st;
};

__device__ __forceinline__ XcdBarrier xcd_barrier_post(unsigned* bar, volatile LAS unsigned* st) {
    XcdBarrier b; b.bar = bar; b.x = xb_xcc_id(); b.st = st;
    if (threadIdx.x == 0) (void)xb_add(&bar[XB_XCNT(b.x)], 1u);
    return b;
}
__device__ __forceinline__ void xcd_barrier_complete(unsigned* bar, unsigned x, unsigned& nloc, unsigned& nx) {
    const unsigned G = gridDim.x * gridDim.y * gridDim.z;
    unsigned sum, cnt, mine, sp = 0u;
    for (;;) {
        sum = 0u; cnt = 0u; mine = 0u;
#pragma unroll
        for (unsigned j = 0; j < 16; ++j) { const unsigned c = xb_ld(&bar[XB_XCNT(j)]); sum += c; cnt += (c > 0u) ? 1u : 0u; mine = (j == x) ? c : mine; }
        if (sum == G) break;
        __builtin_amdgcn_s_sleep(1);
        if ((++sp & 255u) == 0u) { if (xb_ld(&bar[XB_TMO])) break; if (sp > XB_SPIN_CAP) { atomicAdd(&bar[XB_TMO], 1u); break; } }
    }
    nloc = mine > 0u ? mine : 1u; nx = cnt > 0u ? cnt : 1u;
}

__device__ __forceinline__ void xcd_barrier(const XcdBarrier& b) {
    asm volatile("s_waitcnt vmcnt(0)" ::: "memory");
    __syncthreads();
    if (threadIdx.x == 0) {
        unsigned* bar = b.bar;
        __builtin_amdgcn_s_waitcnt(0);
        unsigned nloc = b.st[0], nx = b.st[1];
        if (nloc == 0u) { xcd_barrier_complete(bar, b.x, nloc, nx); b.st[0] = nloc; b.st[1] = nx; }
        const unsigned old = xb_add(&bar[XB_XSUB(b.x)], 1u);
        const unsigned gen = old / nloc;
        if (old + 1u == (gen + 1u) * nloc) {
            __builtin_amdgcn_fence(__ATOMIC_RELEASE, "agent");
            asm volatile("s_waitcnt vmcnt(0)" ::: "memory");
            const unsigned og = xb_add(&bar[XB_TOP], 1u);
            const unsigned tg = og / nx;
            if (og + 1u == (tg + 1u) * nx) xb_add(&bar[XB_TOPGEN], 1u);
            else XB_SPIN(xb_ld(&bar[XB_TOPGEN]) == tg, bar);
            __builtin_amdgcn_fence(__ATOMIC_ACQUIRE, "agent");
            xb_add(&bar[XB_XGEN(b.x)], 1u);
            asm volatile("s_waitcnt vmcnt(0)" ::: "memory");
        } else {
            XB_SPIN(xb_ld(&bar[XB_XGEN(b.x)]) == gen, bar);
            __builtin_amdgcn_fence(__ATOMIC_ACQUIRE, "agent");
            asm volatile("s_waitcnt vmcnt(0)" ::: "memory");
        }
    }
    __syncthreads();
}

constexpr size_t WS_BAR = 512 * 1024, BAR_BYTES = 16384;
constexpr int LDS_BARST = 131072 + 64;
struct Args { const float* in[22]; float* out; unsigned char* ws; int ph_lo, ph_hi; };

__global__ void __launch_bounds__(NTHREADS, 2) fwd_kernel(Args a) {
    extern __shared__ __attribute__((aligned(16))) unsigned char lds[];
#define PTRS() \
    int tid_ = threadIdx.x; asm volatile("" : "+v"(tid_)); const int tid = tid_, lane = tid & 63, wave = __builtin_amdgcn_readfirstlane(tid >> 6); \
    int bx = blockIdx.x, G = gridDim.x; asm volatile("" : "+s"(bx), "+s"(G)); const int vcu = (G % 8 == 0) ? (bx % 8) * (G / 8) + bx / 8 : bx; (void)vcu; (void)tid; \
    const int gw = bx * NWAVES + wave, NGW = G * NWAVES; (void)gw; (void)NGW; (void)lane; \
    GAS unsigned char* wsr_ = (GAS unsigned char*)a.ws; asm volatile("" : "+s"(wsr_)); GAS unsigned char* const ws = (GAS unsigned char*)wsr_; \
    GAS float* const modv = (GAS float*)(ws + WS_MOD); GAS float* const cosT = (GAS float*)(ws + WS_COS); GAS float* const sinT = (GAS float*)(ws + WS_SIN); GAS float* const xctx = (GAS float*)(ws + WS_CTX); \
    GAS bf16* const Wb = (GAS bf16*)(ws + WS_W); GAS bf16* const H = (GAS bf16*)(ws + WS_H); GAS bf16* const Qb = (GAS bf16*)(ws + WS_Q); GAS bf16* const Kb = (GAS bf16*)(ws + WS_K); GAS bf16* const Vb = (GAS bf16*)(ws + WS_V); \
    GAS bf16* const ZA = (GAS bf16*)(ws + WS_ZA); GAS bf16* const ZB = (GAS bf16*)(ws + WS_ZB); GAS bf16* const ZC = (GAS bf16*)(ws + WS_ZC); GAS float* const ZF = (GAS float*)(ws + WS_ZF); \
    GAS bf16* const PCONV = (GAS bf16*)(ws + WS_P + P_CONV); GAS bf16* const PSG = (GAS bf16*)(ws + WS_P + P_SG); GAS bf16* const PG = (GAS bf16*)(ws + WS_P + P_G); GAS bf16* const HFF = (GAS bf16*)(ws + WS_P); \
    GAS bf16* const Zb = H; GAS float* const xlat = (GAS float*)a.out; LAS unsigned char* const ldsl = (LAS unsigned char*)lds; \
    (void)modv; (void)cosT; (void)sinT; (void)xctx; (void)Wb; (void)Qb; (void)Kb; (void)Vb; (void)ZA; (void)ZB; (void)ZC; (void)ZF; (void)PCONV; (void)PSG; (void)PG; (void)HFF; (void)Zb; (void)xlat; (void)ldsl; \
    const int l = (ph - 1) >> 3; const bool last = (l == DEPTH - 1); const GAS float* const modl = modv + (size_t)l * 3 * NMODW; const int Mrows = last ? ML : MT; (void)modl; (void)Mrows; (void)last;

#define CONVERT_WEIGHTS(l) do { \
        LAS float* scr = (LAS float*)ldsl + wave * (64 * 33); \
        for (int it = gw; it < 7808; it += NGW) { int r = it; \
            if (r < 2560) { transpose_item<1>(INP(7) + (size_t)(l) * 1024 * INW, nullptr, 1024, INW, Wb + WO_IN, scr, r, 160, lane); continue; } r -= 2560; \
            if (r < 128) { transpose_item<0>(INP(14) + (size_t)(l) * 256 * 1024, nullptr, 256, 1024, Wb + WO_A, scr, r, 32, lane); continue; } r -= 128; \
            if (r < 256) { transpose_item<0>(INP(15) + (size_t)(l) * 512 * 1024, nullptr, 512, 1024, Wb + WO_B, scr, r, 32, lane); continue; } r -= 256; \
            if (r < 128) { transpose_item<0>(INP(16) + (size_t)(l) * 256 * 1024, nullptr, 256, 1024, Wb + WO_C, scr, r, 32, lane); continue; } r -= 128; \
            if (r < 512) { transpose_item<0>(INP(17) + (size_t)(l) * 1024 * 1024, nullptr, 1024, 1024, Wb + WO_O, scr, r, 32, lane); continue; } r -= 512; \
            if (r < 2816) { transpose_item<2>(INP(19) + (size_t)(l) * 1024 * DFF, INP(20) + (size_t)(l) * 1024 * DFF, 1024, DFF, Wb + WO_13, scr, r, 176, lane); continue; } r -= 2816; \
            transpose_item<0>(INP(21) + (size_t)(l) * DFF * 1024, nullptr, DFF, 1024, Wb + WO_2, scr, r, 32, lane); } \
        __syncthreads(); } while (0)

#define NORM_ROWS(normw, modl, shidx, scidx, nrows) do { \
        for (int r = gw; r < (nrows); r += NGW) { const bool latent = r < ML; const GAS float* xrow = latent ? xlat + (size_t)r * 1024 : xctx + (size_t)(r - ML) * 1024; \
            const int src = latent ? (r >> 13) : 2; const GAS float* shp = (modl) + src * NMODW + (shidx) * 1024; const GAS float* scp = (modl) + src * NMODW + (scidx) * 1024; \
            f32x4 v[4]; float ss = 0.f; \
            _Pragma("unroll") for (int j = 0; j < 4; ++j) { v[j] = *((const GAS f32x4*)xrow + lane + 64 * j); ss += (v[j][0] * v[j][0] + v[j][1] * v[j][1]) + (v[j][2] * v[j][2] + v[j][3] * v[j][3]); } \
            const float rinv = 1.0f / sqrtf(wave_sum(ss) * (1.0f / 1024.0f) + 1e-6f); \
            _Pragma("unroll") for (int j = 0; j < 4; ++j) { const f32x4 gg = *((const GAS f32x4*)(normw) + lane + 64 * j), s4 = *((const GAS f32x4*)scp + lane + 64 * j), h4 = *((const GAS f32x4*)shp + lane + 64 * j); \
                const f32x4 o = v[j] * rinv * gg * (s4 + 1.0f) + h4; v2u w; w.x = pk2(o[0], o[1]); w.y = pk2(o[2], o[3]); *((GAS v2u*)(H + (size_t)r * 1024) + lane + 64 * j) = w; } } } while (0)

    const bool fused_ = (a.ph_hi - a.ph_lo) > 1;
    { volatile LAS unsigned* st_ = (volatile LAS unsigned*)((LAS unsigned char*)lds + LDS_BARST); if (threadIdx.x == 0) { st_[0] = 0u; st_[1] = 0u; } __syncthreads(); }
    XcdBarrier bar; bar.bar = (unsigned*)(a.ws + WS_BAR); bar.x = 0; bar.st = (volatile LAS unsigned*)((LAS unsigned char*)lds + LDS_BARST);
    if (fused_) bar = xcd_barrier_post((unsigned*)(a.ws + WS_BAR), (volatile LAS unsigned*)((LAS unsigned char*)lds + LDS_BARST));
    for (int ph = a.ph_lo; ph < a.ph_hi; ++ph) {
      const int nrep_ = (DUP_S >= 0 && ((ph == 0 && DUP_S == 8) || (ph >= 1 && ((ph - 1) & 7) == DUP_S))) ? 2 : 1;
      for (int rep_ = 0; rep_ < nrep_; ++rep_) {
        if (ph == 0) { PTRS();
            if (bx < 96) {
                LAS float* sil = (LAS float*)ldsl + 8 * 64 * 33; LAS float* red = sil + 3072;
                for (int i = tid; i < 3072; i += NTHREADS) { const int src = i >> 10, k = i & 1023; const float v = src < 2 ? INP(1)[src * 1024 + k] : INP(3)[k]; sil[i] = v / (1.0f + expf(-v)); }
                __syncthreads();
                const int j0 = bx * 256, l = j0 / NMODW, jj = j0 % NMODW;
                const GAS float* Wm = INP(4) + (size_t)l * 1024 * NMODW + jj + 4 * lane;
                f32x4 a0 = {0.f, 0.f, 0.f, 0.f}, a1 = a0, a2 = a0;
#pragma unroll 8
                for (int k = wave * 128; k < wave * 128 + 128; ++k) { const f32x4 w = *(const GAS f32x4*)(Wm + (size_t)k * NMODW); a0 += w * sil[k]; a1 += w * sil[1024 + k]; a2 += w * sil[2048 + k]; }
#pragma unroll
                for (int j = 0; j < 4; ++j) { red[(wave * 3 + 0) * 256 + 4 * lane + j] = a0[j]; red[(wave * 3 + 1) * 256 + 4 * lane + j] = a1[j]; red[(wave * 3 + 2) * 256 + 4 * lane + j] = a2[j]; }
                __syncthreads();
                for (int i = tid; i < 768; i += NTHREADS) { const int src = i >> 8, ci = i & 255; float s = INP(5)[l * NMODW + jj + ci];
#pragma unroll
                    for (int w = 0; w < 8; ++w) s += red[(w * 3 + src) * 256 + ci];
                    modv[(l * 3 + src) * NMODW + jj + ci] = s; }
                __syncthreads();
            }
            CONVERT_WEIGHTS(0);
            { const int gt = bx * NTHREADS + tid, NT_ = G * NTHREADS;
              const GAS f32x4* x4 = (const GAS f32x4*)INP(0); GAS f32x4* o4 = (GAS f32x4*)xlat;
              for (int i = gt; i < ML * 1024 / 4; i += NT_) o4[i] = x4[i];
              const GAS f32x4* c4 = (const GAS f32x4*)INP(2); GAS f32x4* oc4 = (GAS f32x4*)xctx;
              for (int i = gt; i < MC * 1024 / 4; i += NT_) oc4[i] = c4[i];
              for (int i = gt; i < 8192 * 32; i += NT_) { const int t = i >> 5, ax = (i >> 4) & 1, f = i & 15; const float pos = (float)(ax ? (t & 63) : (t >> 6));
                  const float invf = powf(10000.0f, -(float)(2 * f) / 32.0f); const float ang = pos * invf; cosT[i] = cosf(ang); sinT[i] = sinf(ang); } }
        } else {
            const int s = (ph - 1) & 7;
            if (s == 0) { PTRS();
                if (l > 0) CONVERT_WEIGHTS(l);
                NORM_ROWS(INP(6) + l * 1024, modl, 0, 1, MT);
            } else if (s == 1) { PTRS();
                pg8::Gemm g{(const pg8::bf16_t*)H, (const pg8::bf16_t*)(Wb + WO_IN), MT, INW, 1024}; pg8::StaticOrder S; S.init(MT, INW, G, bx);
                pg8::EpiInProj E{PCONV, Qb, Kb, Vb, PSG, PG, INP(8) + l * 64, INP(9) + l * 64, cosT, sinT};
                pg8::gemm_phase<pg8::EpiInProj, pg8::StaticOrder, true, true>(ldsl, g, S, E);
            } else if (s == 2) { PTRS();
                for (int ra_ = 0; ra_ < DUP_ATT; ++ra_) {
                const int upb = (512 + G - 1) / G;
                for (int i = 0; i < upb; ++i) { const int uid = vcu * upb + i; if (uid >= 512) break;
                    const int bhk = uid >> 7, rem = uid & 127, hg = rem >> 5, qb = rem & 31, b = bhk >> 1, h = (bhk & 1) * 4 + hg;
                    attn_body::attn_unit<8>((long)b * 8192 + qb * 256, h, (long)b * 8448, 132, (const attn_body::bf16*)Qb, (const attn_body::bf16*)Kb, (const attn_body::bf16*)Vb, (attn_body::bf16*)ZB, (char*)lds); }
                if (!last) for (int uid = vcu; uid < 16; uid += G) { const int b = uid >> 3, h = uid & 7;
                    attn_body::attn_unit<8>((long)ML + b * 256, h, (long)b * 8448 + 8192, 4, (const attn_body::bf16*)Qb, (const attn_body::bf16*)Kb, (const attn_body::bf16*)Vb, (attn_body::bf16*)ZB, (char*)lds); }
                }
                __syncthreads();
                for (int rs_ = 0; rs_ < DUP_SG; ++rs_) {
                { const GAS float* cw = INP(10) + l * 768 + 4 * lane; const f32x4 w0 = *(const GAS f32x4*)cw, w1 = *(const GAS f32x4*)(cw + 256), w2 = *(const GAS f32x4*)(cw + 512);
                  for (int r = gw; r < Mrows; r += NGW) { const bool latent = r < ML; const int pos = latent ? (r & 8191) : ((r - ML) & 255), len = latent ? 8192 : 256;
                      const GAS bf16* p = PCONV + (size_t)r * 768 + 4 * lane;
                      const v2u ab = *(const GAS v2u*)p, c0 = *(const GAS v2u*)(p + 256), x0 = *(const GAS v2u*)(p + 512);
                      v2u cm = {0u, 0u}, xm = cm, cp = cm, xp = cm;
                      if (pos > 0) { cm = *(const GAS v2u*)(p - 768 + 256); xm = *(const GAS v2u*)(p - 768 + 512); }
                      if (pos < len - 1) { cp = *(const GAS v2u*)(p + 768 + 256); xp = *(const GAS v2u*)(p + 768 + 512); }
                      const f32x4 pm = {bflo(cm.x) * bflo(xm.x), bfhi(cm.x) * bfhi(xm.x), bflo(cm.y) * bflo(xm.y), bfhi(cm.y) * bfhi(xm.y)};
                      const f32x4 p0 = {bflo(c0.x) * bflo(x0.x), bfhi(c0.x) * bfhi(x0.x), bflo(c0.y) * bflo(x0.y), bfhi(c0.y) * bfhi(x0.y)};
                      const f32x4 pp = {bflo(cp.x) * bflo(xp.x), bfhi(cp.x) * bfhi(xp.x), bflo(cp.y) * bflo(xp.y), bfhi(cp.y) * bfhi(xp.y)};
                      const f32x4 av = {bflo(ab.x), bfhi(ab.x), bflo(ab.y), bfhi(ab.y)};
                      const f32x4 o = av * (w0 * pm + w1 * p0 + w2 * pp);
                      v2u w; w.x = pk2(o[0], o[1]); w.y = pk2(o[2], o[3]); *(GAS v2u*)(ZA + (size_t)r * 256 + 4 * lane) = w; } }
                { LAS float* Wl = (LAS float*)ldsl; LAS float* Vl = Wl + 128 * 129;
                  const int nitems = (Mrows / 128) * 4;
                  for (int item = bx; item < nitems; item += G) { const int chunk = item >> 2, g = item & 3, rb = chunk * 128;
                      for (int i = 0; i < 16; ++i) { const int srow = 16 * wave + i; const v2u raw = *(const GAS v2u*)(PSG + (size_t)(rb + srow) * 512 + 256 + 4 * lane);
                          const f32x4 f = {bflo(raw.x), bfhi(raw.x), bflo(raw.y), bfhi(raw.y)};
                          const float ss = wave_sum((f[0] * f[0] + f[1] * f[1]) + (f[2] * f[2] + f[3] * f[3])); const float rinv = 1.0f / sqrtf(ss * (1.0f / 256.0f) + 1e-6f);
                          if ((lane >> 4) == g) { const int d = 4 * (lane & 15); const f32x4 gn = *(const GAS f32x4*)(INP(11) + l * 256 + g * 64 + d);
                              *(LAS f32x4*)(Vl + srow * 64 + d) = f * rinv * gn; } }
                      const GAS float* Wg = INP(12) + (size_t)(l * 4 + g) * 128 * 128;
#pragma unroll
                      for (int i = 0; i < 8; ++i) { const int idx = tid * 4 + i * 2048, t = idx >> 7, s0 = idx & 127; const f32x4 w = *(const GAS f32x4*)(Wg + idx);
                          Wl[t * 129 + s0] = w[0]; Wl[t * 129 + s0 + 1] = w[1]; Wl[t * 129 + s0 + 2] = w[2]; Wl[t * 129 + s0 + 3] = w[3]; }
                      __syncthreads();
                      const int t = tid >> 2, dq = tid & 3;
                      f32x4 ac[4]; ac[0] = (f32x4){0.f, 0.f, 0.f, 0.f}; ac[1] = ac[0]; ac[2] = ac[0]; ac[3] = ac[0];
#pragma unroll 4
                      for (int s2 = 0; s2 < 128; ++s2) { const float w = Wl[t * 129 + s2];
#pragma unroll
                          for (int q = 0; q < 4; ++q) ac[q] += w * *(const LAS f32x4*)(Vl + s2 * 64 + dq * 16 + 4 * q); }
                      const float bias = INP(13)[(l * 4 + g) * 128 + t];
                      const size_t row = (size_t)(rb + t);
                      const v4u u0 = *(const GAS v4u*)(PSG + row * 512 + g * 64 + dq * 16), u1 = *(const GAS v4u*)(PSG + row * 512 + g * 64 + dq * 16 + 8);
                      v4u o0, o1;
                      o0.x = pk2(bflo(u0.x) * (ac[0][0] + bias), bfhi(u0.x) * (ac[0][1] + bias)); o0.y = pk2(bflo(u0.y) * (ac[0][2] + bias), bfhi(u0.y) * (ac[0][3] + bias));
                      o0.z = pk2(bflo(u0.z) * (ac[1][0] + bias), bfhi(u0.z) * (ac[1][1] + bias)); o0.w = pk2(bflo(u0.w) * (ac[1][2] + bias), bfhi(u0.w) * (ac[1][3] + bias));
                      o1.x = pk2(bflo(u1.x) * (ac[2][0] + bias), bfhi(u1.x) * (ac[2][1] + bias)); o1.y = pk2(bflo(u1.y) * (ac[2][2] + bias), bfhi(u1.y) * (ac[2][3] + bias));
                      o1.z = pk2(bflo(u1.z) * (ac[3][0] + bias), bfhi(u1.z) * (ac[3][1] + bias)); o1.w = pk2(bflo(u1.w) * (ac[3][2] + bias), bfhi(u1.w) * (ac[3][3] + bias));
                      *(GAS v4u*)(ZC + row * 256 + g * 64 + dq * 16) = o0; *(GAS v4u*)(ZC + row * 256 + g * 64 + dq * 16 + 8) = o1;
                      __syncthreads(); } }
                }
            } else if (s == 3) { PTRS();
                pg8::StaticOrder S; S.init(Mrows, 1024, G, bx);
                { pg8::Gemm g{(const pg8::bf16_t*)ZA, (const pg8::bf16_t*)(Wb + WO_A), Mrows, 1024, 256}; pg8::EpiMerge<0> E{PG, 0, ZF, Zb}; pg8::gemm_phase<pg8::EpiMerge<0>, pg8::StaticOrder, true, true>(ldsl, g, S, E); }
                { pg8::Gemm g{(const pg8::bf16_t*)ZB, (const pg8::bf16_t*)(Wb + WO_B), Mrows, 1024, 512}; pg8::EpiMerge<1> E{PG, 1024, ZF, Zb}; pg8::gemm_phase<pg8::EpiMerge<1>, pg8::StaticOrder, true, true>(ldsl, g, S, E); }
                { pg8::Gemm g{(const pg8::bf16_t*)ZC, (const pg8::bf16_t*)(Wb + WO_C), Mrows, 1024, 256}; pg8::EpiMerge<2> E{PG, 2048, ZF, Zb}; pg8::gemm_phase<pg8::EpiMerge<2>, pg8::StaticOrder, true, true>(ldsl, g, S, E); }
            } else if (s == 4) { PTRS();
                pg8::Gemm g{(const pg8::bf16_t*)Zb, (const pg8::bf16_t*)(Wb + WO_O), Mrows, 1024, 1024}; pg8::StaticOrder S; S.init(Mrows, 1024, G, bx);
                pg8::EpiResid E{xlat, xctx, modl, 2}; pg8::gemm_phase<pg8::EpiResid, pg8::StaticOrder, true, true>(ldsl, g, S, E);
            } else if (s == 5) { PTRS();
                NORM_ROWS(INP(18) + l * 1024, modl, 3, 4, Mrows);
            } else if (s == 6) { PTRS();
                pg8::Gemm g{(const pg8::bf16_t*)H, (const pg8::bf16_t*)(Wb + WO_13), Mrows, 2 * DFF, 1024}; pg8::StaticOrder S; S.init(Mrows, 2 * DFF, G, bx);
                pg8::EpiSwiGLU E{HFF}; pg8::gemm_phase<pg8::EpiSwiGLU, pg8::StaticOrder, true, true>(ldsl, g, S, E);
            } else { PTRS();
                pg8::Gemm g{(const pg8::bf16_t*)HFF, (const pg8::bf16_t*)(Wb + WO_2), Mrows, 1024, DFF}; pg8::StaticOrder S; S.init(Mrows, 1024, G, bx);
                pg8::EpiResid E{xlat, xctx, modl, 5}; pg8::gemm_phase<pg8::EpiResid, pg8::StaticOrder, true, true>(ldsl, g, S, E);
            }
        }
      }
        if (ph + 1 < a.ph_hi) { if (ph == 0) { asm volatile("s_waitcnt vmcnt(0)" ::: "memory"); cg::this_grid().sync(); } else { xcd_barrier(bar); if (DUP_S == 9) xcd_barrier(bar); } }
    }
}

extern "C" void kernel_launch(void* const* d_in, const int* in_sizes, int n_in, void* d_out, int out_size, void* d_ws, size_t ws_size, hipStream_t stream) {
    static int grid = 0;
    if (grid == 0) {
        if (n_in != 22 || ws_size < WS_END) { fprintf(stderr, "kernel_launch: unexpected n_in %d / ws %zu (need %zu)\n", n_in, ws_size, (size_t)WS_END); grid = -1; return; }
        int dev = 0, cus = 0, per_cu = 0;
        (void)hipGetDevice(&dev); (void)hipDeviceGetAttribute(&cus, hipDeviceAttributeMultiprocessorCount, dev);
        if (hipFuncSetAttribute((const void*)fwd_kernel, hipFuncAttributeMaxDynamicSharedMemorySize, LDS_BYTES) != hipSuccess) { fprintf(stderr, "kernel_launch: hipFuncSetAttribute failed\n"); grid = -1; return; }
        if (hipOccupancyMaxActiveBlocksPerMultiprocessor(&per_cu, (const void*)fwd_kernel, NTHREADS, LDS_BYTES) != hipSuccess || per_cu < 1) { (void)hipGetLastError(); per_cu = 1; }
        grid = cus * per_cu; if (grid <= 0) grid = 256;
    }
    if (grid < 0) return;
    (void)hipMemsetAsync((char*)d_ws + WS_BAR, 0, BAR_BYTES, stream);
    Args a{};
    for (int i = 0; i < 22; ++i) a.in[i] = (const float*)d_in[i];
    a.out = (float*)d_out; a.ws = (unsigned char*)d_ws;
#if MK_MULTI
    for (int ph = 0; ph < NPHASE; ++ph) { a.ph_lo = ph; a.ph_hi = ph + 1; hipLaunchKernelGGL(fwd_kernel, dim3(grid), dim3(NTHREADS), LDS_BYTES, stream, a); }
#else
    a.ph_lo = 0; a.ph_hi = NPHASE;
    void* args[] = {&a};
    hipError_t e = hipLaunchCooperativeKernel((const void*)fwd_kernel, dim3(grid), dim3(NTHREADS), args, LDS_BYTES, stream);
    if (e != hipSuccess) fprintf(stderr, "cooperative launch failed: %s (grid %d)\n", hipGetErrorString(e), grid);
#endif
}
```

```cpp
#include <hip/hip_runtime.h>
#include <hip/hip_cooperative_groups.h>
#include <hip/hip_bf16.h>
#include <cstdio>
#include <cstdint>
#include <cmath>
namespace cg = cooperative_groups;

namespace pg8 {
#define PG8_LAS __attribute__((address_space(3)))
typedef unsigned short bf16_t;
typedef short bf16x8 __attribute__((ext_vector_type(8)));
typedef float f32x4 __attribute__((ext_vector_type(4)));
typedef unsigned u32x4 __attribute__((ext_vector_type(4)));
constexpr int BM = 256, BK = 64, HALF = 128, HTB = HALF * BK * 2  , STAGE_BYTES = 8 * HTB, NXCD = 8, WGM = 8;

__host__ __device__ __forceinline__ int lds_byte(int r, int c) { const int st = (r >> 4) * 2 + (c >> 5), rr = r & 15, cc = c & 31, ob = rr * 64 + cc * 2; return st * 1024 + (ob ^ (((ob >> 9) & 1) << 5)); }
__host__ __device__ __forceinline__ void stage_rc(int b, int& R, int& C) { const int st = b / 1024, sb = b % 1024, swz = sb ^ (((sb >> 9) & 1) << 5); R = (st >> 1) * 16 + swz / 64; C = (st & 1) * 32 + (swz % 64) / 2; }
__host__ __device__ __forceinline__ int perm32(int rho) { const int n = rho >> 4, i = rho & 15; return 8 * (i >> 2) + 4 * n + (i & 3); }

struct Unit { int pm, pn; };
struct Gemm { const bf16_t* A; const bf16_t* Bt; int M, N, K; };

struct StaticOrder {
    int nM, nN, nwg, G, c;
    __host__ __device__ void init(int M, int N, int G_, int c_) { nM = M / BM; nN = N / BM; nwg = nM * nN; G = G_; c = c_; }
    __host__ __device__ bool next(int i, Unit& u) const {
        const long L = (long)i * G + c; if (L >= nwg) return false;
        int wgid = (int)L; { const int q = nwg / NXCD, r = nwg % NXCD, xcd = wgid % NXCD, off = wgid / NXCD; wgid = (xcd < r ? xcd * (q + 1) : r * (q + 1) + (xcd - r) * q) + off; }
        const int nig = WGM * nN, gid = wgid / nig, fm = gid * WGM, gsz = (nM - fm) < WGM ? (nM - fm) : WGM;
        u.pm = fm + ((wgid % nig) % gsz); u.pn = (wgid % nig) / gsz; return true;
    }
    __device__ __forceinline__ void a_ready(const Unit&) const {}
    __device__ __forceinline__ void done(const Unit&) const {}
};

__device__ __forceinline__ unsigned cvt_pk_bf16(float lo, float hi) { unsigned r; asm volatile("v_cvt_pk_bf16_f32 %0, %1, %2" : "=v"(r) : "v"(lo), "v"(hi)); return r; }
typedef float f32x2 __attribute__((ext_vector_type(2)));
__device__ __forceinline__ float bf_lo(unsigned w) { return __uint_as_float(w << 16); }
__device__ __forceinline__ float bf_hi(unsigned w) { return __uint_as_float(w & 0xffff0000u); }
__device__ __forceinline__ float sigmoid_f(float x) { return __builtin_amdgcn_rcpf(1.0f + __builtin_amdgcn_exp2f(-1.4426950408889634f * x)); }
__device__ __forceinline__ float gelu_tanh_f(float x) { const float in2 = 1.5957691216057308f * (x + 0.044715f * x * x * x); return x * sigmoid_f(in2); }
__device__ __forceinline__ f32x4 act4(f32x4 v, int act) {
    if (act == 1) return (f32x4){gelu_tanh_f(v[0]), gelu_tanh_f(v[1]), gelu_tanh_f(v[2]), gelu_tanh_f(v[3])};
    if (act == 2) return (f32x4){sigmoid_f(v[0]), sigmoid_f(v[1]), sigmoid_f(v[2]), sigmoid_f(v[3])};
    return v;
}
constexpr float ATT_C2 = 0.125f * 1.4426950408889634f;
typedef unsigned u32x2 __attribute__((ext_vector_type(2)));
#define GAS __attribute__((address_space(1)))
struct EpiInProj {
    static constexpr bool PERM = true, AFTER_DRAIN = false, HAS_HOOK = false;
    GAS bf16_t *PCONV, *Q, *Kb, *Vb, *PSG, *PG; const GAS float *qg, *kg, *cosT, *sinT;
    __device__ __forceinline__ void operator()(const f32x4 (&acc)[2][2][4][2], const Unit& u, int wr, int wc, int fr, int fq) const {
        const int row0 = u.pm * BM + wr * 64 + fr, pn = u.pn;
        if (pn >= 3 && pn < 6) {
            const bool isq = pn < 5, isv = (pn == 5) && (wc >= 2), latent = u.pm < 64;
            const GAS float* gp = isq ? qg : kg;
            f32x4 gn[2][2];
#pragma unroll
            for (int bj = 0; bj < 2; ++bj)
#pragma unroll
                for (int n = 0; n < 2; ++n) gn[bj][n] = *(const GAS f32x4*)(gp + 32 * bj + 16 * n + 4 * fq);
#pragma unroll
            for (int ai = 0; ai < 2; ++ai)
#pragma unroll
                for (int m = 0; m < 4; ++m) {
                    const int row = row0 + ai * HALF + m * 16;
                    f32x4 v[2][2];
#pragma unroll
                    for (int bj = 0; bj < 2; ++bj)
#pragma unroll
                        for (int n = 0; n < 2; ++n) v[bj][n] = acc[ai][bj][m][n];
                    if (!isv) {
                        float ss = 0.f;
#pragma unroll
                        for (int bj = 0; bj < 2; ++bj)
#pragma unroll
                            for (int n = 0; n < 2; ++n) { const f32x4 x = v[bj][n]; ss += (x[0] * x[0] + x[1] * x[1]) + (x[2] * x[2] + x[3] * x[3]); }
                        ss += __shfl_xor(ss, 16); ss += __shfl_xor(ss, 32);
                        const float r = (1.0f / sqrtf(ss * (1.0f / 64.0f) + 1e-6f)) * (isq ? ATT_C2 : 1.0f);
#pragma unroll
                        for (int bj = 0; bj < 2; ++bj)
#pragma unroll
                            for (int n = 0; n < 2; ++n) v[bj][n] = v[bj][n] * gn[bj][n] * r;
                        if (latent) {
                            const int t = row & 8191;
#pragma unroll
                            for (int bj = 0; bj < 2; ++bj) {
                                const f32x4 c = *(const GAS f32x4*)(cosT + t * 32 + bj * 16 + 4 * fq), s = *(const GAS f32x4*)(sinT + t * 32 + bj * 16 + 4 * fq);
                                const f32x4 x1 = v[bj][0], x2 = v[bj][1];
                                v[bj][0] = x1 * c - x2 * s; v[bj][1] = x2 * c + x1 * s;
                            }
                        }
                    }
                    GAS bf16_t* dst;
                    if (isq) dst = Q + (size_t)row * 512 + (pn - 3) * 256 + wc * 64;
                    else {
                        const int rc = row - 16384;
                        const size_t kvrow = latent ? (size_t)((row >> 13) * 8448 + (row & 8191)) : (size_t)((rc >> 8) * 8448 + 8192 + (rc & 255));
                        dst = isv ? Vb + kvrow * 128 + (wc - 2) * 64 : Kb + kvrow * 128 + wc * 64;
                    }
#pragma unroll
                    for (int bj = 0; bj < 2; ++bj)
#pragma unroll
                        for (int n = 0; n < 2; ++n) { u32x2 w; w.x = cvt_pk_bf16(v[bj][n][0], v[bj][n][1]); w.y = cvt_pk_bf16(v[bj][n][2], v[bj][n][3]);
                            *(GAS u32x2*)(dst + 32 * bj + 16 * n + 4 * fq) = w; }
                }
        } else if (pn == 1 || pn == 2) {
            const int col0 = 256 + (pn - 1) * 128 + wc * 32 + 8 * fq;
#pragma unroll
            for (int ai = 0; ai < 2; ++ai)
#pragma unroll
                for (int m = 0; m < 4; ++m) { const f32x4 v0 = acc[ai][0][m][0] * acc[ai][1][m][0], v1 = acc[ai][0][m][1] * acc[ai][1][m][1];
                    u32x4 w; w.x = cvt_pk_bf16(v0[0], v0[1]); w.y = cvt_pk_bf16(v0[2], v0[3]); w.z = cvt_pk_bf16(v1[0], v1[1]); w.w = cvt_pk_bf16(v1[2], v1[3]);
                    *(GAS u32x4*)(PCONV + (size_t)(row0 + ai * HALF + m * 16) * 512 + col0) = w; }
        } else {
            GAS bf16_t* base; int ld, colt, act;
            if (pn < 3) { base = PCONV; ld = 512; colt = 0; act = 0; }
            else if (pn < 8) { base = PSG; ld = 512; colt = (pn - 6) * 256; act = 1; }
            else { base = PG; ld = 3072; colt = (pn - 8) * 256; act = 2; }
            const int col0 = colt + wc * 32 + 8 * fq;
#pragma unroll
            for (int ai = 0; ai < 2; ++ai)
#pragma unroll
                for (int m = 0; m < 4; ++m) { GAS bf16_t* rowp = base + (size_t)(row0 + ai * HALF + m * 16) * ld + col0;
#pragma unroll
                    for (int bj = 0; bj < 2; ++bj) { const f32x4 v0 = act4(acc[ai][bj][m][0], act), v1 = act4(acc[ai][bj][m][1], act);
                        u32x4 w; w.x = cvt_pk_bf16(v0[0], v0[1]); w.y = cvt_pk_bf16(v0[2], v0[3]); w.z = cvt_pk_bf16(v1[0], v1[1]); w.w = cvt_pk_bf16(v1[2], v1[3]);
                        *(GAS u32x4*)(rowp + bj * HALF) = w; } }
        }
    }
};
struct EpiMergeFused {
    static constexpr bool PERM = true, AFTER_DRAIN = false, HAS_HOOK = true; static constexpr int T1 = 4, T2 = 12;
    const GAS bf16_t* PG; GAS bf16_t* z;
    __device__ __forceinline__ void hook(f32x4 (&acc)[2][2][4][2], const Unit& u, int t, int wr, int wc, int fr, int fq) const {
        asm volatile("" : "+v"(fr), "+v"(fq));
        const int row0 = u.pm * BM + wr * 64 + fr, col0 = u.pn * BM + wc * 32 + 8 * fq, goff = (t == T1) ? 0 : 1024;
#pragma unroll
        for (int ai = 0; ai < 2; ++ai)
#pragma unroll
            for (int m = 0; m < 4; ++m) { const size_t row = (size_t)(row0 + ai * HALF + m * 16);
#pragma unroll
                for (int bj = 0; bj < 2; ++bj) { const GAS bf16_t* gp = PG + row * 3072 + goff + col0 + bj * HALF;
                    const u32x4 gn = *(const GAS u32x4*)gp, gd = *(const GAS u32x4*)(gp + 1024);
                    const f32x4 n0 = {bf_lo(gn.x), bf_hi(gn.x), bf_lo(gn.y), bf_hi(gn.y)}, n1 = {bf_lo(gn.z), bf_hi(gn.z), bf_lo(gn.w), bf_hi(gn.w)};
                    f32x4 d0 = {bf_lo(gd.x), bf_hi(gd.x), bf_lo(gd.y), bf_hi(gd.y)}, d1 = {bf_lo(gd.z), bf_hi(gd.z), bf_lo(gd.w), bf_hi(gd.w)};
#pragma unroll
                    for (int j = 0; j < 4; ++j) { d0[j] = __builtin_amdgcn_rcpf(__builtin_fmaxf(d0[j], 1e-30f)); d1[j] = __builtin_amdgcn_rcpf(__builtin_fmaxf(d1[j], 1e-30f)); }
                    acc[ai][bj][m][0] = acc[ai][bj][m][0] * (n0 * d0); acc[ai][bj][m][1] = acc[ai][bj][m][1] * (n1 * d1); } }
    }
    __device__ __forceinline__ void operator()(const f32x4 (&acc)[2][2][4][2], const Unit& u, int wr, int wc, int fr, int fq) const {
        asm volatile("" : "+v"(fr), "+v"(fq));
        const int row0 = u.pm * BM + wr * 64 + fr, col0 = u.pn * BM + wc * 32 + 8 * fq;
#pragma unroll
        for (int ai = 0; ai < 2; ++ai)
#pragma unroll
            for (int m = 0; m < 4; ++m) { const size_t row = (size_t)(row0 + ai * HALF + m * 16);
#pragma unroll
                for (int bj = 0; bj < 2; ++bj) { const int col = col0 + bj * HALF;
                    const u32x4 gw = *(const GAS u32x4*)(PG + row * 3072 + 2048 + col);
                    const f32x4 v0 = acc[ai][bj][m][0] * (f32x4){bf_lo(gw.x), bf_hi(gw.x), bf_lo(gw.y), bf_hi(gw.y)};
                    const f32x4 v1 = acc[ai][bj][m][1] * (f32x4){bf_lo(gw.z), bf_hi(gw.z), bf_lo(gw.w), bf_hi(gw.w)};
                    u32x4 w; w.x = cvt_pk_bf16(v0[0], v0[1]); w.y = cvt_pk_bf16(v0[2], v0[3]); w.z = cvt_pk_bf16(v1[0], v1[1]); w.w = cvt_pk_bf16(v1[2], v1[3]);
                    *(GAS u32x4*)(z + row * 1024 + col) = w; } }
    }
};
struct EpiResid {
    static constexpr bool PERM = false, AFTER_DRAIN = false, HAS_HOOK = false;
    const GAS float* xsrc; GAS float* xlat; GAS float* xctx; const GAS float* modl; int gidx;
    __device__ __forceinline__ void operator()(const f32x4 (&acc)[2][2][4][2], const Unit& u, int wr, int wc, int fr, int fq) const {
        const int row0 = u.pm * BM + wr * 64 + fr, col0 = u.pn * BM + wc * 32 + 4 * fq;
        const bool latent = u.pm < 64; const int src = latent ? (u.pm >> 5) : 2;
        f32x4 gt[2][2];
#pragma unroll
        for (int bj = 0; bj < 2; ++bj)
#pragma unroll
            for (int n = 0; n < 2; ++n) gt[bj][n] = *(const GAS f32x4*)(modl + src * 6144 + gidx * 1024 + col0 + bj * HALF + n * 16);
#pragma unroll
        for (int ai = 0; ai < 2; ++ai)
#pragma unroll
            for (int m = 0; m < 4; ++m) { const int row = row0 + ai * HALF + m * 16;
                GAS float* xp = (latent ? xlat + (size_t)row * 1024 : xctx + (size_t)(row - 16384) * 1024) + col0;
                const GAS float* xs = (latent ? xsrc + (size_t)row * 1024 : xctx + (size_t)(row - 16384) * 1024) + col0;
#pragma unroll
                for (int bj = 0; bj < 2; ++bj)
#pragma unroll
                    for (int n = 0; n < 2; ++n) { *(GAS f32x4*)(xp + bj * HALF + n * 16) = *(const GAS f32x4*)(xs + bj * HALF + n * 16) + gt[bj][n] * acc[ai][bj][m][n]; } }
    }
};
struct EpiResidNorm {
    static constexpr bool PERM = true, AFTER_DRAIN = true, HAS_HOOK = false;
    const GAS float* xsrc; GAS float* xlat; const GAS float* modl; int gidx; GAS bf16_t* Hout; const GAS float* normw; const GAS float* modn; int shidx, scidx;
    unsigned* xbuf; unsigned* cnt; unsigned want;
    __device__ __forceinline__ void operator()(const f32x4 (&)[2][2][4][2], const Unit&, int, int, int, int) const {}
    __device__ __forceinline__ void fused(f32x4 (&acc)[2][2][4][2], const Unit& u, int wr, int wc, int fr, int fq, PG8_LAS unsigned char* lds, int wid, int lane) const {
        asm volatile("" : "+v"(fr), "+v"(fq));
        PG8_LAS float* P = (PG8_LAS float*)lds;
        PG8_LAS float* S = (PG8_LAS float*)(lds + 4096);
        const int row0 = u.pm * BM + wr * 64 + fr, col0 = u.pn * BM + wc * 32 + 8 * fq, src = u.pm >> 5;
        f32x4 gt[2][2];
#pragma unroll
        for (int bj = 0; bj < 2; ++bj)
#pragma unroll
            for (int n = 0; n < 2; ++n) gt[bj][n] = *(const GAS f32x4*)(modl + src * 6144 + gidx * 1024 + col0 + bj * HALF + n * 4);
#pragma unroll
        for (int ai = 0; ai < 2; ++ai)
#pragma unroll
            for (int m = 0; m < 4; ++m) { const int row = row0 + ai * HALF + m * 16; float ss = 0.f;
                GAS float* xp = xlat + (size_t)row * 1024 + col0; const GAS float* xs = xsrc + (size_t)row * 1024 + col0;
#pragma unroll
                for (int bj = 0; bj < 2; ++bj)
#pragma unroll
                    for (int n = 0; n < 2; ++n) { const f32x4 xn = *(const GAS f32x4*)(xs + bj * HALF + n * 4) + gt[bj][n] * acc[ai][bj][m][n]; acc[ai][bj][m][n] = xn;
                        *(GAS f32x4*)(xp + bj * HALF + n * 4) = xn; ss += (xn[0] * xn[0] + xn[1] * xn[1]) + (xn[2] * xn[2] + xn[3] * xn[3]); }
                ss += __shfl_xor(ss, 16); ss += __shfl_xor(ss, 32);
                if (fq == 0) P[(ai * HALF + wr * 64 + m * 16 + fr) * 4 + wc] = ss; }
        asm volatile("s_waitcnt lgkmcnt(0)" ::: "memory"); __builtin_amdgcn_s_barrier(); asm volatile("" ::: "memory");
        const int rl = wid * 32 + (lane & 31);
        if (lane < 32) { const float t = (P[rl * 4 + 0] + P[rl * 4 + 1]) + (P[rl * 4 + 2] + P[rl * 4 + 3]);
            __hip_atomic_store(xbuf + ((size_t)(u.pm * BM + rl) * 4 + u.pn), __float_as_uint(t), __ATOMIC_RELAXED, __HIP_MEMORY_SCOPE_AGENT); }
        asm volatile("s_waitcnt vmcnt(0)" ::: "memory");
        if (lane == 0) __hip_atomic_fetch_add(cnt + 64 * u.pm, 1u, __ATOMIC_RELAXED, __HIP_MEMORY_SCOPE_AGENT);
        if (wid == 0) { unsigned sp = 0;
            while ((unsigned)__builtin_amdgcn_readfirstlane(__hip_atomic_load(cnt + 64 * u.pm, __ATOMIC_RELAXED, __HIP_MEMORY_SCOPE_AGENT)) < want) { __builtin_amdgcn_s_sleep(1); if (++sp > (1u << 22)) break; }
            __builtin_amdgcn_fence(__ATOMIC_ACQUIRE, "agent"); }
        asm volatile("s_waitcnt vmcnt(0) lgkmcnt(0)" ::: "memory"); __builtin_amdgcn_s_barrier(); asm volatile("" ::: "memory");
        if (lane < 32) { const unsigned* sl = xbuf + (size_t)(u.pm * BM + rl) * 4; float t = 0.f;
#pragma unroll
            for (int k = 0; k < 4; ++k) t += __uint_as_float(__hip_atomic_load(sl + k, __ATOMIC_RELAXED, __HIP_MEMORY_SCOPE_AGENT));
            S[rl] = 1.0f / sqrtf(t * (1.0f / 1024.0f) + 1e-6f); }
        asm volatile("s_waitcnt vmcnt(0) lgkmcnt(0)" ::: "memory"); __builtin_amdgcn_s_barrier(); asm volatile("" ::: "memory");
        const GAS float* shp = modn + src * 6144 + shidx * 1024 + col0; const GAS float* scp = modn + src * 6144 + scidx * 1024 + col0; const GAS float* nwp = normw + col0;
#pragma unroll
        for (int bj = 0; bj < 2; ++bj) { const int co = bj * HALF;
            const f32x4 gm0 = *(const GAS f32x4*)(nwp + co) * (*(const GAS f32x4*)(scp + co) + 1.0f), sh0 = *(const GAS f32x4*)(shp + co);
            const f32x4 gm1 = *(const GAS f32x4*)(nwp + co + 4) * (*(const GAS f32x4*)(scp + co + 4) + 1.0f), sh1 = *(const GAS f32x4*)(shp + co + 4);
#pragma unroll
            for (int ai = 0; ai < 2; ++ai)
#pragma unroll
                for (int m = 0; m < 4; ++m) { const int rloc = ai * HALF + wr * 64 + m * 16 + fr; const float rinv = S[rloc];
                    const f32x4 h0 = acc[ai][bj][m][0] * rinv * gm0 + sh0, h1 = acc[ai][bj][m][1] * rinv * gm1 + sh1;
                    u32x4 w; w.x = cvt_pk_bf16(h0[0], h0[1]); w.y = cvt_pk_bf16(h0[2], h0[3]); w.z = cvt_pk_bf16(h1[0], h1[1]); w.w = cvt_pk_bf16(h1[2], h1[3]);
                    *(GAS u32x4*)(Hout + (size_t)(u.pm * BM + rloc) * 1024 + col0 + co) = w; } }
    }
};
struct EpiSwiGLU {
    static constexpr bool PERM = true, AFTER_DRAIN = false, HAS_HOOK = false;
    GAS bf16_t* HFF;
    __device__ __forceinline__ void operator()(const f32x4 (&acc)[2][2][4][2], const Unit& u, int wr, int wc, int fr, int fq) const {
        const int row0 = u.pm * BM + wr * 64 + fr, col0 = u.pn * HALF + wc * 32 + 8 * fq;
#pragma unroll
        for (int ai = 0; ai < 2; ++ai)
#pragma unroll
            for (int m = 0; m < 4; ++m) { const size_t row = (size_t)(row0 + ai * HALF + m * 16);
                const f32x4 a0 = acc[ai][0][m][0], a1 = acc[ai][0][m][1], b0 = acc[ai][1][m][0], b1 = acc[ai][1][m][1];
                f32x4 h0, h1;
#pragma unroll
                for (int j = 0; j < 4; ++j) { h0[j] = a0[j] * sigmoid_f(a0[j]) * b0[j]; h1[j] = a1[j] * sigmoid_f(a1[j]) * b1[j]; }
                u32x4 w; w.x = cvt_pk_bf16(h0[0], h0[1]); w.y = cvt_pk_bf16(h0[2], h0[3]); w.z = cvt_pk_bf16(h1[0], h1[1]); w.w = cvt_pk_bf16(h1[2], h1[3]);
                *(GAS u32x4*)(HFF + row * 2816 + col0) = w; }
    }
};
template <class Epi, class Sched, bool ALIGN_EPI = false, bool SP2 = false>
__device__ __forceinline__ void gemm_phase(PG8_LAS unsigned char* lds, const Gemm g, const Sched& S, const Epi& E) {
    int tid_ = threadIdx.x; asm volatile("" : "+v"(tid_)); const int tid = tid_, wid = __builtin_amdgcn_readfirstlane(tid >> 6), lane = tid & 63, wr = wid >> 2, wc = wid & 3, fr = lane & 15, fq = lane >> 4;
    int K_ = g.K; asm volatile("" : "+s"(K_)); const int K = K_, nt = K / BK;
    unsigned voffA[2], voffB[2];
#pragma unroll
    for (int i = 0; i < 2; ++i) { int R, C; stage_rc(tid * 16 + i * 8192, R, C); const int Rb = Epi::PERM ? ((R & ~31) + perm32(R & 31)) : R;
        voffA[i] = (unsigned)(R * K + C) * 2u; voffB[i] = (unsigned)(Rb * K + C) * 2u; }
    const size_t kstep = (size_t)(BK * 2);
    const size_t hstep = (size_t)HALF * K * 2;
    const size_t tstep = 2 * hstep;
    const unsigned ldsw = (unsigned)wid * 1024u;
    const int aoff = lds_byte(wr * 64 + fr, fq * 8), boff = lds_byte(wc * 32 + fr, fq * 8);
#define PG8_SA(b, h) (((b) * 2 + (h)) * HTB)
#define PG8_SB(b, h) ((4 + (b) * 2 + (h)) * HTB)
#define PG8_STAGE(bufoff, gbase, voff) do { _Pragma("unroll") for (int _i = 0; _i < 2; ++_i) \
        __builtin_amdgcn_global_load_lds((const unsigned*)((const char*)(gbase) + (voff)[_i]), (PG8_LAS unsigned*)(lds + (bufoff) + ldsw + _i * 8192), 16, 0, 0); } while (0)
#define PG8_LDA(dst, b, h) do { _Pragma("unroll") for (int m = 0; m < 4; ++m) _Pragma("unroll") for (int k = 0; k < 2; ++k) dst[m][k] = *(const PG8_LAS bf16x8*)(lds + PG8_SA(b, h) + aoff + m * 2048 + k * 1024); } while (0)
#define PG8_LDB(dst, b, h) do { _Pragma("unroll") for (int n = 0; n < 2; ++n) _Pragma("unroll") for (int k = 0; k < 2; ++k) dst[n][k] = *(const PG8_LAS bf16x8*)(lds + PG8_SB(b, h) + boff + n * 2048 + k * 1024); } while (0)
#define PG8_MMA(ai, bj, At, Bt) do { __builtin_amdgcn_s_setprio(1); _Pragma("unroll") for (int m = 0; m < 4; ++m) _Pragma("unroll") for (int n = 0; n < 2; ++n) _Pragma("unroll") for (int k = 0; k < 2; ++k) \
        acc[ai][bj][m][n] = __builtin_amdgcn_mfma_f32_16x16x32_bf16(Bt[n][k], At[m][k], acc[ai][bj][m][n], 0, 0, 0); __builtin_amdgcn_s_setprio(0); } while (0)
#define PG8_WAIT_V(n) asm volatile("s_waitcnt vmcnt(" #n ")" ::: "memory")
#define PG8_WAIT_L(n) asm volatile("s_waitcnt lgkmcnt(" #n ")" ::: "memory")
#define PG8_BAR __builtin_amdgcn_s_barrier()
#define PG8_SCHED __builtin_amdgcn_sched_barrier(0)
    Unit cur, nxt; int ui = 0;
    if (!S.next(0, cur)) return;
    f32x4 acc[2][2][4][2];
#pragma unroll
    for (int a = 0; a < 2; ++a)
#pragma unroll
        for (int b = 0; b < 2; ++b)
#pragma unroll
            for (int m = 0; m < 4; ++m)
#pragma unroll
                for (int n = 0; n < 2; ++n) acc[a][b][m][n] = (f32x4){0.f, 0.f, 0.f, 0.f};
    bf16x8 At[4][2], B0[2][2], B1[2][2];
    const char* cA = (const char*)g.A + (size_t)cur.pm * tstep; const char* cB = (const char*)g.Bt + (size_t)cur.pn * tstep;
    S.a_ready(cur);
    if constexpr (SP2) {
        PG8_STAGE(PG8_SB(0, 0), cB, voffB); PG8_STAGE(PG8_SB(0, 1), cB + hstep, voffB); PG8_STAGE(PG8_SA(0, 0), cA, voffA); PG8_STAGE(PG8_SA(0, 1), cA + hstep, voffA);
        if (wr == 1) PG8_BAR;
        PG8_WAIT_V(2); PG8_BAR;
        PG8_STAGE(PG8_SB(1, 0), cB + kstep, voffB); PG8_STAGE(PG8_SA(1, 0), cA + kstep, voffA); PG8_STAGE(PG8_SB(1, 1), cB + hstep + kstep, voffB);
        PG8_WAIT_V(6); PG8_BAR;
    } else {
        PG8_STAGE(PG8_SB(0, 0), cB, voffB); PG8_STAGE(PG8_SA(0, 0), cA, voffA); PG8_STAGE(PG8_SB(0, 1), cB + hstep, voffB); PG8_STAGE(PG8_SA(0, 1), cA + hstep, voffA);
        if (wr == 1) PG8_BAR;
        PG8_WAIT_V(4); PG8_BAR;
        PG8_STAGE(PG8_SB(1, 0), cB + kstep, voffB); PG8_STAGE(PG8_SA(1, 0), cA + kstep, voffA); PG8_STAGE(PG8_SB(1, 1), cB + hstep + kstep, voffB);
        PG8_WAIT_V(6); PG8_BAR;
    }
    for (;;) {
        const bool has_next = S.next(ui + 1, nxt);
        const char* nA = has_next ? (const char*)g.A + (size_t)nxt.pm * tstep : cA; const char* nB = has_next ? (const char*)g.Bt + (size_t)nxt.pn * tstep : cB;
        for (int t = 0; t < nt; t += 2) {
            if constexpr (Epi::HAS_HOOK) { if (t == Epi::T1 || t == Epi::T2) E.hook(acc, cur, t, wr, wc, fr, fq); }
            const bool last = (t == nt - 2);
            const char* a1 = cA + (size_t)(t + 1) * kstep;
            const char* a2 = last ? nA : cA + (size_t)(t + 2) * kstep; const char* b2 = last ? nB : cB + (size_t)(t + 2) * kstep;
            const char* a3 = a2 + kstep; const char* b3 = b2 + kstep;
            if (last && has_next) S.a_ready(nxt);
            if constexpr (SP2) {
            PG8_LDB(B0, 0, 0); PG8_LDB(B1, 0, 1); PG8_SCHED; PG8_LDA(At, 0, 0); PG8_STAGE(PG8_SA(1, 1), a1 + hstep, voffA);
            PG8_WAIT_V(8); PG8_WAIT_L(0); PG8_BAR; PG8_MMA(0, 0, At, B0); PG8_MMA(0, 1, At, B1); PG8_BAR; PG8_SCHED;
            PG8_LDA(At, 0, 1); PG8_STAGE(PG8_SB(0, 0), b2, voffB); PG8_STAGE(PG8_SB(0, 1), b2 + hstep, voffB); PG8_STAGE(PG8_SA(0, 0), a2, voffA);
            PG8_WAIT_V(8); PG8_WAIT_L(0); PG8_BAR; PG8_MMA(1, 0, At, B0); PG8_MMA(1, 1, At, B1); PG8_BAR; PG8_SCHED;
            PG8_LDB(B0, 1, 0); PG8_LDB(B1, 1, 1); PG8_SCHED; PG8_LDA(At, 1, 0); PG8_STAGE(PG8_SA(0, 1), a2 + hstep, voffA);
            PG8_WAIT_V(8); PG8_WAIT_L(0); PG8_BAR; PG8_MMA(0, 0, At, B0); PG8_MMA(0, 1, At, B1); PG8_BAR; PG8_SCHED;
            PG8_LDA(At, 1, 1); PG8_STAGE(PG8_SB(1, 0), b3, voffB); PG8_STAGE(PG8_SB(1, 1), b3 + hstep, voffB); PG8_STAGE(PG8_SA(1, 0), a3, voffA);
            PG8_WAIT_V(8); PG8_WAIT_L(0); PG8_BAR; PG8_MMA(1, 0, At, B0); PG8_MMA(1, 1, At, B1); PG8_BAR; PG8_SCHED;
            } else {
            PG8_LDB(B0, 0, 0); PG8_SCHED; PG8_LDA(At, 0, 0); PG8_STAGE(PG8_SA(1, 1), a1 + hstep, voffA);
            PG8_WAIT_L(8); PG8_BAR; PG8_WAIT_L(0); PG8_MMA(0, 0, At, B0); PG8_BAR; PG8_SCHED;
            PG8_LDB(B1, 0, 1); PG8_STAGE(PG8_SB(0, 0), b2, voffB);
            PG8_BAR; PG8_WAIT_L(0); PG8_MMA(0, 1, At, B1); PG8_BAR;
            PG8_LDA(At, 0, 1); PG8_STAGE(PG8_SA(0, 0), a2, voffA);
            PG8_BAR; PG8_WAIT_L(0); PG8_MMA(1, 0, At, B0); PG8_BAR; PG8_SCHED;
            PG8_STAGE(PG8_SB(0, 1), b2 + hstep, voffB);
            PG8_WAIT_V(6); PG8_BAR; PG8_MMA(1, 1, At, B1); PG8_BAR;
            PG8_LDB(B0, 1, 0); PG8_SCHED; PG8_LDA(At, 1, 0); PG8_STAGE(PG8_SA(0, 1), a2 + hstep, voffA);
            PG8_WAIT_L(8); PG8_BAR; PG8_WAIT_L(0); PG8_MMA(0, 0, At, B0); PG8_BAR; PG8_SCHED;
            PG8_LDB(B1, 1, 1); PG8_STAGE(PG8_SB(1, 0), b3, voffB);
            PG8_BAR; PG8_WAIT_L(0); PG8_MMA(0, 1, At, B1); PG8_BAR;
            PG8_LDA(At, 1, 1); PG8_STAGE(PG8_SA(1, 0), a3, voffA);
            PG8_BAR; PG8_WAIT_L(0); PG8_MMA(1, 0, At, B0); PG8_BAR; PG8_SCHED;
            PG8_STAGE(PG8_SB(1, 1), b3 + hstep, voffB);
            PG8_WAIT_V(6); PG8_BAR; PG8_MMA(1, 1, At, B1); PG8_BAR;
            }
        }
        if constexpr (ALIGN_EPI) { if (wr == 0) PG8_BAR; }
        if constexpr (!Epi::AFTER_DRAIN) { E(acc, cur, wr, wc, fr, fq); S.done(cur); __builtin_amdgcn_s_waitcnt(0x0F70);   }
        if (!has_next) break;
#pragma unroll
        for (int a = 0; a < 2; ++a)
#pragma unroll
            for (int b = 0; b < 2; ++b)
#pragma unroll
                for (int m = 0; m < 4; ++m)
#pragma unroll
                    for (int n = 0; n < 2; ++n) acc[a][b][m][n] = (f32x4){0.f, 0.f, 0.f, 0.f};
        cur = nxt; cA = nA; cB = nB; ++ui;
        if constexpr (ALIGN_EPI) { if (wr == 1) PG8_BAR; }
    }
    PG8_WAIT_V(0);
    if constexpr (!ALIGN_EPI) { if (wr == 0) PG8_BAR; }
    PG8_BAR;
    if constexpr (Epi::AFTER_DRAIN) { E.fused(acc, cur, wr, wc, fr, fq, lds, wid, lane); S.done(cur); }
#undef PG8_SA
#undef PG8_SB
#undef PG8_STAGE
#undef PG8_LDA
#undef PG8_LDB
#undef PG8_MMA
#undef PG8_WAIT_V
#undef PG8_WAIT_L
#undef PG8_BAR
#undef PG8_SCHED
}
}
#include <hip/hip_bf16.h>
#include <cmath>
namespace attn_body {
using bf16=__hip_bfloat16;
using bf16x8=__attribute__((ext_vector_type(8)))short;
using s16x4=__attribute__((ext_vector_type(4)))short;
using f32x16=__attribute__((ext_vector_type(16)))float;
using u32x4=__attribute__((ext_vector_type(4)))unsigned;
constexpr int D=64,QP=512,KP=128,OP=1024;
constexpr int NW=8,QBLK=32,QB=QBLK*NW,KVBLK=64;
constexpr int ATTN_UNIT_ROWS=QB;
__device__ __forceinline__ int crow(int r,int hi){return (r&3)+8*(r>>2)+4*hi;}
#define SBAR() __builtin_amdgcn_sched_barrier(0)
__device__ __forceinline__ void cmask(f32x16&p0,f32x16&p1,int jb,int qrel,int hi){
  const float NEG=-INFINITY; int kb=64*jb+4*hi;
  #pragma unroll
  for(int r=0;r<16;++r){int kv=kb+(r&3)+8*(r>>2); if(kv>qrel)p0[r]=NEG; if(kv+32>qrel)p1[r]=NEG;}
}

constexpr int NSLOT=3, SLOTB=8192;
constexpr int LDS_K=0, LDS_V=NSLOT*SLOTB, LDS_WS=2*NSLOT*SLOTB, LDS_OST=LDS_WS+NW*64*4, LDS_BYTES=LDS_OST+NW*4096;
constexpr float C2=0.125f*1.4426950408889634f;
__device__ __forceinline__ void glds16(const void*gsrc,unsigned lds_dst){unsigned keep;
  asm volatile("s_mov_b32 %0, m0\n\ts_mov_b32 m0, %2\n\ts_nop 0\n\tglobal_load_lds_dwordx4 %1, off\n\ts_mov_b32 m0, %0":"=&s"(keep):"v"(gsrc),"s"(lds_dst):"memory");}
__device__ __forceinline__ float max3f(float a,float b,float c){float r;asm("v_max3_f32 %0, %1, %2, %3":"=v"(r):"v"(a),"v"(b),"v"(c));return r;}
__device__ __forceinline__ float max2f(float a,float b){float r;asm("v_max_f32_e32 %0, %1, %2":"=v"(r):"v"(a),"v"(b));return r;}
__device__ __forceinline__ float fadd_s(float a,float b){float r;asm("v_add_f32_e32 %0, %1, %2":"=v"(r):"v"(a),"v"(b));return r;}
__device__ __forceinline__ float fsub_s(float a,float b){float r;asm("v_sub_f32_e32 %0, %1, %2":"=v"(r):"v"(a),"v"(b));return r;}
typedef float f32x2_t __attribute__((ext_vector_type(2))); typedef __bf16 bf16x2_t __attribute__((ext_vector_type(2)));
__device__ __forceinline__ unsigned cvtpk_s(float lo,float hi){f32x2_t v={lo,hi};bf16x2_t b=__builtin_convertvector(v,bf16x2_t);return __builtin_bit_cast(unsigned,b);}
#define WAIT_BAR(N) asm volatile("s_waitcnt vmcnt(" #N ") lgkmcnt(0)\n\ts_barrier":::"memory")

__device__ __forceinline__ void qkt(f32x16&p0,f32x16&p1,const char*Kslot,const bf16x8*qr,const f32x16&negm,int r32,int hi){
  const char*kb=Kslot+hi*1024+r32*16;
  #pragma unroll
  for(int d0=0;d0<4;++d0){
    const bf16x8 b0=*reinterpret_cast<const bf16x8*>(kb+d0*2048);
    const bf16x8 b1=*reinterpret_cast<const bf16x8*>(kb+d0*2048+512);
    if(d0==0){p0=__builtin_amdgcn_mfma_f32_32x32x16_bf16(b0,qr[0],negm,0,0,0);p1=__builtin_amdgcn_mfma_f32_32x32x16_bf16(b1,qr[0],negm,0,0,0);}
    else{p0=__builtin_amdgcn_mfma_f32_32x32x16_bf16(b0,qr[d0],p0,0,0,0);p1=__builtin_amdgcn_mfma_f32_32x32x16_bf16(b1,qr[d0],p1,0,0,0);}}
}
typedef __attribute__((address_space(3))) const char* lds_cptr;
typedef short v4i16_t __attribute__((ext_vector_type(4)));
__device__ __forceinline__ void kload8(bf16x8*kf,lds_cptr kp){
  kf[0]=*(const __attribute__((address_space(3))) bf16x8*)(kp);      kf[1]=*(const __attribute__((address_space(3))) bf16x8*)(kp+512);
  kf[2]=*(const __attribute__((address_space(3))) bf16x8*)(kp+2048); kf[3]=*(const __attribute__((address_space(3))) bf16x8*)(kp+2560);
  kf[4]=*(const __attribute__((address_space(3))) bf16x8*)(kp+4096); kf[5]=*(const __attribute__((address_space(3))) bf16x8*)(kp+4608);
  kf[6]=*(const __attribute__((address_space(3))) bf16x8*)(kp+6144); kf[7]=*(const __attribute__((address_space(3))) bf16x8*)(kp+6656);
}
__device__ __forceinline__ void kload2(bf16x8*kf,lds_cptr kp,int j){ kf[2*j]=*(const __attribute__((address_space(3))) bf16x8*)(kp+j*2048); kf[2*j+1]=*(const __attribute__((address_space(3))) bf16x8*)(kp+j*2048+512); }
__device__ __forceinline__ s16x4 vtr(lds_cptr p){ return __builtin_bit_cast(s16x4,__builtin_amdgcn_ds_read_tr16_b64_v4i16((__attribute__((address_space(3))) v4i16_t*)p)); }
__device__ __forceinline__ float rowmax(const f32x16&p0,const f32x16&p1){
  float a=max3f(p0[0],p0[1],p1[0]),b=max3f(p0[2],p0[3],p1[1]);a=max3f(a,p1[2],p1[3]);
  #pragma unroll
  for(int r=4;r<16;r+=4){a=max3f(a,p0[r],p0[r+1]);b=max3f(b,p0[r+2],p0[r+3]);a=max3f(a,p1[r],p1[r+1]);b=max3f(b,p1[r+2],p1[r+3]);}
  const float m=max2f(a,b);
  auto rr=__builtin_amdgcn_permlane32_swap(__float_as_uint(m),__float_as_uint(m),false,false);
  return max2f(__uint_as_float(rr[0]),__uint_as_float(rr[1]));
}
__device__ __forceinline__ void pv(f32x16*o,int vb,bf16x8 pa0,bf16x8 pa1,bf16x8 pa2,bf16x8 pa3){
  #pragma unroll
  for(int d0=0;d0<2;++d0){s16x4 lo[4],hi[4];
    #pragma unroll
    for(int ks=0;ks<4;++ks){
      asm volatile("ds_read_b64_tr_b16 %0,%1 offset:%c2":"=&v"(lo[ks]):"v"(vb),"i"(d0*4096+ks*1024):"memory");
      asm volatile("ds_read_b64_tr_b16 %0,%1 offset:%c2":"=&v"(hi[ks]):"v"(vb),"i"(d0*4096+ks*1024+512):"memory");}
    asm volatile("s_waitcnt lgkmcnt(0)":::"memory");SBAR();
    #define PK(k) (bf16x8){lo[k][0],lo[k][1],lo[k][2],lo[k][3],hi[k][0],hi[k][1],hi[k][2],hi[k][3]}
    o[d0]=__builtin_amdgcn_mfma_f32_32x32x16_bf16(pa0,PK(0),o[d0],0,0,0);
    o[d0]=__builtin_amdgcn_mfma_f32_32x32x16_bf16(pa1,PK(1),o[d0],0,0,0);
    o[d0]=__builtin_amdgcn_mfma_f32_32x32x16_bf16(pa2,PK(2),o[d0],0,0,0);
    o[d0]=__builtin_amdgcn_mfma_f32_32x32x16_bf16(pa3,PK(3),o[d0],0,0,0);
    #undef PK
  }
}

#ifndef ATTN_STORE16
#define ATTN_STORE16(p,v) (*(u32x4*)(p)=(v))
#endif
template<int THRL,bool NOMAX> __device__ __forceinline__ void attn_unit(long qrow0,int h,long kvrow0,int NT,const bf16*Q,const bf16*__restrict__ K,const bf16*__restrict__ V,bf16*O,char*shm){
  int tid_=threadIdx.x; asm volatile("":"+v"(tid_)); const int tid=tid_,lane=tid&63,r32=lane&31,hi=lane>>5; const int wid=__builtin_amdgcn_readfirstlane(tid>>6);
  const bf16*Qw=Q+(qrow0+wid*QBLK)*QP+h*D;
  const bf16*Kh=K+kvrow0*KP+(h>>2)*D,*Vh=V+kvrow0*KP+(h>>2)*D;
  const unsigned lds0=(unsigned)(uintptr_t)shm;
  float*wsf=(float*)(shm+LDS_WS)+wid*64;
  const bf16*ksrc=Kh+(long)lane*KP+wid*8;
  const bf16*vsrc=Vh+(long)(16*(wid&3)+(lane>>2))*KP+(wid>>2)*32+(lane&3)*8;
  const unsigned kdst=lds0+LDS_K+wid*1024, vdst=lds0+LDS_V+wid*1024;
  #define DMA_K(t,slot) glds16(ksrc+(long)(t)*KVBLK*KP,(unsigned)__builtin_amdgcn_readfirstlane(kdst+(slot)))
  #define DMA_V(t,slot) glds16(vsrc+(long)(t)*KVBLK*KP,(unsigned)__builtin_amdgcn_readfirstlane(vdst+(slot)))
  const int vb0=(int)(lds0+LDS_V)+((lane>>4)&1)*32+(lane&3)*8+(4*hi+((lane&15)>>2))*64;
  const char*Kbase=shm+LDS_K; bf16x8 kf[8];
  const lds_cptr shm3=(lds_cptr)shm; const lds_cptr kp0=shm3+LDS_K+hi*1024+r32*16; const lds_cptr vp0=shm3+LDS_V+((lane>>4)&1)*32+(lane&3)*8+(4*hi+((lane&15)>>2))*64;
  DMA_K(0,0);DMA_V(0,0);DMA_K(1,SLOTB);
  bf16x8 qr[4];
  #pragma unroll
  for(int d0=0;d0<4;++d0)qr[d0]=*reinterpret_cast<const bf16x8*>(&Qw[(long)r32*QP+d0*16+hi*8]);
  float mhat=0.f,l_reg=0.f;f32x16 o[2];o[0]=f32x16{};o[1]=f32x16{};f32x16 negm=f32x16{};asm volatile("":"+v"(negm));
  #define CMASK(P0,P1,t) do{}while(0)
  bool resc=false;
  #define START(P0,P1) do{ resc=false; if constexpr(!NOMAX) \
    { const float rm=rowmax(P0,P1); const float dl=rm; mhat=fadd_s(mhat,dl); \
      _Pragma("unroll") for(int r=0;r<16;++r){P0[r]=fsub_s(P0[r],dl);P1[r]=fsub_s(P1[r],dl);} \
      _Pragma("unroll") for(int r=0;r<16;++r)negm[r]=-mhat; asm volatile("":"+v"(negm)); } \
    _Pragma("unroll") for(int r=0;r<16;++r)P0[r]=__builtin_amdgcn_exp2f(P0[r]); }while(0)
  #define RESC() do{ if constexpr(!NOMAX) if(resc){ asm volatile("s_waitcnt lgkmcnt(0)":::"memory"); \
      _Pragma("unroll") for(int d_=0;d_<2;++d_) _Pragma("unroll") for(int r=0;r<16;++r)o[d_][r]*=wsf[crow(r,hi)]; } }while(0)
  f32x16 pA0,pA1,pB0,pB1;
  int sl_prev=0,sl_cur=0,sl_next=SLOTB;
  #define ROT() do{sl_prev=sl_cur;sl_cur=sl_next;sl_next=(sl_next==(NSLOT-1)*SLOTB)?0:sl_next+SLOTB;}while(0)
  DMA_K(2,2*SLOTB);
  WAIT_BAR(3);
  qkt(pA0,pA1,Kbase,qr,negm,r32,hi);asm volatile("s_nop 15\n\ts_nop 7":"+v"(pA0),"+v"(pA1));CMASK(pA0,pA1,0);
  START(pA0,pA1);
  _Pragma("unroll") for(int r=0;r<16;++r)pA1[r]=__builtin_amdgcn_exp2f(pA1[r]);
  WAIT_BAR(0);
  DMA_K(3,0);DMA_V(1,SLOTB);
  ROT();
  kload8(kf,kp0+sl_cur);
  WAIT_BAR(2);
  s16x4 vlo[8],vhi[8]; u32x4 pw0,pw1,pw2,pw3;
  #define PKW(P,B) cvtpk_s(P[B],P[B+1])
  #define PAF(k) __builtin_bit_cast(bf16x8,pw##k)
  #define VFR(i) (bf16x8){vlo[i][0],vlo[i][1],vlo[i][2],vlo[i][3],vhi[i][0],vhi[i][1],vhi[i][2],vhi[i][3]}
  #define PIN(x) asm volatile("":"+v"(x))
  #define MX3(a,b,c) __builtin_fmaxf(__builtin_fmaxf((a),(b)),(c))
  #define GAPA(MF,A0,A1,A2,A3,W0,W1,PW) do{ MF; sacc+=A0; sacc+=A1; sacc+=A2; sacc+=A3; PIN(sacc); W0; W1; PIN(PW); SBAR(); }while(0)
  #define EX(v) __builtin_amdgcn_exp2f(v)
  #define GAPB(MF,X,B) do{ MF; X[B]=EX(X[B]); X[B+1]=EX(X[B+1]); X[B+2]=EX(X[B+2]); X[B+3]=EX(X[B+3]); PIN(X); SBAR(); }while(0)
  #define VRD(i) do{ vlo[i]=vtr(vp_+(((i)>>2)*4096+((i)&3)*1024)); vhi[i]=vtr(vp_+(((i)>>2)*4096+((i)&3)*1024+512)); }while(0)
  #define KRD(G,j) do{ if(G){ kload2(kf,kp0+sl_next,j); SBAR(); } }while(0)
  #define STEP(C0,C1,P0,P1,t,GK,GV,GL) do{ SBAR(); \
    const lds_cptr vp_=vp0+sl_prev; \
    VRD(0); SBAR(); float sacc=(P0[0]+P0[1]); \
    GAPA(C0=__builtin_amdgcn_mfma_f32_32x32x16_bf16(kf[0],qr[0],negm,0,0,0), P0[2],P0[3],P0[4],P0[5],     pw0[0]=PKW(P0,0), pw0[1]=PKW(P0,2), pw0); \
    VRD(4); SBAR(); GAPA(C1=__builtin_amdgcn_mfma_f32_32x32x16_bf16(kf[1],qr[0],negm,0,0,0), P0[6],P0[7],P0[8],P0[9],     pw0[2]=PKW(P0,4), pw0[3]=PKW(P0,6), pw0); \
    VRD(1); SBAR(); GAPA(C0=__builtin_amdgcn_mfma_f32_32x32x16_bf16(kf[2],qr[1],C0,0,0,0),   P0[10],P0[11],P0[12],P0[13], pw1[0]=PKW(P0,8), pw1[1]=PKW(P0,10), pw1); \
    VRD(5); SBAR(); GAPA(C1=__builtin_amdgcn_mfma_f32_32x32x16_bf16(kf[3],qr[1],C1,0,0,0),   P0[14],P0[15],P1[0],P1[1],   pw1[2]=PKW(P0,12),pw1[3]=PKW(P0,14), pw1); \
    VRD(2); SBAR(); GAPA(C0=__builtin_amdgcn_mfma_f32_32x32x16_bf16(kf[4],qr[2],C0,0,0,0),   P1[2],P1[3],P1[4],P1[5],     pw2[0]=PKW(P1,0), pw2[1]=PKW(P1,2), pw2); \
    VRD(6); SBAR(); GAPA(C1=__builtin_amdgcn_mfma_f32_32x32x16_bf16(kf[5],qr[2],C1,0,0,0),   P1[6],P1[7],P1[8],P1[9],     pw2[2]=PKW(P1,4), pw2[3]=PKW(P1,6), pw2); \
    VRD(3); SBAR(); GAPA(C0=__builtin_amdgcn_mfma_f32_32x32x16_bf16(kf[6],qr[3],C0,0,0,0),   P1[10],P1[11],P1[12],P1[13], pw3[0]=PKW(P1,8), pw3[1]=PKW(P1,10), pw3); \
    VRD(7); SBAR(); GAPA(C1=__builtin_amdgcn_mfma_f32_32x32x16_bf16(kf[7],qr[3],C1,0,0,0),   P1[14],P1[15],0.f,0.f,       pw3[2]=PKW(P1,12),pw3[3]=PKW(P1,14), pw3); \
    l_reg+=sacc; \
    if(GK){DMA_K((t)+3,sl_cur);} if(GV){DMA_V((t)+1,sl_next);} \
    CMASK(C0,C1,t); \
    if constexpr(!NOMAX){ float a=MX3(C0[0],C0[1],C1[0]),b=MX3(C0[2],C0[3],C1[1]); a=MX3(a,C1[2],C1[3]); \
      _Pragma("unroll") for(int r=4;r<16;r+=4){a=MX3(a,C0[r],C0[r+1]);b=MX3(b,C0[r+2],C0[r+3]);a=MX3(a,C1[r],C1[r+1]);b=MX3(b,C1[r+2],C1[r+3]);} \
      float rm=__builtin_fmaxf(a,b); { auto rr=__builtin_amdgcn_permlane32_swap(__float_as_uint(rm),__float_as_uint(rm),false,false); rm=__builtin_fmaxf(__uint_as_float(rr[0]),__uint_as_float(rr[1])); } \
      resc=false; \
      if(__builtin_expect(__any(rm>(float)THRL),0)){ const float dl=__builtin_fmaxf(rm,0.f); mhat+=dl; \
        _Pragma("unroll") for(int r=0;r<16;++r){C0[r]-=dl;C1[r]-=dl;} \
        _Pragma("unroll") for(int r=0;r<16;++r)negm[r]=-mhat; asm volatile("":"+v"(negm)); \
        const float f=__builtin_amdgcn_exp2f(-dl); l_reg*=f; if(hi==0)wsf[r32]=f; resc=true; } } \
    SBAR(); \
    GAPB(o[0]=__builtin_amdgcn_mfma_f32_32x32x16_bf16(PAF(0),VFR(0),o[0],0,0,0), C0,0); \
    GAPB(o[1]=__builtin_amdgcn_mfma_f32_32x32x16_bf16(PAF(0),VFR(4),o[1],0,0,0), C0,4); \
    KRD(GL,0); GAPB(o[0]=__builtin_amdgcn_mfma_f32_32x32x16_bf16(PAF(1),VFR(1),o[0],0,0,0), C0,8); \
    KRD(GL,1); GAPB(o[1]=__builtin_amdgcn_mfma_f32_32x32x16_bf16(PAF(1),VFR(5),o[1],0,0,0), C0,12); \
    KRD(GL,2); GAPB(o[0]=__builtin_amdgcn_mfma_f32_32x32x16_bf16(PAF(2),VFR(2),o[0],0,0,0), C1,0); \
    KRD(GL,3); GAPB(o[1]=__builtin_amdgcn_mfma_f32_32x32x16_bf16(PAF(2),VFR(6),o[1],0,0,0), C1,4); \
    GAPB(o[0]=__builtin_amdgcn_mfma_f32_32x32x16_bf16(PAF(3),VFR(3),o[0],0,0,0), C1,8); \
    GAPB(o[1]=__builtin_amdgcn_mfma_f32_32x32x16_bf16(PAF(3),VFR(7),o[1],0,0,0), C1,12); \
    }while(0)
  int t=1;
  #undef CMASK
  #define CMASK(P0,P1,t) do{}while(0)
  for(;t+5<NT;t+=2){
    STEP(pB0,pB1,pA0,pA1,t,true,true,true);     WAIT_BAR(2); RESC(); ROT();
    STEP(pA0,pA1,pB0,pB1,t+1,true,true,true);   WAIT_BAR(2); RESC(); ROT();
  }
  #undef CMASK
  #define CMASK(P0,P1,t) do{}while(0)
  #define ENDW(tt) do{ if((tt)+3<NT){WAIT_BAR(2);} else if((tt)+2<NT){WAIT_BAR(1);} else {WAIT_BAR(0);} }while(0)
  for(;t+1<NT;t+=2){
    STEP(pB0,pB1,pA0,pA1,t,(t+3<NT),(t+1<NT),(t+1<NT));       ENDW(t);   RESC(); ROT();
    STEP(pA0,pA1,pB0,pB1,t+1,(t+4<NT),(t+2<NT),(t+2<NT));     ENDW(t+1); RESC(); ROT();
  }
  STEP(pB0,pB1,pA0,pA1,NT-1,false,false,false); RESC();
  { float sacc=pB0[0]+pB0[1]; _Pragma("unroll") for(int r=2;r<16;++r)sacc+=pB0[r]; _Pragma("unroll") for(int r=0;r<16;++r)sacc+=pB1[r]; l_reg+=sacc;
    pw0=(u32x4){PKW(pB0,0),PKW(pB0,2),PKW(pB0,4),PKW(pB0,6)};pw1=(u32x4){PKW(pB0,8),PKW(pB0,10),PKW(pB0,12),PKW(pB0,14)};pw2=(u32x4){PKW(pB1,0),PKW(pB1,2),PKW(pB1,4),PKW(pB1,6)};pw3=(u32x4){PKW(pB1,8),PKW(pB1,10),PKW(pB1,12),PKW(pB1,14)};
    SBAR(); pv(o,vb0+sl_cur,PAF(0),PAF(1),PAF(2),PAF(3)); }
  #undef PKW
  #undef PAF
  #undef VFR
  #undef PIN
  #undef MX3
  #undef GAPA
  #undef GAPB
  #undef EX
  #undef VRD
  #undef KRD
  #undef STEP
  #undef ENDW
  {auto rr=__builtin_amdgcn_permlane32_swap(__float_as_uint(l_reg),__float_as_uint(l_reg),false,false);l_reg=__uint_as_float(rr[0])+__uint_as_float(rr[1]);}
  if(hi==0)wsf[32+r32]=l_reg;asm volatile("s_waitcnt lgkmcnt(0)":::"memory");
  float rli[16];
  #pragma unroll
  for(int r=0;r<16;++r)rli[r]=__builtin_amdgcn_rcpf(wsf[32+crow(r,hi)]);
  bf16*Ow=O+(qrow0+wid*QBLK)*OP+h*D;
  { bf16*stg=(bf16*)(shm+LDS_OST)+wid*2048;
    #pragma unroll
    for(int r=0;r<16;++r){const int orow=crow(r,hi);
      #pragma unroll
      for(int d0=0;d0<2;++d0)stg[orow*64+d0*32+r32]=__float2bfloat16(o[d0][r]*rli[r]);}
    asm volatile("s_waitcnt lgkmcnt(0)":::"memory");
    #pragma unroll
    for(int i=0;i<4;++i){const int row=i*8+(lane>>3),ch=lane&7; const u32x4 v=*(const u32x4*)(stg+row*64+ch*8); ATTN_STORE16(Ow+(long)row*OP+ch*8,v);} }
  asm volatile("s_waitcnt lgkmcnt(0)\n\ts_barrier":::"memory");
  #undef DMA_K
  #undef DMA_V
  #undef CMASK
  #undef START
  #undef RESC
  #undef ROT
}
constexpr int ATTN_LDS_BYTES=LDS_BYTES;
#undef SBAR
#undef WAIT_BAR
}
#define LAS __attribute__((address_space(3)))
#define INP(i) ((const GAS float*)a.in[i])
typedef unsigned short bf16;
typedef unsigned v4u __attribute__((ext_vector_type(4)));
typedef unsigned v2u __attribute__((ext_vector_type(2)));
typedef float f32x4 __attribute__((ext_vector_type(4)));
#ifndef DUP_S
#define DUP_S -1
#endif
#ifndef DUP_ATT
#define DUP_ATT 1
#endif
#ifndef DUP_SG
#define DUP_SG 1
#endif
#ifndef TIME_S
#define TIME_S -1
#endif
#ifndef TIME_MASK
#define TIME_MASK (TIME_S == 10 ? 0x1ff : (1 << (TIME_S < 0 ? 0 : TIME_S)))
#endif
#ifndef MK_MULTI
#define MK_MULTI 0
#endif
constexpr int NWAVES = 8, NTHREADS = 512;
constexpr int DMODEL = 1024, DEPTH = 4, ML = 16384, MC = 512, MT = ML + MC;
constexpr int INW = 5120, DFF = 2816, NMODW = 6144;
constexpr int NPHASE = 1 + 8 * DEPTH;
constexpr size_t MiB = 1u << 20;
constexpr size_t WS_MOD = 0, WS_COS = 1 * MiB, WS_SIN = 2 * MiB, WS_CTX = 3 * MiB, WS_W = 6 * MiB, WS_H = 38 * MiB, WS_Q = 72 * MiB, WS_K = 89 * MiB, WS_V = 94 * MiB,
                 WS_ZA = 99 * MiB, WS_ZB = 108 * MiB, WS_ZC = 125 * MiB, WS_ZF = 134 * MiB, WS_P = 200 * MiB;
constexpr size_t P_CONV = 0, P_SG = (size_t)MT * 768 * 2, P_G = P_SG + (size_t)MT * 512 * 2, WS_END = WS_P + P_G + (size_t)MT * 3072 * 2;
constexpr size_t WS_W2 = 342 * MiB, WS_END2 = WS_W2 + 32 * MiB;
static_assert(WS_END <= WS_W2, "ws map 3");
constexpr size_t WO_IN = 0, WO_A = WO_IN + 5120 * 1024  , WO_O = WO_A + 1024 * 1024, WO_13 = WO_O + 1024 * 1024,
                 WO_2 = WO_13 + 5632 * 1024, WO_END = WO_2 + 1024 * 2816;
static_assert(WO_END * 2 <= 32 * MiB && (size_t)MT * 1024 * 2 <= 34 * MiB && (size_t)MT * 1024 * 4 <= 66 * MiB && (size_t)MT * 2816 * 2 <= WS_END - WS_P, "ws map");
constexpr int LDS_BYTES = 147456;

__device__ __forceinline__ unsigned f2bf(float f) { unsigned u = __builtin_bit_cast(unsigned, f); return (u + 0x7fffu + ((u >> 16) & 1u)) >> 16; }
__device__ __forceinline__ unsigned pk2(float lo, float hi) { return f2bf(lo) | (f2bf(hi) << 16); }
__device__ __forceinline__ float bflo(unsigned w) { return __uint_as_float(w << 16); }
__device__ __forceinline__ float bfhi(unsigned w) { return __uint_as_float(w & 0xffff0000u); }
__device__ __forceinline__ float wave_sum(float v) {
#pragma unroll
    for (int o = 1; o < 64; o <<= 1) v += __shfl_xor(v, o);
    return v;
}
__device__ __forceinline__ int inproj_src_col(int nn) {
    if (nn >= 256 && nn < 768) { const int q = nn - 256, tile = q >> 8, p = q & 255; return 256 + (p >> 7) * 256 + tile * 128 + (p & 127); }
    if (nn < 768 || nn >= 1536) return nn;
    const int q = nn - 768, tile = q >> 8, p = q & 255, bj = p >> 7, wc = (p >> 5) & 3, fq = (p >> 3) & 3, n = (p >> 2) & 1, j = p & 3;
    return 768 + tile * 256 + wc * 64 + 32 * bj + 16 * n + 4 * fq + j;
}
template <int MODE> __device__ __forceinline__ void transpose_item(const GAS float* W, const GAS float* W3, int K, int N, GAS bf16* WT, LAS float* scr, int item, int nblk, int lane, int dpitch = 0, int koff = 0) {
    if (dpitch == 0) dpitch = K;
    const int kb = item / nblk, nb = item % nblk, k0 = 64 * kb, n0 = 32 * nb, nn = n0 + (lane & 31);
    const GAS float* src;
    if (MODE == 0) src = W + nn;
    else if (MODE == 1) src = W + inproj_src_col(nn);
    else { const int tile = nn >> 8, p = nn & 255; src = ((p >> 7) ? W3 : W) + 128 * tile + (p & 127); }
#pragma unroll 8
    for (int i = 0; i < 32; ++i) { const int kk = 2 * i + (lane >> 5); scr[kk * 33 + (lane & 31)] = src[(size_t)(k0 + kk) * N]; }
    asm volatile("s_waitcnt lgkmcnt(0)" ::: "memory");
    const int c = lane & 7;
#pragma unroll
    for (int j = 0; j < 4; ++j) { const int n = (lane >> 3) + 8 * j; const LAS float* s = scr + (8 * c) * 33 + n;
        v4u o; o.x = pk2(s[0 * 33], s[1 * 33]); o.y = pk2(s[2 * 33], s[3 * 33]); o.z = pk2(s[4 * 33], s[5 * 33]); o.w = pk2(s[6 * 33], s[7 * 33]);
        *(GAS v4u*)(WT + (size_t)(n0 + n) * dpitch + koff + k0 + 8 * c) = o; }
    asm volatile("s_waitcnt lgkmcnt(0)" ::: "memory");
}
typedef GAS unsigned gu32;
#define RLX_AGENT __ATOMIC_RELAXED, __HIP_MEMORY_SCOPE_AGENT
#define XB_TMO      128
#define XB_XCNT(j)  (256  + 64 * (j))
#define XB_XSUB(j)  (1280 + 64 * (j))
#define XB_XGEN(j)  (2304 + 64 * (j))
#define XB_TOP      3328
#define XB_TOPGEN   3392
#define XCD_BAR_WORDS 3456
#define XB_SPIN_CAP (1u << 18)

__device__ __forceinline__ unsigned xb_ld(unsigned* p)              { return __hip_atomic_load(p, __ATOMIC_RELAXED, __HIP_MEMORY_SCOPE_AGENT); }
__device__ __forceinline__ unsigned xb_add(unsigned* p, unsigned v) { return __hip_atomic_fetch_add(p, v, __ATOMIC_RELAXED, __HIP_MEMORY_SCOPE_AGENT); }
__device__ __forceinline__ unsigned xb_xcc_id() { return (unsigned)__builtin_amdgcn_s_getreg((3 << 11) | 20) & 0xFu; }
#define XB_SPIN(cond, bar) do { unsigned _sp = 0; while (cond) { __builtin_amdgcn_s_sleep(1); \
    if ((++_sp & 255u) == 0u) { if (xb_ld(&(bar)[XB_TMO])) break; if (_sp > XB_SPIN_CAP) { atomicAdd(&(bar)[XB_TMO], 1u); break; } } } } while (0)

struct XcdBarrier {
    unsigned* bar; unsigned x;
    volatile LAS unsigned* st;
};

__device__ __forceinline__ XcdBarrier xcd_barrier_post(unsigned* bar, volatile LAS unsigned* st) {
    XcdBarrier b; b.bar = bar; b.x = xb_xcc_id(); b.st = st;
    if (threadIdx.x == 0) (void)xb_add(&bar[XB_XCNT(b.x)], 1u);
    return b;
}
__device__ __forceinline__ void xcd_barrier_complete(unsigned* bar, unsigned x, unsigned& nloc, unsigned& nx) {
    const unsigned G = gridDim.x * gridDim.y * gridDim.z;
    unsigned sum, cnt, mine, sp = 0u;
    for (;;) {
        sum = 0u; cnt = 0u; mine = 0u;
#pragma unroll
        for (unsigned j = 0; j < 16; ++j) { const unsigned c = xb_ld(&bar[XB_XCNT(j)]); sum += c; cnt += (c > 0u) ? 1u : 0u; mine = (j == x) ? c : mine; }
        if (sum == G) break;
        __builtin_amdgcn_s_sleep(1);
        if ((++sp & 255u) == 0u) { if (xb_ld(&bar[XB_TMO])) break; if (sp > XB_SPIN_CAP) { atomicAdd(&bar[XB_TMO], 1u); break; } }
    }
    nloc = mine > 0u ? mine : 1u; nx = cnt > 0u ? cnt : 1u;
}

__device__ __forceinline__ void xcd_barrier(const XcdBarrier& b) {
    asm volatile("s_waitcnt vmcnt(0)" ::: "memory");
    __syncthreads();
    if (threadIdx.x == 0) {
        unsigned* bar = b.bar;
        __builtin_amdgcn_s_waitcnt(0);
        unsigned nloc = b.st[0], nx = b.st[1];
        if (nloc == 0u) { xcd_barrier_complete(bar, b.x, nloc, nx); b.st[0] = nloc; b.st[1] = nx; }
        const unsigned old = xb_add(&bar[XB_XSUB(b.x)], 1u);
        const unsigned gen = old / nloc;
        if (old + 1u == (gen + 1u) * nloc) {
            __builtin_amdgcn_fence(__ATOMIC_RELEASE, "agent");
            asm volatile("s_waitcnt vmcnt(0)" ::: "memory");
            const unsigned og = xb_add(&bar[XB_TOP], 1u);
            const unsigned tg = og / nx;
            if (og + 1u == (tg + 1u) * nx) xb_add(&bar[XB_TOPGEN], 1u);
            else XB_SPIN(xb_ld(&bar[XB_TOPGEN]) == tg, bar);
            __builtin_amdgcn_fence(__ATOMIC_ACQUIRE, "agent");
            xb_add(&bar[XB_XGEN(b.x)], 1u);
            asm volatile("s_waitcnt vmcnt(0)" ::: "memory");
        } else {
            XB_SPIN(xb_ld(&bar[XB_XGEN(b.x)]) == gen, bar);
            __builtin_amdgcn_fence(__ATOMIC_ACQUIRE, "agent");
            asm volatile("s_waitcnt vmcnt(0)" ::: "memory");
        }
    }
    __syncthreads();
}

constexpr size_t WS_BAR = 512 * 1024, BAR_BYTES = 16384 + 16384 + 4096;
constexpr size_t WS_XCNT = WS_BAR + 16384, WS_XCNTC = WS_BAR + 32768  , WS_XBUF = 640 * 1024, WS_XBUFC = 896 * 1024  ;
static_assert(WS_XBUFC + 512 * 32 * 4 <= MiB, "ws map 5");
static_assert(WS_XBUF + (size_t)ML * 16 <= MiB, "ws map 4");
constexpr int LDS_BARST = 131072 + 64;

typedef short cbf16x8 __attribute__((ext_vector_type(8)));
typedef float cf32x16 __attribute__((ext_vector_type(16)));
__device__ __forceinline__ cf32x16 ctx_seg(const GAS bf16* Arow, const GAS bf16* Brow, int kbeg, int kend) {
    cf32x16 acc; for (int r = 0; r < 16; ++r) acc[r] = 0.f;
#pragma unroll 8
    for (int k = kbeg; k < kend; k += 16) { const cbf16x8 av = *(const GAS cbf16x8*)(Arow + k), bv = *(const GAS cbf16x8*)(Brow + k);
        acc = __builtin_amdgcn_mfma_f32_32x32x16_bf16(bv, av, acc, 0, 0, 0); }
    return acc;
}
__device__ __forceinline__ void ctx_reduce(cf32x16& tot, LAS float* red, int wave, int lane) {
    const int q = wave & 3, tsel = wave >> 2;
    LAS float* mine = red + ((tsel * 4 + q) * 64 + lane) * 16;
    if (q != 0) {
#pragma unroll
        for (int r = 0; r < 16; r += 4) *(LAS f32x4*)(mine + r) = (f32x4){tot[r], tot[r + 1], tot[r + 2], tot[r + 3]}; }
    __syncthreads();
    if (q == 0) {
#pragma unroll
        for (int p = 1; p < 4; ++p)
#pragma unroll
            for (int r = 0; r < 16; r += 4) { const f32x4 v = *(const LAS f32x4*)(red + ((tsel * 4 + p) * 64 + lane) * 16 + r); tot[r] += v[0]; tot[r + 1] += v[1]; tot[r + 2] += v[2]; tot[r + 3] += v[3]; } }
    __syncthreads();
}
struct Args { const float* in[22]; float* out; unsigned char* ws; int ph_lo, ph_hi; };

__global__ void __launch_bounds__(NTHREADS, 2) fwd_kernel(Args a) {
    extern __shared__ __attribute__((aligned(16))) unsigned char lds[];
#define PTRS() \
    int tid_ = threadIdx.x; asm volatile("" : "+v"(tid_)); const int tid = tid_, lane = tid & 63, wave = __builtin_amdgcn_readfirstlane(tid >> 6); \
    int bx = blockIdx.x, G = gridDim.x; asm volatile("" : "+s"(bx), "+s"(G)); const int vcu = (G % 8 == 0) ? (bx % 8) * (G / 8) + bx / 8 : bx; (void)vcu; (void)tid; \
    const int gw = bx * NWAVES + wave, NGW = G * NWAVES; (void)gw; (void)NGW; (void)lane; \
    GAS unsigned char* wsr_ = (GAS unsigned char*)a.ws; asm volatile("" : "+s"(wsr_)); GAS unsigned char* const ws = (GAS unsigned char*)wsr_; \
    GAS float* const modv = (GAS float*)(ws + WS_MOD); GAS float* const cosT = (GAS float*)(ws + WS_COS); GAS float* const sinT = (GAS float*)(ws + WS_SIN); GAS float* const xctx = (GAS float*)(ws + WS_CTX); \
    GAS bf16* const Wb = (GAS bf16*)(ws + ((((ph - 1) >> 3) & 1) ? WS_W2 : WS_W)); GAS bf16* const Wn = (GAS bf16*)(ws + ((((ph - 1) >> 3) & 1) ? WS_W : WS_W2)); (void)Wn; GAS bf16* const H = (GAS bf16*)(ws + WS_H); GAS bf16* const Qb = (GAS bf16*)(ws + WS_Q); GAS bf16* const Kb = (GAS bf16*)(ws + WS_K); GAS bf16* const Vb = (GAS bf16*)(ws + WS_V); \
    GAS bf16* const Zcat = (GAS bf16*)(ws + WS_ZA);      GAS float* const ZF = (GAS float*)(ws + WS_ZF); \
    GAS bf16* const PCONV = (GAS bf16*)(ws + WS_P + P_CONV); GAS bf16* const PSG = (GAS bf16*)(ws + WS_P + P_SG); GAS bf16* const PG = (GAS bf16*)(ws + WS_P + P_G); GAS bf16* const HFF = (GAS bf16*)(ws + WS_P); \
    GAS bf16* const Zb = H; GAS float* const xlat = (GAS float*)a.out; LAS unsigned char* const ldsl = (LAS unsigned char*)lds; \
    (void)modv; (void)cosT; (void)sinT; (void)xctx; (void)Wb; (void)Qb; (void)Kb; (void)Vb; (void)Zcat; (void)ZF; (void)PCONV; (void)PSG; (void)PG; (void)HFF; (void)Zb; (void)xlat; (void)ldsl; \
    const int l = (ph - 1) >> 3; const bool last = (l == DEPTH - 1); const GAS float* const modl = modv + (size_t)l * 3 * NMODW; const int Mrows = last ? ML : MT; (void)modl; (void)Mrows; (void)last;

#define CONVERT_WEIGHTS(l, Wd, gw0_, ngw_) do { \
        LAS float* scr = (LAS float*)ldsl + wave * (64 * 33); \
        for (int it = (gw0_); it < 7808; it += (ngw_)) { int r = it; \
            if (r < 2560) { transpose_item<1>(INP(7) + (size_t)(l) * 1024 * INW, nullptr, 1024, INW, (Wd) + WO_IN, scr, r, 160, lane); continue; } r -= 2560; \
            if (r < 128) { transpose_item<0>(INP(14) + (size_t)(l) * 256 * 1024, nullptr, 256, 1024, (Wd) + WO_A, scr, r, 32, lane, 1024, 0); continue; } r -= 128; \
            if (r < 256) { transpose_item<0>(INP(15) + (size_t)(l) * 512 * 1024, nullptr, 512, 1024, (Wd) + WO_A, scr, r, 32, lane, 1024, 256); continue; } r -= 256; \
            if (r < 128) { transpose_item<0>(INP(16) + (size_t)(l) * 256 * 1024, nullptr, 256, 1024, (Wd) + WO_A, scr, r, 32, lane, 1024, 768); continue; } r -= 128; \
            if (r < 512) { transpose_item<0>(INP(17) + (size_t)(l) * 1024 * 1024, nullptr, 1024, 1024, (Wd) + WO_O, scr, r, 32, lane); continue; } r -= 512; \
            if (r < 2816) { transpose_item<2>(INP(19) + (size_t)(l) * 1024 * DFF, INP(20) + (size_t)(l) * 1024 * DFF, 1024, DFF, (Wd) + WO_13, scr, r, 176, lane); continue; } r -= 2816; \
            transpose_item<0>(INP(21) + (size_t)(l) * DFF * 1024, nullptr, DFF, 1024, (Wd) + WO_2, scr, r, 32, lane); } \
        __syncthreads(); } while (0)

#define NORM_ROWS(xsrc_, normw, modl, shidx, scidx, r0_, nrows) do { \
        for (int r = (r0_) + gw; r < (nrows); r += NGW) { const bool latent = r < ML; const GAS float* xrow = latent ? (xsrc_) + (size_t)r * 1024 : xctx + (size_t)(r - ML) * 1024; \
            const int src = latent ? (r >> 13) : 2; const GAS float* shp = (modl) + src * NMODW + (shidx) * 1024; const GAS float* scp = (modl) + src * NMODW + (scidx) * 1024; \
            f32x4 v[4]; float ss = 0.f; \
            _Pragma("unroll") for (int j = 0; j < 4; ++j) { v[j] = *((const GAS f32x4*)xrow + lane + 64 * j); ss += (v[j][0] * v[j][0] + v[j][1] * v[j][1]) + (v[j][2] * v[j][2] + v[j][3] * v[j][3]); } \
            const float rinv = 1.0f / sqrtf(wave_sum(ss) * (1.0f / 1024.0f) + 1e-6f); \
            _Pragma("unroll") for (int j = 0; j < 4; ++j) { const f32x4 gg = *((const GAS f32x4*)(normw) + lane + 64 * j), s4 = *((const GAS f32x4*)scp + lane + 64 * j), h4 = *((const GAS f32x4*)shp + lane + 64 * j); \
                const f32x4 o = v[j] * rinv * gg * (s4 + 1.0f) + h4; v2u w; w.x = pk2(o[0], o[1]); w.y = pk2(o[2], o[3]); *((GAS v2u*)(H + (size_t)r * 1024) + lane + 64 * j) = w; } } } while (0)


#define CTX_MERGE() do { \
        for (int tile0 = bx * 2; tile0 < 512; tile0 += 2 * G) { const int tile = tile0 + (wave >> 2), q = wave & 3, r32 = lane & 31, hi = lane >> 5; \
            const int row0 = ML + (tile >> 5) * 32, col0 = (tile & 31) * 32; const size_t arow = (size_t)(row0 + r32); \
            cf32x16 tot; \
            { const cf32x16 sa = ctx_seg(Zcat + arow * 1024 + 8 * hi, Wb + WO_A + (size_t)(col0 + r32) * 1024 + 8 * hi, q * 64, q * 64 + 64); \
              const cf32x16 sb = ctx_seg(Zcat + arow * 1024 + 256 + 8 * hi, Wb + WO_A + (size_t)(col0 + r32) * 1024 + 256 + 8 * hi, q * 128, q * 128 + 128); \
              const cf32x16 sc = ctx_seg(Zcat + arow * 1024 + 768 + 8 * hi, Wb + WO_A + (size_t)(col0 + r32) * 1024 + 768 + 8 * hi, q * 64, q * 64 + 64); \
              _Pragma("unroll") for (int qq = 0; qq < 4; ++qq) { const GAS bf16* gp = PG + arow * 3072 + col0 + 8 * qq + 4 * hi; \
                  const v2u ga = *(const GAS v2u*)gp, gb = *(const GAS v2u*)(gp + 1024), gc = *(const GAS v2u*)(gp + 2048); \
                  tot[4 * qq + 0] = bflo(ga.x) * sa[4 * qq + 0] + bflo(gb.x) * sb[4 * qq + 0] + bflo(gc.x) * sc[4 * qq + 0]; \
                  tot[4 * qq + 1] = bfhi(ga.x) * sa[4 * qq + 1] + bfhi(gb.x) * sb[4 * qq + 1] + bfhi(gc.x) * sc[4 * qq + 1]; \
                  tot[4 * qq + 2] = bflo(ga.y) * sa[4 * qq + 2] + bflo(gb.y) * sb[4 * qq + 2] + bflo(gc.y) * sc[4 * qq + 2]; \
                  tot[4 * qq + 3] = bfhi(ga.y) * sa[4 * qq + 3] + bfhi(gb.y) * sb[4 * qq + 3] + bfhi(gc.y) * sc[4 * qq + 3]; } } \
            ctx_reduce(tot, (LAS float*)ldsl, wave, lane); \
            if (q == 0) { _Pragma("unroll") for (int qq = 0; qq < 4; ++qq) { v2u o; o.x = pk2(tot[4 * qq], tot[4 * qq + 1]); o.y = pk2(tot[4 * qq + 2], tot[4 * qq + 3]); \
                *(GAS v2u*)(Zb + arow * 1024 + col0 + 8 * qq + 4 * hi) = o; } } } } while (0)
#define CTX_RESID(Aptr, lda_, Woff, gidx_, NRM_, normw_, modn_, shidx_, scidx_, want_) do { \
        for (int tile0 = bx * 2; tile0 < 512; tile0 += 2 * G) { const int tile = tile0 + (wave >> 2), q = wave & 3, r32 = lane & 31, hi = lane >> 5; \
            const int row0 = ML + (tile >> 5) * 32, col0 = (tile & 31) * 32; const size_t arow = (size_t)(row0 + r32); \
            cf32x16 tot = ctx_seg((Aptr) + arow * (lda_) + 8 * hi, Wb + (Woff) + (size_t)(col0 + r32) * (lda_) + 8 * hi, q * ((lda_) / 4), (q + 1) * ((lda_) / 4)); \
            ctx_reduce(tot, (LAS float*)ldsl, wave, lane); \
            if (q == 0) { float ss = 0.f; \
                _Pragma("unroll") for (int qq = 0; qq < 4; ++qq) { const int c = col0 + 8 * qq + 4 * hi; const f32x4 gt = *(const GAS f32x4*)(modl + 2 * NMODW + (gidx_) * 1024 + c); \
                    GAS f32x4* xp = (GAS f32x4*)(xctx + (arow - ML) * 1024 + c); const f32x4 xn = *xp + gt * (f32x4){tot[4 * qq], tot[4 * qq + 1], tot[4 * qq + 2], tot[4 * qq + 3]}; *xp = xn; \
                    tot[4 * qq] = xn[0]; tot[4 * qq + 1] = xn[1]; tot[4 * qq + 2] = xn[2]; tot[4 * qq + 3] = xn[3]; ss += (xn[0] * xn[0] + xn[1] * xn[1]) + (xn[2] * xn[2] + xn[3] * xn[3]); } \
                if (NRM_) {     \
                    unsigned* slots = (unsigned*)(ws + WS_XBUFC); unsigned* cntc = (unsigned*)(ws + WS_XCNTC) + 64 * (tile >> 5); \
                    ss += __shfl_xor(ss, 32); \
                    if (hi == 0) __hip_atomic_store(slots + (arow - ML) * 32 + (tile & 31), __float_as_uint(ss), __ATOMIC_RELAXED, __HIP_MEMORY_SCOPE_AGENT); \
                    asm volatile("s_waitcnt vmcnt(0)" ::: "memory"); \
                    if (lane == 0) __hip_atomic_fetch_add(cntc, 1u, __ATOMIC_RELAXED, __HIP_MEMORY_SCOPE_AGENT); \
                    { unsigned sp = 0; while ((unsigned)__builtin_amdgcn_readfirstlane(__hip_atomic_load(cntc, __ATOMIC_RELAXED, __HIP_MEMORY_SCOPE_AGENT)) < (want_)) { __builtin_amdgcn_s_sleep(1); if (++sp > (1u << 22)) break; } } \
                    __builtin_amdgcn_fence(__ATOMIC_ACQUIRE, "agent"); \
                    float tsum = 0.f; \
                    _Pragma("unroll 8") for (int k = 0; k < 32; ++k) tsum += __uint_as_float(__hip_atomic_load(slots + (arow - ML) * 32 + k, __ATOMIC_RELAXED, __HIP_MEMORY_SCOPE_AGENT)); \
                    const float rinv = 1.0f / sqrtf(tsum * (1.0f / 1024.0f) + 1e-6f); \
                    _Pragma("unroll") for (int qq = 0; qq < 4; ++qq) { const int c = col0 + 8 * qq + 4 * hi; \
                        const f32x4 gm = *(const GAS f32x4*)((normw_) + c) * (*(const GAS f32x4*)((modn_) + 2 * NMODW + (scidx_) * 1024 + c) + 1.0f), sh = *(const GAS f32x4*)((modn_) + 2 * NMODW + (shidx_) * 1024 + c); \
                        const f32x4 hh = (f32x4){tot[4 * qq], tot[4 * qq + 1], tot[4 * qq + 2], tot[4 * qq + 3]} * rinv * gm + sh; \
                        v2u w; w.x = pk2(hh[0], hh[1]); w.y = pk2(hh[2], hh[3]); *(GAS v2u*)(H + arow * 1024 + c) = w; } } } } } while (0)

    const bool fused_ = (a.ph_hi - a.ph_lo) > 1;
    { volatile LAS unsigned* st_ = (volatile LAS unsigned*)((LAS unsigned char*)lds + LDS_BARST); if (threadIdx.x == 0) { st_[0] = 0u; st_[1] = 0u; } __syncthreads(); }
    XcdBarrier bar; bar.bar = (unsigned*)(a.ws + WS_BAR); bar.x = 0; bar.st = (volatile LAS unsigned*)((LAS unsigned char*)lds + LDS_BARST);
    if (fused_) bar = xcd_barrier_post((unsigned*)(a.ws + WS_BAR), (volatile LAS unsigned*)((LAS unsigned char*)lds + LDS_BARST));
    unsigned long long tacc_ = 0ull, tph_ = 0ull; (void)tph_;
#if DUP_S >= 0 && DUP_S != 9
    for (int it_ = a.ph_lo * 2; it_ < a.ph_hi * 2; ++it_) { const int ph = it_ >> 1;
      const bool dupm_ = (ph == 0 && DUP_S == 8) || (ph >= 1 && ((ph - 1) & 7) == DUP_S);
      if (!(it_ & 1) || dupm_) {
#else
    for (int ph = a.ph_lo; ph < a.ph_hi; ++ph) { const int it_ = (gridDim.x == 256 && ph >= 1 && (((ph - 1) & 7) == 5 || (((ph - 1) & 7) == 0 && ph > 1))) ? 0 : 1; if (it_) {
#endif
        if (TIME_S >= 0) { tph_ = __builtin_amdgcn_s_memrealtime(); asm volatile("s_waitcnt lgkmcnt(0)" : "+s"(tph_) :: "memory"); }
        if (ph == 0) { PTRS();
            if (bx < 192) {
                typedef float f32x2_ __attribute__((ext_vector_type(2)));
                LAS float* sil = (LAS float*)ldsl + 8 * 64 * 33; LAS float* red = sil + 3072;
                for (int i = tid; i < 3072; i += NTHREADS) { const int src = i >> 10, k = i & 1023; const float v = src < 2 ? INP(1)[src * 1024 + k] : INP(3)[k]; sil[i] = v / (1.0f + expf(-v)); }
                __syncthreads();
                const int j0 = bx * 128, l = j0 / NMODW, jj = j0 % NMODW;
                const GAS float* Wm = INP(4) + (size_t)l * 1024 * NMODW + jj + 2 * lane;
                f32x2_ a0 = {0.f, 0.f}, a1 = a0, a2 = a0;
#pragma unroll 8
                for (int k = wave * 128; k < wave * 128 + 128; ++k) { const f32x2_ w = *(const GAS f32x2_*)(Wm + (size_t)k * NMODW); a0 += w * sil[k]; a1 += w * sil[1024 + k]; a2 += w * sil[2048 + k]; }
#pragma unroll
                for (int j = 0; j < 2; ++j) { red[(wave * 3 + 0) * 128 + 2 * lane + j] = a0[j]; red[(wave * 3 + 1) * 128 + 2 * lane + j] = a1[j]; red[(wave * 3 + 2) * 128 + 2 * lane + j] = a2[j]; }
                __syncthreads();
                for (int i = tid; i < 384; i += NTHREADS) { const int src = i >> 7, ci = i & 127; float s = INP(5)[l * NMODW + jj + ci];
#pragma unroll
                    for (int w = 0; w < 8; ++w) s += red[(w * 3 + src) * 128 + ci];
                    modv[(l * 3 + src) * NMODW + jj + ci] = s; }
                __syncthreads();
            }
            CONVERT_WEIGHTS(0, (GAS bf16*)(ws + WS_W), gw, NGW);
            { const int gt = bx * NTHREADS + tid, NT_ = G * NTHREADS;
              const GAS f32x4* c4 = (const GAS f32x4*)INP(2); GAS f32x4* oc4 = (GAS f32x4*)xctx;
              for (int i = gt; i < MC * 1024 / 4; i += NT_) oc4[i] = c4[i];
              for (int i = gt; i < 8192 * 32; i += NT_) { const int t = i >> 5, ax = (i >> 4) & 1, f = i & 15; const float pos = (float)(ax ? (t & 63) : (t >> 6));
                  const float invf = powf(10000.0f, -(float)(2 * f) / 32.0f); const float ang = pos * invf; cosT[i] = cosf(ang); sinT[i] = sinf(ang); } }
        } else {
            const int s = (ph - 1) & 7;
            if (s == 0) { PTRS();
                NORM_ROWS((l == 0 ? INP(0) : (const GAS float*)xlat), INP(6) + l * 1024, modl, 0, 1, ((l > 0 && G == 256) ? ML : 0), MT);
            } else if (s == 1) { PTRS();
                pg8::Gemm g{(const pg8::bf16_t*)H, (const pg8::bf16_t*)(Wb + WO_IN), MT, INW, 1024}; pg8::StaticOrder S; S.init(MT, INW, G, bx);
                pg8::EpiInProj E{PCONV, Qb, Kb, Vb, PSG, PG, INP(8) + l * 64, INP(9) + l * 64, cosT, sinT};
                pg8::gemm_phase<pg8::EpiInProj, pg8::StaticOrder, true, true>(ldsl, g, S, E);
                if (!last) { const int nbusy = (MT / 256) * (INW / 256) - ((MT / 256) * (INW / 256) / G) * G;
                    if (G - nbusy >= G / 2) { if (bx >= nbusy) CONVERT_WEIGHTS(l + 1, Wn, (bx - nbusy) * NWAVES + wave, (G - nbusy) * NWAVES); } else CONVERT_WEIGHTS(l + 1, Wn, gw, NGW); }
            } else if (s == 2) { PTRS();
                for (int ra_ = 0; ra_ < DUP_ATT; ++ra_) {
                const int upb = (512 + G - 1) / G;
                float mq_ = __builtin_fabsf(INP(8)[l * 64 + lane]), mk_ = __builtin_fabsf(INP(9)[l * 64 + lane]);
#pragma unroll
                for (int o = 1; o < 64; o <<= 1) { mq_ = __builtin_fmaxf(mq_, __shfl_xor(mq_, o)); mk_ = __builtin_fmaxf(mk_, __shfl_xor(mk_, o)); }
                const bool nomax = __builtin_amdgcn_readfirstlane((int)(64.0f * attn_body::C2 * mq_ * mk_ < 48.0f)) != 0;
                for (int i = 0;; ++i) { long qrow0_, kvrow0_; int h_, nt_;
                    if (i < upb) { const int uid = vcu * upb + i; if (uid >= 512) continue;
                        const int bhk = uid >> 7, rem = uid & 127, hg = rem >> 5, qb = rem & 31, b = bhk >> 1; h_ = (bhk & 1) * 4 + hg; qrow0_ = (long)b * 8192 + qb * 256; kvrow0_ = (long)b * 8448; nt_ = 132; }
                    else { const int uid = vcu + (i - upb) * G; if (last || uid >= 16) break; const int b = uid >> 3; h_ = uid & 7; qrow0_ = (long)ML + b * 256; kvrow0_ = (long)b * 8448 + 8192; nt_ = 4; }
                    if (nomax) attn_body::attn_unit<8, true>(qrow0_, h_, kvrow0_, nt_, (const attn_body::bf16*)Qb, (const attn_body::bf16*)Kb, (const attn_body::bf16*)Vb, (attn_body::bf16*)(Zcat + 256), (char*)lds);
                    else attn_body::attn_unit<8, false>(qrow0_, h_, kvrow0_, nt_, (const attn_body::bf16*)Qb, (const attn_body::bf16*)Kb, (const attn_body::bf16*)Vb, (attn_body::bf16*)(Zcat + 256), (char*)lds); }
                }
                __syncthreads();
                for (int rs_ = 0; rs_ < DUP_SG; ++rs_) {
                { const GAS float* cw = INP(10) + l * 768 + 4 * lane; const f32x4 w0 = *(const GAS f32x4*)cw, w1 = *(const GAS f32x4*)(cw + 256), w2 = *(const GAS f32x4*)(cw + 512);
#pragma unroll 4
                  for (int r = gw; r < Mrows; r += NGW) { const bool latent = r < ML; const int pos = latent ? (r & 8191) : ((r - ML) & 255), len = latent ? 8192 : 256;
                      const GAS bf16* p = PCONV + (size_t)r * 512 + 4 * lane;
                      const v2u ab = *(const GAS v2u*)p, q0 = *(const GAS v2u*)(p + 256);
                      v2u qm = {0u, 0u}, qp = qm;
                      if (pos > 0) qm = *(const GAS v2u*)(p - 512 + 256);
                      if (pos < len - 1) qp = *(const GAS v2u*)(p + 512 + 256);
                      const f32x4 pm = {bflo(qm.x), bfhi(qm.x), bflo(qm.y), bfhi(qm.y)}, p0 = {bflo(q0.x), bfhi(q0.x), bflo(q0.y), bfhi(q0.y)}, pp = {bflo(qp.x), bfhi(qp.x), bflo(qp.y), bfhi(qp.y)};
                      const f32x4 av = {bflo(ab.x), bfhi(ab.x), bflo(ab.y), bfhi(ab.y)};
                      const f32x4 o = av * (w0 * pm + w1 * p0 + w2 * pp);
                      v2u w; w.x = pk2(o[0], o[1]); w.y = pk2(o[2], o[3]); *(GAS v2u*)(Zcat + (size_t)r * 1024 + 4 * lane) = w; } }
                { typedef short bf16x8_t __attribute__((ext_vector_type(8))); typedef float f32x16_t __attribute__((ext_vector_type(16)));
                  LAS unsigned short* VT = (LAS unsigned short*)ldsl;
                  const int nitems = (Mrows / 128) * 4;
                  for (int item = bx; item < nitems; item += G) { const int chunk = item >> 2, g = item & 3, rb = chunk * 128;
                      { const int sub = lane >> 4, li = lane & 15;
#pragma unroll
                        for (int i = 0; i < 4; ++i) { const int srow = 16 * wave + 4 * i + sub; const GAS bf16* sp = PSG + (size_t)(rb + srow) * 512 + 256 + 16 * li;
                            const v4u r0 = *(const GAS v4u*)sp, r1 = *(const GAS v4u*)(sp + 8);
                            const float fv[16] = {bflo(r0.x), bfhi(r0.x), bflo(r0.y), bfhi(r0.y), bflo(r0.z), bfhi(r0.z), bflo(r0.w), bfhi(r0.w), bflo(r1.x), bfhi(r1.x), bflo(r1.y), bfhi(r1.y), bflo(r1.z), bfhi(r1.z), bflo(r1.w), bfhi(r1.w)};
                            float ss = 0.f;
#pragma unroll
                            for (int j = 0; j < 16; ++j) ss += fv[j] * fv[j];
                            ss += __shfl_xor(ss, 1); ss += __shfl_xor(ss, 2); ss += __shfl_xor(ss, 4); ss += __shfl_xor(ss, 8);
                            const float rinv = 1.0f / sqrtf(ss * (1.0f / 256.0f) + 1e-6f);
                            if ((li >> 2) == g) { const int d0 = 16 * (li & 3); const GAS float* gp_ = INP(11) + l * 256 + g * 64 + d0;
#pragma unroll
                                for (int j4 = 0; j4 < 4; ++j4) { const f32x4 gn = *(const GAS f32x4*)(gp_ + 4 * j4);
#pragma unroll
                                    for (int j = 0; j < 4; ++j) VT[(d0 + 4 * j4 + j) * 136 + srow] = (unsigned short)f2bf(fv[4 * j4 + j] * rinv * gn[j]); } } } }
                      __syncthreads();
                      const int tm = wave >> 1, tn = wave & 1, r32 = lane & 31, hi = lane >> 5;
                      const GAS float* Wrow = INP(12) + (size_t)(l * 4 + g) * 128 * 128 + (size_t)(32 * tm + r32) * 128 + 8 * hi;
                      const LAS unsigned short* Vrow = VT + (32 * tn + r32) * 136 + 8 * hi;
                      f32x16_t acc; for (int r = 0; r < 16; ++r) acc[r] = 0.f;
#pragma unroll
                      for (int k0 = 0; k0 < 8; ++k0) { const f32x4 w0 = *(const GAS f32x4*)(Wrow + 16 * k0), w1 = *(const GAS f32x4*)(Wrow + 16 * k0 + 4);
                          const v4u wp = {pk2(w0[0], w0[1]), pk2(w0[2], w0[3]), pk2(w1[0], w1[1]), pk2(w1[2], w1[3])};
                          const bf16x8_t af = *(const LAS bf16x8_t*)(Vrow + 16 * k0);
                          acc = __builtin_amdgcn_mfma_f32_32x32x16_bf16(af, __builtin_bit_cast(bf16x8_t, wp), acc, 0, 0, 0); }
                      const int t = 32 * tm + r32; const float bias = INP(13)[(l * 4 + g) * 128 + t]; const size_t row = (size_t)(rb + t);
#pragma unroll
                      for (int q = 0; q < 4; ++q) { const int dcol = g * 64 + 32 * tn + 8 * q + 4 * hi;
                          const v2u uu = *(const GAS v2u*)(PSG + row * 512 + dcol);
                          v2u o; o.x = pk2(bflo(uu.x) * (acc[4 * q + 0] + bias), bfhi(uu.x) * (acc[4 * q + 1] + bias)); o.y = pk2(bflo(uu.y) * (acc[4 * q + 2] + bias), bfhi(uu.y) * (acc[4 * q + 3] + bias));
                          *(GAS v2u*)(Zcat + row * 1024 + 768 + dcol) = o; }
                      __syncthreads(); } }
                }
            } else if (s == 3) { PTRS();
                pg8::StaticOrder S; S.init(ML, 1024, G, bx);
                { pg8::Gemm g{(const pg8::bf16_t*)Zcat, (const pg8::bf16_t*)(Wb + WO_A), ML, 1024, 1024}; pg8::EpiMergeFused E{PG, Zb}; pg8::gemm_phase<pg8::EpiMergeFused, pg8::StaticOrder, true, true>(ldsl, g, S, E); }
                if (!last) CTX_MERGE();
            } else if (s == 4) { PTRS();
                pg8::Gemm g{(const pg8::bf16_t*)Zb, (const pg8::bf16_t*)(Wb + WO_O), ML, 1024, 1024}; pg8::StaticOrder S; S.init(ML, 1024, G, bx);
                if (G == 256) { pg8::EpiResidNorm E{(l == 0 ? INP(0) : (const GAS float*)xlat), xlat, modl, 2, H, INP(18) + l * 1024, modl, 3, 4, (unsigned*)(ws + WS_XBUF), (unsigned*)(ws + WS_XCNT), 32u * (unsigned)(2 * l + 1)};
                    pg8::gemm_phase<pg8::EpiResidNorm, pg8::StaticOrder, false, true>(ldsl, g, S, E); }
                else { pg8::EpiResid E{(l == 0 ? INP(0) : (const GAS float*)xlat), xlat, xctx, modl, 2}; pg8::gemm_phase<pg8::EpiResid, pg8::StaticOrder, true, true>(ldsl, g, S, E); }
                if (!last) { if (G == 256) CTX_RESID(Zb, 1024, WO_O, 2, 1, INP(18) + l * 1024, modl, 3, 4, 32u * (unsigned)(2 * l + 1)); else CTX_RESID(Zb, 1024, WO_O, 2, 0, INP(18), modl, 3, 4, 0u); }
            } else if (s == 5) { PTRS();
                NORM_ROWS((const GAS float*)xlat, INP(18) + l * 1024, modl, 3, 4, (G == 256 ? ML : 0), Mrows);
            } else if (s == 6) { PTRS();
                pg8::Gemm g{(const pg8::bf16_t*)H, (const pg8::bf16_t*)(Wb + WO_13), Mrows, 2 * DFF, 1024}; pg8::StaticOrder S; S.init(Mrows, 2 * DFF, G, bx);
                pg8::EpiSwiGLU E{HFF}; pg8::gemm_phase<pg8::EpiSwiGLU, pg8::StaticOrder, true, true>(ldsl, g, S, E);
            } else { PTRS();
                pg8::Gemm g{(const pg8::bf16_t*)HFF, (const pg8::bf16_t*)(Wb + WO_2), ML, 1024, DFF}; pg8::StaticOrder S; S.init(ML, 1024, G, bx);
                if (G == 256 && !last) { pg8::EpiResidNorm E{(const GAS float*)xlat, xlat, modl, 5, H, INP(6) + (l + 1) * 1024, modv + (size_t)(l + 1) * 3 * NMODW, 0, 1, (unsigned*)(ws + WS_XBUF), (unsigned*)(ws + WS_XCNT), 32u * (unsigned)(2 * l + 2)};
                    pg8::gemm_phase<pg8::EpiResidNorm, pg8::StaticOrder, false, true>(ldsl, g, S, E); }
                else { pg8::EpiResid E{(const GAS float*)xlat, xlat, xctx, modl, 5}; pg8::gemm_phase<pg8::EpiResid, pg8::StaticOrder, true, true>(ldsl, g, S, E); }
                if (!last) { if (G == 256) CTX_RESID(HFF, DFF, WO_2, 5, 1, INP(6) + (l + 1) * 1024, modv + (size_t)(l + 1) * 3 * NMODW, 0, 1, 32u * (unsigned)(2 * l + 2)); else CTX_RESID(HFF, DFF, WO_2, 5, 0, INP(6), modl, 0, 1, 0u); }
            }
        }
      }
        if ((it_ & 1) && ph + 1 < a.ph_hi) { if (a.ph_hi > NPHASE) { asm volatile("s_waitcnt vmcnt(0)" ::: "memory"); cg::this_grid().sync(); } xcd_barrier(bar); if (DUP_S == 9) xcd_barrier(bar); }
        if (TIME_S >= 0 && (((TIME_MASK) >> (ph == 0 ? 8 : ((ph - 1) & 7))) & 1)) tacc_ += __builtin_amdgcn_s_memrealtime() - tph_;
    }
    if (TIME_S >= 0 && blockIdx.x == 0) { const unsigned long long te_ = __builtin_amdgcn_s_memrealtime() + tacc_; while (__builtin_amdgcn_s_memrealtime() < te_) __builtin_amdgcn_s_sleep(8); }
}

extern "C" void kernel_launch(void* const* d_in, const int* in_sizes, int n_in, void* d_out, int out_size, void* d_ws, size_t ws_size, hipStream_t stream) {
    static int grid = 0;
    if (grid == 0) {
        if (n_in != 22 || ws_size < WS_END) { fprintf(stderr, "kernel_launch: unexpected n_in %d / ws %zu (need %zu)\n", n_in, ws_size, (size_t)WS_END); grid = -1; return; }
        int dev = 0, cus = 0, per_cu = 0;
        (void)hipGetDevice(&dev); (void)hipDeviceGetAttribute(&cus, hipDeviceAttributeMultiprocessorCount, dev);
        if (hipFuncSetAttribute((const void*)fwd_kernel, hipFuncAttributeMaxDynamicSharedMemorySize, LDS_BYTES) != hipSuccess) { fprintf(stderr, "kernel_launch: hipFuncSetAttribute failed\n"); grid = -1; return; }
        if (hipOccupancyMaxActiveBlocksPerMultiprocessor(&per_cu, (const void*)fwd_kernel, NTHREADS, LDS_BYTES) != hipSuccess || per_cu < 1) { (void)hipGetLastError(); per_cu = 1; }
        grid = cus * per_cu; if (grid <= 0) grid = 256;
    }
    if (grid < 0) return;
    (void)hipMemsetAsync((char*)d_ws + WS_BAR, 0, BAR_BYTES, stream);
    Args a{};
    for (int i = 0; i < 22; ++i) a.in[i] = (const float*)d_in[i];
    a.out = (float*)d_out; a.ws = (unsigned char*)d_ws;
#if MK_MULTI
    for (int ph = 0; ph < NPHASE; ++ph) { a.ph_lo = ph; a.ph_hi = ph + 1; hipLaunchKernelGGL(fwd_kernel, dim3(grid), dim3(NTHREADS), LDS_BYTES, stream, a); }
#else
    a.ph_lo = 0; a.ph_hi = NPHASE;
    void* args[] = {&a};
    hipError_t e = hipLaunchCooperativeKernel((const void*)fwd_kernel, dim3(grid), dim3(NTHREADS), args, LDS_BYTES, stream);
    if (e != hipSuccess) fprintf(stderr, "cooperative launch failed: %s (grid %d)\n", hipGetErrorString(e), grid);
#endif
}
```

```cpp
#include <hip/hip_runtime.h>
#include <hip/hip_cooperative_groups.h>
#include <hip/hip_bf16.h>
#include <cstdio>
#include <cstdint>
#include <cmath>
namespace cg = cooperative_groups;

namespace pg8 {
#define PG8_LAS __attribute__((address_space(3)))
typedef unsigned short bf16_t;
typedef short bf16x8 __attribute__((ext_vector_type(8)));
typedef float f32x4 __attribute__((ext_vector_type(4)));
typedef unsigned u32x4 __attribute__((ext_vector_type(4)));
constexpr int BM = 256, BK = 64, HALF = 128, HTB = HALF * BK * 2  , STAGE_BYTES = 8 * HTB, NXCD = 8, WGM = 8;

__host__ __device__ __forceinline__ int lds_byte(int r, int c) { const int st = (r >> 4) * 2 + (c >> 5), rr = r & 15, cc = c & 31, ob = rr * 64 + cc * 2; return st * 1024 + (ob ^ (((ob >> 9) & 1) << 5)); }
__host__ __device__ __forceinline__ void stage_rc(int b, int& R, int& C) { const int st = b / 1024, sb = b % 1024, swz = sb ^ (((sb >> 9) & 1) << 5); R = (st >> 1) * 16 + swz / 64; C = (st & 1) * 32 + (swz % 64) / 2; }
__host__ __device__ __forceinline__ int perm32(int rho) { const int n = rho >> 4, i = rho & 15; return 8 * (i >> 2) + 4 * n + (i & 3); }

struct Unit { int pm, pn; };
struct Gemm { const bf16_t* A; const bf16_t* Bt; int M, N, K; };

struct StaticOrder {
    int nM, nN, nwg, G, c;
    __host__ __device__ void init(int M, int N, int G_, int c_) { nM = M / BM; nN = N / BM; nwg = nM * nN; G = G_; c = c_; }
    __host__ __device__ bool next(int i, Unit& u) const {
        const long L = (long)i * G + c; if (L >= nwg) return false;
        int wgid = (int)L; { const int q = nwg / NXCD, r = nwg % NXCD, xcd = wgid % NXCD, off = wgid / NXCD; wgid = (xcd < r ? xcd * (q + 1) : r * (q + 1) + (xcd - r) * q) + off; }
        const int nig = WGM * nN, gid = wgid / nig, fm = gid * WGM, gsz = (nM - fm) < WGM ? (nM - fm) : WGM;
        u.pm = fm + ((wgid % nig) % gsz); u.pn = (wgid % nig) / gsz; return true;
    }
    __device__ __forceinline__ void a_ready(const Unit&) const {}
    __device__ __forceinline__ void done(const Unit&) const {}
};

__device__ __forceinline__ unsigned cvt_pk_bf16(float lo, float hi) { unsigned r; asm volatile("v_cvt_pk_bf16_f32 %0, %1, %2" : "=v"(r) : "v"(lo), "v"(hi)); return r; }
typedef float f32x2 __attribute__((ext_vector_type(2)));
__device__ __forceinline__ float bf_lo(unsigned w) { return __uint_as_float(w << 16); }
__device__ __forceinline__ float bf_hi(unsigned w) { return __uint_as_float(w & 0xffff0000u); }
__device__ __forceinline__ float sigmoid_f(float x) { return __builtin_amdgcn_rcpf(1.0f + __builtin_amdgcn_exp2f(-1.4426950408889634f * x)); }
__device__ __forceinline__ float gelu_tanh_f(float x) { const float in2 = 1.5957691216057308f * (x + 0.044715f * x * x * x); return x * sigmoid_f(in2); }
__device__ __forceinline__ f32x4 act4(f32x4 v, int act) {
    if (act == 1) return (f32x4){gelu_tanh_f(v[0]), gelu_tanh_f(v[1]), gelu_tanh_f(v[2]), gelu_tanh_f(v[3])};
    if (act == 2) return (f32x4){sigmoid_f(v[0]), sigmoid_f(v[1]), sigmoid_f(v[2]), sigmoid_f(v[3])};
    return v;
}
constexpr float ATT_C2 = 0.125f * 1.4426950408889634f;
typedef unsigned u32x2 __attribute__((ext_vector_type(2)));
#define GAS __attribute__((address_space(1)))
struct EpiInProj {
    static constexpr bool PERM = true, AFTER_DRAIN = false, HAS_HOOK = false;
    GAS bf16_t *PCONV, *Q, *Kb, *Vb, *PSG, *PG; const GAS float *qg, *kg, *cosT, *sinT;
    __device__ __forceinline__ void operator()(const f32x4 (&acc)[2][2][4][2], const Unit& u, int wr, int wc, int fr, int fq) const {
        const int row0 = u.pm * BM + wr * 64 + fr, pn = u.pn;
        if (pn >= 3 && pn < 6) {
            const bool isq = pn < 5, isv = (pn == 5) && (wc >= 2), latent = u.pm < 64;
            const GAS float* gp = isq ? qg : kg;
            f32x4 gn[2][2];
#pragma unroll
            for (int bj = 0; bj < 2; ++bj)
#pragma unroll
                for (int n = 0; n < 2; ++n) gn[bj][n] = *(const GAS f32x4*)(gp + 32 * bj + 16 * n + 4 * fq);
#pragma unroll
            for (int ai = 0; ai < 2; ++ai)
#pragma unroll
                for (int m = 0; m < 4; ++m) {
                    const int row = row0 + ai * HALF + m * 16;
                    f32x4 v[2][2];
#pragma unroll
                    for (int bj = 0; bj < 2; ++bj)
#pragma unroll
                        for (int n = 0; n < 2; ++n) v[bj][n] = acc[ai][bj][m][n];
                    if (!isv) {
                        float ss = 0.f;
#pragma unroll
                        for (int bj = 0; bj < 2; ++bj)
#pragma unroll
                            for (int n = 0; n < 2; ++n) { const f32x4 x = v[bj][n]; ss += (x[0] * x[0] + x[1] * x[1]) + (x[2] * x[2] + x[3] * x[3]); }
                        ss += __shfl_xor(ss, 16); ss += __shfl_xor(ss, 32);
                        const float r = (1.0f / sqrtf(ss * (1.0f / 64.0f) + 1e-6f)) * (isq ? ATT_C2 : 1.0f);
#pragma unroll
                        for (int bj = 0; bj < 2; ++bj)
#pragma unroll
                            for (int n = 0; n < 2; ++n) v[bj][n] = v[bj][n] * gn[bj][n] * r;
                        if (latent) {
                            const int t = row & 8191;
#pragma unroll
                            for (int bj = 0; bj < 2; ++bj) {
                                const f32x4 c = *(const GAS f32x4*)(cosT + t * 32 + bj * 16 + 4 * fq), s = *(const GAS f32x4*)(sinT + t * 32 + bj * 16 + 4 * fq);
                                const f32x4 x1 = v[bj][0], x2 = v[bj][1];
                                v[bj][0] = x1 * c - x2 * s; v[bj][1] = x2 * c + x1 * s;
                            }
                        }
                    }
                    GAS bf16_t* dst;
                    if (isq) dst = Q + (size_t)row * 512 + (pn - 3) * 256 + wc * 64;
                    else {
                        const int rc = row - 16384;
                        const size_t kvrow = latent ? (size_t)((row >> 13) * 8448 + (row & 8191)) : (size_t)((rc >> 8) * 8448 + 8192 + (rc & 255));
                        dst = isv ? Vb + kvrow * 128 + (wc - 2) * 64 : Kb + kvrow * 128 + wc * 64;
                    }
#pragma unroll
                    for (int bj = 0; bj < 2; ++bj)
#pragma unroll
                        for (int n = 0; n < 2; ++n) { u32x2 w; w.x = cvt_pk_bf16(v[bj][n][0], v[bj][n][1]); w.y = cvt_pk_bf16(v[bj][n][2], v[bj][n][3]);
                            *(GAS u32x2*)(dst + 32 * bj + 16 * n + 4 * fq) = w; }
                }
        } else if (pn == 1 || pn == 2) {
            const int col0 = 256 + (pn - 1) * 128 + wc * 32 + 8 * fq;
#pragma unroll
            for (int ai = 0; ai < 2; ++ai)
#pragma unroll
                for (int m = 0; m < 4; ++m) { const f32x4 v0 = acc[ai][0][m][0] * acc[ai][1][m][0], v1 = acc[ai][0][m][1] * acc[ai][1][m][1];
                    u32x4 w; w.x = cvt_pk_bf16(v0[0], v0[1]); w.y = cvt_pk_bf16(v0[2], v0[3]); w.z = cvt_pk_bf16(v1[0], v1[1]); w.w = cvt_pk_bf16(v1[2], v1[3]);
                    *(GAS u32x4*)(PCONV + (size_t)(row0 + ai * HALF + m * 16) * 512 + col0) = w; }
        } else {
            GAS bf16_t* base; int ld, colt, act;
            if (pn < 3) { base = PCONV; ld = 512; colt = 0; act = 0; }
            else if (pn < 8) { base = PSG; ld = 512; colt = (pn - 6) * 256; act = 1; }
            else { base = PG; ld = 3072; colt = (pn - 8) * 256; act = 2; }
            const int col0 = colt + wc * 32 + 8 * fq;
#pragma unroll
            for (int ai = 0; ai < 2; ++ai)
#pragma unroll
                for (int m = 0; m < 4; ++m) { GAS bf16_t* rowp = base + (size_t)(row0 + ai * HALF + m * 16) * ld + col0;
#pragma unroll
                    for (int bj = 0; bj < 2; ++bj) { const f32x4 v0 = act4(acc[ai][bj][m][0], act), v1 = act4(acc[ai][bj][m][1], act);
                        u32x4 w; w.x = cvt_pk_bf16(v0[0], v0[1]); w.y = cvt_pk_bf16(v0[2], v0[3]); w.z = cvt_pk_bf16(v1[0], v1[1]); w.w = cvt_pk_bf16(v1[2], v1[3]);
                        *(GAS u32x4*)(rowp + bj * HALF) = w; } }
        }
    }
};
struct EpiMergeFused {
    static constexpr bool PERM = true, AFTER_DRAIN = false, HAS_HOOK = true; static constexpr int T1 = 4, T2 = 12;
    const GAS bf16_t* PG; GAS bf16_t* z;
    __device__ __forceinline__ void hook(f32x4 (&acc)[2][2][4][2], const Unit& u, int t, int wr, int wc, int fr, int fq) const {
        asm volatile("" : "+v"(fr), "+v"(fq));
        const int row0 = u.pm * BM + wr * 64 + fr, col0 = u.pn * BM + wc * 32 + 8 * fq, goff = (t == T1) ? 0 : 1024;
#pragma unroll
        for (int ai = 0; ai < 2; ++ai)
#pragma unroll
            for (int m = 0; m < 4; ++m) { const size_t row = (size_t)(row0 + ai * HALF + m * 16);
#pragma unroll
                for (int bj = 0; bj < 2; ++bj) { const GAS bf16_t* gp = PG + row * 3072 + goff + col0 + bj * HALF;
                    const u32x4 gn = *(const GAS u32x4*)gp, gd = *(const GAS u32x4*)(gp + 1024);
                    const f32x4 n0 = {bf_lo(gn.x), bf_hi(gn.x), bf_lo(gn.y), bf_hi(gn.y)}, n1 = {bf_lo(gn.z), bf_hi(gn.z), bf_lo(gn.w), bf_hi(gn.w)};
                    f32x4 d0 = {bf_lo(gd.x), bf_hi(gd.x), bf_lo(gd.y), bf_hi(gd.y)}, d1 = {bf_lo(gd.z), bf_hi(gd.z), bf_lo(gd.w), bf_hi(gd.w)};
#pragma unroll
                    for (int j = 0; j < 4; ++j) { d0[j] = __builtin_amdgcn_rcpf(__builtin_fmaxf(d0[j], 1e-30f)); d1[j] = __builtin_amdgcn_rcpf(__builtin_fmaxf(d1[j], 1e-30f)); }
                    acc[ai][bj][m][0] = acc[ai][bj][m][0] * (n0 * d0); acc[ai][bj][m][1] = acc[ai][bj][m][1] * (n1 * d1); } }
    }
    __device__ __forceinline__ void operator()(const f32x4 (&acc)[2][2][4][2], const Unit& u, int wr, int wc, int fr, int fq) const {
        asm volatile("" : "+v"(fr), "+v"(fq));
        const int row0 = u.pm * BM + wr * 64 + fr, col0 = u.pn * BM + wc * 32 + 8 * fq;
#pragma unroll
        for (int ai = 0; ai < 2; ++ai)
#pragma unroll
            for (int m = 0; m < 4; ++m) { const size_t row = (size_t)(row0 + ai * HALF + m * 16);
#pragma unroll
                for (int bj = 0; bj < 2; ++bj) { const int col = col0 + bj * HALF;
                    const u32x4 gw = *(const GAS u32x4*)(PG + row * 3072 + 2048 + col);
                    const f32x4 v0 = acc[ai][bj][m][0] * (f32x4){bf_lo(gw.x), bf_hi(gw.x), bf_lo(gw.y), bf_hi(gw.y)};
                    const f32x4 v1 = acc[ai][bj][m][1] * (f32x4){bf_lo(gw.z), bf_hi(gw.z), bf_lo(gw.w), bf_hi(gw.w)};
                    u32x4 w; w.x = cvt_pk_bf16(v0[0], v0[1]); w.y = cvt_pk_bf16(v0[2], v0[3]); w.z = cvt_pk_bf16(v1[0], v1[1]); w.w = cvt_pk_bf16(v1[2], v1[3]);
                    *(GAS u32x4*)(z + row * 1024 + col) = w; } }
    }
};
struct EpiResid {
    static constexpr bool PERM = false, AFTER_DRAIN = false, HAS_HOOK = false;
    const GAS float* xsrc; GAS float* xlat; GAS float* xctx; const GAS float* modl; int gidx;
    __device__ __forceinline__ void operator()(const f32x4 (&acc)[2][2][4][2], const Unit& u, int wr, int wc, int fr, int fq) const {
        const int row0 = u.pm * BM + wr * 64 + fr, col0 = u.pn * BM + wc * 32 + 4 * fq;
        const bool latent = u.pm < 64; const int src = latent ? (u.pm >> 5) : 2;
        f32x4 gt[2][2];
#pragma unroll
        for (int bj = 0; bj < 2; ++bj)
#pragma unroll
            for (int n = 0; n < 2; ++n) gt[bj][n] = *(const GAS f32x4*)(modl + src * 6144 + gidx * 1024 + col0 + bj * HALF + n * 16);
#pragma unroll
        for (int ai = 0; ai < 2; ++ai)
#pragma unroll
            for (int m = 0; m < 4; ++m) { const int row = row0 + ai * HALF + m * 16;
                GAS float* xp = (latent ? xlat + (size_t)row * 1024 : xctx + (size_t)(row - 16384) * 1024) + col0;
                const GAS float* xs = (latent ? xsrc + (size_t)row * 1024 : xctx + (size_t)(row - 16384) * 1024) + col0;
#pragma unroll
                for (int bj = 0; bj < 2; ++bj)
#pragma unroll
                    for (int n = 0; n < 2; ++n) { *(GAS f32x4*)(xp + bj * HALF + n * 16) = *(const GAS f32x4*)(xs + bj * HALF + n * 16) + gt[bj][n] * acc[ai][bj][m][n]; } }
    }
};
struct EpiResidNorm {
    static constexpr bool PERM = true, AFTER_DRAIN = true, HAS_HOOK = false;
    const GAS float* xsrc; GAS float* xlat; const GAS float* modl; int gidx; GAS bf16_t* Hout; const GAS float* normw; const GAS float* modn; int shidx, scidx;
    unsigned* xbuf; unsigned* cnt; unsigned want;
    __device__ __forceinline__ void operator()(const f32x4 (&)[2][2][4][2], const Unit&, int, int, int, int) const {}
    __device__ __forceinline__ void fused(f32x4 (&acc)[2][2][4][2], const Unit& u, int wr, int wc, int fr, int fq, PG8_LAS unsigned char* lds, int wid, int lane) const {
        asm volatile("" : "+v"(fr), "+v"(fq));
        PG8_LAS float* P = (PG8_LAS float*)lds;
        PG8_LAS float* S = (PG8_LAS float*)(lds + 4096);
        const int row0 = u.pm * BM + wr * 64 + fr, col0 = u.pn * BM + wc * 32 + 8 * fq, src = u.pm >> 5;
        f32x4 gt[2][2];
#pragma unroll
        for (int bj = 0; bj < 2; ++bj)
#pragma unroll
            for (int n = 0; n < 2; ++n) gt[bj][n] = *(const GAS f32x4*)(modl + src * 6144 + gidx * 1024 + col0 + bj * HALF + n * 4);
#pragma unroll
        for (int ai = 0; ai < 2; ++ai)
#pragma unroll
            for (int m = 0; m < 4; ++m) { const int row = row0 + ai * HALF + m * 16; float ss = 0.f;
                GAS float* xp = xlat + (size_t)row * 1024 + col0; const GAS float* xs = xsrc + (size_t)row * 1024 + col0;
#pragma unroll
                for (int bj = 0; bj < 2; ++bj)
#pragma unroll
                    for (int n = 0; n < 2; ++n) { const f32x4 xn = *(const GAS f32x4*)(xs + bj * HALF + n * 4) + gt[bj][n] * acc[ai][bj][m][n]; acc[ai][bj][m][n] = xn;
                        *(GAS f32x4*)(xp + bj * HALF + n * 4) = xn; ss += (xn[0] * xn[0] + xn[1] * xn[1]) + (xn[2] * xn[2] + xn[3] * xn[3]); }
                ss += __shfl_xor(ss, 16); ss += __shfl_xor(ss, 32);
                if (fq == 0) P[(ai * HALF + wr * 64 + m * 16 + fr) * 4 + wc] = ss; }
        asm volatile("s_waitcnt lgkmcnt(0)" ::: "memory"); __builtin_amdgcn_s_barrier(); asm volatile("" ::: "memory");
        const int rl = wid * 32 + (lane & 31);
        if (lane < 32) { const float t = (P[rl * 4 + 0] + P[rl * 4 + 1]) + (P[rl * 4 + 2] + P[rl * 4 + 3]);
            __hip_atomic_store(xbuf + ((size_t)(u.pm * BM + rl) * 4 + u.pn), __float_as_uint(t), __ATOMIC_RELAXED, __HIP_MEMORY_SCOPE_AGENT); }
        asm volatile("s_waitcnt vmcnt(0)" ::: "memory");
        if (lane == 0) __hip_atomic_fetch_add(cnt + 64 * u.pm, 1u, __ATOMIC_RELAXED, __HIP_MEMORY_SCOPE_AGENT);
        if (wid == 0) { unsigned sp = 0;
            while ((unsigned)__builtin_amdgcn_readfirstlane(__hip_atomic_load(cnt + 64 * u.pm, __ATOMIC_RELAXED, __HIP_MEMORY_SCOPE_AGENT)) < want) { __builtin_amdgcn_s_sleep(1); if (++sp > (1u << 22)) break; }
            __builtin_amdgcn_fence(__ATOMIC_ACQUIRE, "agent"); }
        asm volatile("s_waitcnt vmcnt(0) lgkmcnt(0)" ::: "memory"); __builtin_amdgcn_s_barrier(); asm volatile("" ::: "memory");
        if (lane < 32) { const unsigned* sl = xbuf + (size_t)(u.pm * BM + rl) * 4; float t = 0.f;
#pragma unroll
            for (int k = 0; k < 4; ++k) t += __uint_as_float(__hip_atomic_load(sl + k, __ATOMIC_RELAXED, __HIP_MEMORY_SCOPE_AGENT));
            S[rl] = 1.0f / sqrtf(t * (1.0f / 1024.0f) + 1e-6f); }
        asm volatile("s_waitcnt vmcnt(0) lgkmcnt(0)" ::: "memory"); __builtin_amdgcn_s_barrier(); asm volatile("" ::: "memory");
        const GAS float* shp = modn + src * 6144 + shidx * 1024 + col0; const GAS float* scp = modn + src * 6144 + scidx * 1024 + col0; const GAS float* nwp = normw + col0;
#pragma unroll
        for (int bj = 0; bj < 2; ++bj) { const int co = bj * HALF;
            const f32x4 gm0 = *(const GAS f32x4*)(nwp + co) * (*(const GAS f32x4*)(scp + co) + 1.0f), sh0 = *(const GAS f32x4*)(shp + co);
            const f32x4 gm1 = *(const GAS f32x4*)(nwp + co + 4) * (*(const GAS f32x4*)(scp + co + 4) + 1.0f), sh1 = *(const GAS f32x4*)(shp + co + 4);
#pragma unroll
            for (int ai = 0; ai < 2; ++ai)
#pragma unroll
                for (int m = 0; m < 4; ++m) { const int rloc = ai * HALF + wr * 64 + m * 16 + fr; const float rinv = S[rloc];
                    const f32x4 h0 = acc[ai][bj][m][0] * rinv * gm0 + sh0, h1 = acc[ai][bj][m][1] * rinv * gm1 + sh1;
                    u32x4 w; w.x = cvt_pk_bf16(h0[0], h0[1]); w.y = cvt_pk_bf16(h0[2], h0[3]); w.z = cvt_pk_bf16(h1[0], h1[1]); w.w = cvt_pk_bf16(h1[2], h1[3]);
                    *(GAS u32x4*)(Hout + (size_t)(u.pm * BM + rloc) * 1024 + col0 + co) = w; } }
    }
};
struct EpiSwiGLU {
    static constexpr bool PERM = true, AFTER_DRAIN = false, HAS_HOOK = false;
    GAS bf16_t* HFF;
    __device__ __forceinline__ void operator()(const f32x4 (&acc)[2][2][4][2], const Unit& u, int wr, int wc, int fr, int fq) const {
        const int row0 = u.pm * BM + wr * 64 + fr, col0 = u.pn * HALF + wc * 32 + 8 * fq;
#pragma unroll
        for (int ai = 0; ai < 2; ++ai)
#pragma unroll
            for (int m = 0; m < 4; ++m) { const size_t row = (size_t)(row0 + ai * HALF + m * 16);
                const f32x4 a0 = acc[ai][0][m][0], a1 = acc[ai][0][m][1], b0 = acc[ai][1][m][0], b1 = acc[ai][1][m][1];
                f32x4 h0, h1;
#pragma unroll
                for (int j = 0; j < 4; ++j) { h0[j] = a0[j] * sigmoid_f(a0[j]) * b0[j]; h1[j] = a1[j] * sigmoid_f(a1[j]) * b1[j]; }
                u32x4 w; w.x = cvt_pk_bf16(h0[0], h0[1]); w.y = cvt_pk_bf16(h0[2], h0[3]); w.z = cvt_pk_bf16(h1[0], h1[1]); w.w = cvt_pk_bf16(h1[2], h1[3]);
                *(GAS u32x4*)(HFF + row * 2816 + col0) = w; }
    }
};
template <class Epi, class Sched, bool ALIGN_EPI = false, bool SP2 = false>
__device__ __forceinline__ void gemm_phase(PG8_LAS unsigned char* lds, const Gemm g, const Sched& S, const Epi& E) {
    int tid_ = threadIdx.x; asm volatile("" : "+v"(tid_)); const int tid = tid_, wid = __builtin_amdgcn_readfirstlane(tid >> 6), lane = tid & 63, wr = wid >> 2, wc = wid & 3, fr = lane & 15, fq = lane >> 4;
    int K_ = g.K; asm volatile("" : "+s"(K_)); const int K = K_, nt = K / BK;
    unsigned voffA[2], voffB[2];
#pragma unroll
    for (int i = 0; i < 2; ++i) { int R, C; stage_rc(tid * 16 + i * 8192, R, C); const int Rb = Epi::PERM ? ((R & ~31) + perm32(R & 31)) : R;
        voffA[i] = (unsigned)(R * K + C) * 2u; voffB[i] = (unsigned)(Rb * K + C) * 2u; }
    const size_t kstep = (size_t)(BK * 2);
    const size_t hstep = (size_t)HALF * K * 2;
    const size_t tstep = 2 * hstep;
    const unsigned ldsw = (unsigned)wid * 1024u;
    const int aoff = lds_byte(wr * 64 + fr, fq * 8), boff = lds_byte(wc * 32 + fr, fq * 8);
#define PG8_SA(b, h) (((b) * 2 + (h)) * HTB)
#define PG8_SB(b, h) ((4 + (b) * 2 + (h)) * HTB)
#define PG8_STAGE(bufoff, gbase, voff) do { _Pragma("unroll") for (int _i = 0; _i < 2; ++_i) \
        __builtin_amdgcn_global_load_lds((const unsigned*)((const char*)(gbase) + (voff)[_i]), (PG8_LAS unsigned*)(lds + (bufoff) + ldsw + _i * 8192), 16, 0, 0); } while (0)
#define PG8_LDA(dst, b, h) do { _Pragma("unroll") for (int m = 0; m < 4; ++m) _Pragma("unroll") for (int k = 0; k < 2; ++k) dst[m][k] = *(const PG8_LAS bf16x8*)(lds + PG8_SA(b, h) + aoff + m * 2048 + k * 1024); } while (0)
#define PG8_LDB(dst, b, h) do { _Pragma("unroll") for (int n = 0; n < 2; ++n) _Pragma("unroll") for (int k = 0; k < 2; ++k) dst[n][k] = *(const PG8_LAS bf16x8*)(lds + PG8_SB(b, h) + boff + n * 2048 + k * 1024); } while (0)
#define PG8_MMA(ai, bj, At, Bt) do { __builtin_amdgcn_s_setprio(1); _Pragma("unroll") for (int m = 0; m < 4; ++m) _Pragma("unroll") for (int n = 0; n < 2; ++n) _Pragma("unroll") for (int k = 0; k < 2; ++k) \
        acc[ai][bj][m][n] = __builtin_amdgcn_mfma_f32_16x16x32_bf16(Bt[n][k], At[m][k], acc[ai][bj][m][n], 0, 0, 0); __builtin_amdgcn_s_setprio(0); } while (0)
#define PG8_WAIT_V(n) asm volatile("s_waitcnt vmcnt(" #n ")" ::: "memory")
#define PG8_WAIT_L(n) asm volatile("s_waitcnt lgkmcnt(" #n ")" ::: "memory")
#define PG8_BAR __builtin_amdgcn_s_barrier()
#define PG8_SCHED __builtin_amdgcn_sched_barrier(0)
    Unit cur, nxt; int ui = 0;
    if (!S.next(0, cur)) return;
    f32x4 acc[2][2][4][2];
#pragma unroll
    for (int a = 0; a < 2; ++a)
#pragma unroll
        for (int b = 0; b < 2; ++b)
#pragma unroll
            for (int m = 0; m < 4; ++m)
#pragma unroll
                for (int n = 0; n < 2; ++n) acc[a][b][m][n] = (f32x4){0.f, 0.f, 0.f, 0.f};
    bf16x8 At[4][2], B0[2][2], B1[2][2];
    const char* cA = (const char*)g.A + (size_t)cur.pm * tstep; const char* cB = (const char*)g.Bt + (size_t)cur.pn * tstep;
    S.a_ready(cur);
    if constexpr (SP2) {
        PG8_STAGE(PG8_SB(0, 0), cB, voffB); PG8_STAGE(PG8_SB(0, 1), cB + hstep, voffB); PG8_STAGE(PG8_SA(0, 0), cA, voffA); PG8_STAGE(PG8_SA(0, 1), cA + hstep, voffA);
        if (wr == 1) PG8_BAR;
        PG8_WAIT_V(2); PG8_BAR;
        PG8_STAGE(PG8_SB(1, 0), cB + kstep, voffB); PG8_STAGE(PG8_SA(1, 0), cA + kstep, voffA); PG8_STAGE(PG8_SB(1, 1), cB + hstep + kstep, voffB);
        PG8_WAIT_V(6); PG8_BAR;
    } else {
        PG8_STAGE(PG8_SB(0, 0), cB, voffB); PG8_STAGE(PG8_SA(0, 0), cA, voffA); PG8_STAGE(PG8_SB(0, 1), cB + hstep, voffB); PG8_STAGE(PG8_SA(0, 1), cA + hstep, voffA);
        if (wr == 1) PG8_BAR;
        PG8_WAIT_V(4); PG8_BAR;
        PG8_STAGE(PG8_SB(1, 0), cB + kstep, voffB); PG8_STAGE(PG8_SA(1, 0), cA + kstep, voffA); PG8_STAGE(PG8_SB(1, 1), cB + hstep + kstep, voffB);
        PG8_WAIT_V(6); PG8_BAR;
    }
    for (;;) {
        const bool has_next = S.next(ui + 1, nxt);
        const char* nA = has_next ? (const char*)g.A + (size_t)nxt.pm * tstep : cA; const char* nB = has_next ? (const char*)g.Bt + (size_t)nxt.pn * tstep : cB;
        for (int t = 0; t < nt; t += 2) {
            if constexpr (Epi::HAS_HOOK) { if (t == Epi::T1 || t == Epi::T2) E.hook(acc, cur, t, wr, wc, fr, fq); }
            const bool last = (t == nt - 2);
            const char* a1 = cA + (size_t)(t + 1) * kstep;
            const char* a2 = last ? nA : cA + (size_t)(t + 2) * kstep; const char* b2 = last ? nB : cB + (size_t)(t + 2) * kstep;
            const char* a3 = a2 + kstep; const char* b3 = b2 + kstep;
            if (last && has_next) S.a_ready(nxt);
            if constexpr (SP2) {
            PG8_LDB(B0, 0, 0); PG8_LDB(B1, 0, 1); PG8_SCHED; PG8_LDA(At, 0, 0); PG8_STAGE(PG8_SA(1, 1), a1 + hstep, voffA);
            PG8_WAIT_V(8); PG8_WAIT_L(0); PG8_BAR; PG8_MMA(0, 0, At, B0); PG8_MMA(0, 1, At, B1); PG8_BAR; PG8_SCHED;
            PG8_LDA(At, 0, 1); PG8_STAGE(PG8_SB(0, 0), b2, voffB); PG8_STAGE(PG8_SB(0, 1), b2 + hstep, voffB); PG8_STAGE(PG8_SA(0, 0), a2, voffA);
            PG8_WAIT_V(8); PG8_WAIT_L(0); PG8_BAR; PG8_MMA(1, 0, At, B0); PG8_MMA(1, 1, At, B1); PG8_BAR; PG8_SCHED;
            PG8_LDB(B0, 1, 0); PG8_LDB(B1, 1, 1); PG8_SCHED; PG8_LDA(At, 1, 0); PG8_STAGE(PG8_SA(0, 1), a2 + hstep, voffA);
            PG8_WAIT_V(8); PG8_WAIT_L(0); PG8_BAR; PG8_MMA(0, 0, At, B0); PG8_MMA(0, 1, At, B1); PG8_BAR; PG8_SCHED;
            PG8_LDA(At, 1, 1); PG8_STAGE(PG8_SB(1, 0), b3, voffB); PG8_STAGE(PG8_SB(1, 1), b3 + hstep, voffB); PG8_STAGE(PG8_SA(1, 0), a3, voffA);
            PG8_WAIT_V(8); PG8_WAIT_L(0); PG8_BAR; PG8_MMA(1, 0, At, B0); PG8_MMA(1, 1, At, B1); PG8_BAR; PG8_SCHED;
            } else {
            PG8_LDB(B0, 0, 0); PG8_SCHED; PG8_LDA(At, 0, 0); PG8_STAGE(PG8_SA(1, 1), a1 + hstep, voffA);
            PG8_WAIT_L(8); PG8_BAR; PG8_WAIT_L(0); PG8_MMA(0, 0, At, B0); PG8_BAR; PG8_SCHED;
            PG8_LDB(B1, 0, 1); PG8_STAGE(PG8_SB(0, 0), b2, voffB);
            PG8_BAR; PG8_WAIT_L(0); PG8_MMA(0, 1, At, B1); PG8_BAR;
            PG8_LDA(At, 0, 1); PG8_STAGE(PG8_SA(0, 0), a2, voffA);
            PG8_BAR; PG8_WAIT_L(0); PG8_MMA(1, 0, At, B0); PG8_BAR; PG8_SCHED;
            PG8_STAGE(PG8_SB(0, 1), b2 + hstep, voffB);
            PG8_WAIT_V(6); PG8_BAR; PG8_MMA(1, 1, At, B1); PG8_BAR;
            PG8_LDB(B0, 1, 0); PG8_SCHED; PG8_LDA(At, 1, 0); PG8_STAGE(PG8_SA(0, 1), a2 + hstep, voffA);
            PG8_WAIT_L(8); PG8_BAR; PG8_WAIT_L(0); PG8_MMA(0, 0, At, B0); PG8_BAR; PG8_SCHED;
            PG8_LDB(B1, 1, 1); PG8_STAGE(PG8_SB(1, 0), b3, voffB);
            PG8_BAR; PG8_WAIT_L(0); PG8_MMA(0, 1, At, B1); PG8_BAR;
            PG8_LDA(At, 1, 1); PG8_STAGE(PG8_SA(1, 0), a3, voffA);
            PG8_BAR; PG8_WAIT_L(0); PG8_MMA(1, 0, At, B0); PG8_BAR; PG8_SCHED;
            PG8_STAGE(PG8_SB(1, 1), b3 + hstep, voffB);
            PG8_WAIT_V(6); PG8_BAR; PG8_MMA(1, 1, At, B1); PG8_BAR;
            }
        }
        if constexpr (ALIGN_EPI) { if (wr == 0) PG8_BAR; }
        if constexpr (!Epi::AFTER_DRAIN) { E(acc, cur, wr, wc, fr, fq); S.done(cur); __builtin_amdgcn_s_waitcnt(0x0F70);   }
        if (!has_next) break;
#pragma unroll
        for (int a = 0; a < 2; ++a)
#pragma unroll
            for (int b = 0; b < 2; ++b)
#pragma unroll
                for (int m = 0; m < 4; ++m)
#pragma unroll
                    for (int n = 0; n < 2; ++n) acc[a][b][m][n] = (f32x4){0.f, 0.f, 0.f, 0.f};
        cur = nxt; cA = nA; cB = nB; ++ui;
        if constexpr (ALIGN_EPI) { if (wr == 1) PG8_BAR; }
    }
    PG8_WAIT_V(0);
    if constexpr (!ALIGN_EPI) { if (wr == 0) PG8_BAR; }
    PG8_BAR;
    if constexpr (Epi::AFTER_DRAIN) { E.fused(acc, cur, wr, wc, fr, fq, lds, wid, lane); S.done(cur); }
#undef PG8_SA
#undef PG8_SB
#undef PG8_STAGE
#undef PG8_LDA
#undef PG8_LDB
#undef PG8_MMA
#undef PG8_WAIT_V
#undef PG8_WAIT_L
#undef PG8_BAR
#undef PG8_SCHED
}
}
#include <hip/hip_bf16.h>
#include <cmath>
namespace attn_body {
using bf16=__hip_bfloat16;
using bf16x8=__attribute__((ext_vector_type(8)))short;
using s16x4=__attribute__((ext_vector_type(4)))short;
using f32x16=__attribute__((ext_vector_type(16)))float;
using u32x4=__attribute__((ext_vector_type(4)))unsigned;
constexpr int D=64,QP=512,KP=128,OP=1024;
constexpr int NW=8,QBLK=32,QB=QBLK*NW,KVBLK=64;
constexpr int ATTN_UNIT_ROWS=QB;
__device__ __forceinline__ int crow(int r,int hi){return (r&3)+8*(r>>2)+4*hi;}
#define SBAR() __builtin_amdgcn_sched_barrier(0)
__device__ __forceinline__ void cmask(f32x16&p0,f32x16&p1,int jb,int qrel,int hi){
  const float NEG=-INFINITY; int kb=64*jb+4*hi;
  #pragma unroll
  for(int r=0;r<16;++r){int kv=kb+(r&3)+8*(r>>2); if(kv>qrel)p0[r]=NEG; if(kv+32>qrel)p1[r]=NEG;}
}

constexpr int NSLOT=3, SLOTB=8192;
constexpr int LDS_K=0, LDS_V=NSLOT*SLOTB, LDS_WS=2*NSLOT*SLOTB, LDS_OST=LDS_WS+NW*64*4, LDS_BYTES=LDS_OST+NW*4096;
constexpr float C2=0.125f*1.4426950408889634f;
__device__ __forceinline__ void glds16(const void*gsrc,unsigned lds_dst){unsigned keep;
  asm volatile("s_mov_b32 %0, m0\n\ts_mov_b32 m0, %2\n\ts_nop 0\n\tglobal_load_lds_dwordx4 %1, off\n\ts_mov_b32 m0, %0":"=&s"(keep):"v"(gsrc),"s"(lds_dst):"memory");}
__device__ __forceinline__ float max3f(float a,float b,float c){float r;asm("v_max3_f32 %0, %1, %2, %3":"=v"(r):"v"(a),"v"(b),"v"(c));return r;}
__device__ __forceinline__ float max2f(float a,float b){float r;asm("v_max_f32_e32 %0, %1, %2":"=v"(r):"v"(a),"v"(b));return r;}
__device__ __forceinline__ float fadd_s(float a,float b){float r;asm("v_add_f32_e32 %0, %1, %2":"=v"(r):"v"(a),"v"(b));return r;}
__device__ __forceinline__ float fsub_s(float a,float b){float r;asm("v_sub_f32_e32 %0, %1, %2":"=v"(r):"v"(a),"v"(b));return r;}
typedef float f32x2_t __attribute__((ext_vector_type(2))); typedef __bf16 bf16x2_t __attribute__((ext_vector_type(2)));
__device__ __forceinline__ unsigned cvtpk_s(float lo,float hi){f32x2_t v={lo,hi};bf16x2_t b=__builtin_convertvector(v,bf16x2_t);return __builtin_bit_cast(unsigned,b);}
#define WAIT_BAR(N) asm volatile("s_waitcnt vmcnt(" #N ") lgkmcnt(0)\n\ts_barrier":::"memory")

__device__ __forceinline__ void qkt(f32x16&p0,f32x16&p1,const char*Kslot,const bf16x8*qr,const f32x16&negm,int r32,int hi){
  const char*kb=Kslot+hi*1024+r32*16;
  #pragma unroll
  for(int d0=0;d0<4;++d0){
    const bf16x8 b0=*reinterpret_cast<const bf16x8*>(kb+d0*2048);
    const bf16x8 b1=*reinterpret_cast<const bf16x8*>(kb+d0*2048+512);
    if(d0==0){p0=__builtin_amdgcn_mfma_f32_32x32x16_bf16(b0,qr[0],negm,0,0,0);p1=__builtin_amdgcn_mfma_f32_32x32x16_bf16(b1,qr[0],negm,0,0,0);}
    else{p0=__builtin_amdgcn_mfma_f32_32x32x16_bf16(b0,qr[d0],p0,0,0,0);p1=__builtin_amdgcn_mfma_f32_32x32x16_bf16(b1,qr[d0],p1,0,0,0);}}
}
typedef __attribute__((address_space(3))) const char* lds_cptr;
typedef short v4i16_t __attribute__((ext_vector_type(4)));
__device__ __forceinline__ void kload8(bf16x8*kf,lds_cptr kp){
  kf[0]=*(const __attribute__((address_space(3))) bf16x8*)(kp);      kf[1]=*(const __attribute__((address_space(3))) bf16x8*)(kp+512);
  kf[2]=*(const __attribute__((address_space(3))) bf16x8*)(kp+2048); kf[3]=*(const __attribute__((address_space(3))) bf16x8*)(kp+2560);
  kf[4]=*(const __attribute__((address_space(3))) bf16x8*)(kp+4096); kf[5]=*(const __attribute__((address_space(3))) bf16x8*)(kp+4608);
  kf[6]=*(const __attribute__((address_space(3))) bf16x8*)(kp+6144); kf[7]=*(const __attribute__((address_space(3))) bf16x8*)(kp+6656);
}
__device__ __forceinline__ void kload2(bf16x8*kf,lds_cptr kp,int j){ kf[2*j]=*(const __attribute__((address_space(3))) bf16x8*)(kp+j*2048); kf[2*j+1]=*(const __attribute__((address_space(3))) bf16x8*)(kp+j*2048+512); }
__device__ __forceinline__ s16x4 vtr(lds_cptr p){ return __builtin_bit_cast(s16x4,__builtin_amdgcn_ds_read_tr16_b64_v4i16((__attribute__((address_space(3))) v4i16_t*)p)); }
__device__ __forceinline__ float rowmax(const f32x16&p0,const f32x16&p1){
  float a=max3f(p0[0],p0[1],p1[0]),b=max3f(p0[2],p0[3],p1[1]);a=max3f(a,p1[2],p1[3]);
  #pragma unroll
  for(int r=4;r<16;r+=4){a=max3f(a,p0[r],p0[r+1]);b=max3f(b,p0[r+2],p0[r+3]);a=max3f(a,p1[r],p1[r+1]);b=max3f(b,p1[r+2],p1[r+3]);}
  const float m=max2f(a,b);
  auto rr=__builtin_amdgcn_permlane32_swap(__float_as_uint(m),__float_as_uint(m),false,false);
  return max2f(__uint_as_float(rr[0]),__uint_as_float(rr[1]));
}
__device__ __forceinline__ void pv(f32x16*o,int vb,bf16x8 pa0,bf16x8 pa1,bf16x8 pa2,bf16x8 pa3){
  #pragma unroll
  for(int d0=0;d0<2;++d0){s16x4 lo[4],hi[4];
    #pragma unroll
    for(int ks=0;ks<4;++ks){
      asm volatile("ds_read_b64_tr_b16 %0,%1 offset:%c2":"=&v"(lo[ks]):"v"(vb),"i"(d0*4096+ks*1024):"memory");
      asm volatile("ds_read_b64_tr_b16 %0,%1 offset:%c2":"=&v"(hi[ks]):"v"(vb),"i"(d0*4096+ks*1024+512):"memory");}
    asm volatile("s_waitcnt lgkmcnt(0)":::"memory");SBAR();
    #define PK(k) (bf16x8){lo[k][0],lo[k][1],lo[k][2],lo[k][3],hi[k][0],hi[k][1],hi[k][2],hi[k][3]}
    o[d0]=__builtin_amdgcn_mfma_f32_32x32x16_bf16(pa0,PK(0),o[d0],0,0,0);
    o[d0]=__builtin_amdgcn_mfma_f32_32x32x16_bf16(pa1,PK(1),o[d0],0,0,0);
    o[d0]=__builtin_amdgcn_mfma_f32_32x32x16_bf16(pa2,PK(2),o[d0],0,0,0);
    o[d0]=__builtin_amdgcn_mfma_f32_32x32x16_bf16(pa3,PK(3),o[d0],0,0,0);
    #undef PK
  }
}

#ifndef ATTN_STORE16
#define ATTN_STORE16(p,v) (*(u32x4*)(p)=(v))
#endif
template<int THRL,bool NOMAX> __device__ __forceinline__ void attn_unit(long qrow0,int h,long kvrow0,int NT,const bf16*Q,const bf16*__restrict__ K,const bf16*__restrict__ V,bf16*O,char*shm){
  int tid_=threadIdx.x; asm volatile("":"+v"(tid_)); const int tid=tid_,lane=tid&63,r32=lane&31,hi=lane>>5; const int wid=__builtin_amdgcn_readfirstlane(tid>>6);
  const bf16*Qw=Q+(qrow0+wid*QBLK)*QP+h*D;
  const bf16*Kh=K+kvrow0*KP+(h>>2)*D,*Vh=V+kvrow0*KP+(h>>2)*D;
  const unsigned lds0=(unsigned)(uintptr_t)shm;
  float*wsf=(float*)(shm+LDS_WS)+wid*64;
  const bf16*ksrc=Kh+(long)lane*KP+wid*8;
  const bf16*vsrc=Vh+(long)(16*(wid&3)+(lane>>2))*KP+(wid>>2)*32+(lane&3)*8;
  const unsigned kdst=lds0+LDS_K+wid*1024, vdst=lds0+LDS_V+wid*1024;
  #define DMA_K(t,slot) glds16(ksrc+(long)(t)*KVBLK*KP,(unsigned)__builtin_amdgcn_readfirstlane(kdst+(slot)))
  #define DMA_V(t,slot) glds16(vsrc+(long)(t)*KVBLK*KP,(unsigned)__builtin_amdgcn_readfirstlane(vdst+(slot)))
  const int vb0=(int)(lds0+LDS_V)+((lane>>4)&1)*32+(lane&3)*8+(4*hi+((lane&15)>>2))*64;
  const char*Kbase=shm+LDS_K; bf16x8 kf[8];
  const lds_cptr shm3=(lds_cptr)shm; const lds_cptr kp0=shm3+LDS_K+hi*1024+r32*16; const lds_cptr vp0=shm3+LDS_V+((lane>>4)&1)*32+(lane&3)*8+(4*hi+((lane&15)>>2))*64;
  DMA_K(0,0);DMA_V(0,0);DMA_K(1,SLOTB);
  bf16x8 qr[4];
  #pragma unroll
  for(int d0=0;d0<4;++d0)qr[d0]=*reinterpret_cast<const bf16x8*>(&Qw[(long)r32*QP+d0*16+hi*8]);
  float mhat=0.f,l_reg=0.f;f32x16 o[2];o[0]=f32x16{};o[1]=f32x16{};f32x16 negm=f32x16{};asm volatile("":"+v"(negm));
  #define CMASK(P0,P1,t) do{}while(0)
  bool resc=false;
  #define START(P0,P1) do{ resc=false; if constexpr(!NOMAX) \
    { const float rm=rowmax(P0,P1); const float dl=rm; mhat=fadd_s(mhat,dl); \
      _Pragma("unroll") for(int r=0;r<16;++r){P0[r]=fsub_s(P0[r],dl);P1[r]=fsub_s(P1[r],dl);} \
      _Pragma("unroll") for(int r=0;r<16;++r)negm[r]=-mhat; asm volatile("":"+v"(negm)); } \
    _Pragma("unroll") for(int r=0;r<16;++r)P0[r]=__builtin_amdgcn_exp2f(P0[r]); }while(0)
  #define RESC() do{ if constexpr(!NOMAX) if(resc){ asm volatile("s_waitcnt lgkmcnt(0)":::"memory"); \
      _Pragma("unroll") for(int d_=0;d_<2;++d_) _Pragma("unroll") for(int r=0;r<16;++r)o[d_][r]*=wsf[crow(r,hi)]; } }while(0)
  f32x16 pA0,pA1,pB0,pB1;
  int sl_prev=0,sl_cur=0,sl_next=SLOTB;
  #define ROT() do{sl_prev=sl_cur;sl_cur=sl_next;sl_next=(sl_next==(NSLOT-1)*SLOTB)?0:sl_next+SLOTB;}while(0)
  DMA_K(2,2*SLOTB);
  WAIT_BAR(3);
  qkt(pA0,pA1,Kbase,qr,negm,r32,hi);asm volatile("s_nop 15\n\ts_nop 7":"+v"(pA0),"+v"(pA1));CMASK(pA0,pA1,0);
  START(pA0,pA1);
  _Pragma("unroll") for(int r=0;r<16;++r)pA1[r]=__builtin_amdgcn_exp2f(pA1[r]);
  WAIT_BAR(0);
  DMA_K(3,0);DMA_V(1,SLOTB);
  ROT();
  kload8(kf,kp0+sl_cur);
  WAIT_BAR(2);
  s16x4 vlo[8],vhi[8]; u32x4 pw0,pw1,pw2,pw3;
  #define PKW(P,B) cvtpk_s(P[B],P[B+1])
  #define PAF(k) __builtin_bit_cast(bf16x8,pw##k)
  #define VFR(i) (bf16x8){vlo[i][0],vlo[i][1],vlo[i][2],vlo[i][3],vhi[i][0],vhi[i][1],vhi[i][2],vhi[i][3]}
  #define PIN(x) asm volatile("":"+v"(x))
  #define MX3(a,b,c) __builtin_fmaxf(__builtin_fmaxf((a),(b)),(c))
  #define GAPA(MF,A0,A1,A2,A3,W0,W1,PW) do{ MF; sacc+=A0; sacc+=A1; sacc+=A2; sacc+=A3; PIN(sacc); W0; W1; PIN(PW); SBAR(); }while(0)
  #define EX(v) __builtin_amdgcn_exp2f(v)
  #define GAPB(MF,X,B) do{ MF; X[B]=EX(X[B]); X[B+1]=EX(X[B+1]); X[B+2]=EX(X[B+2]); X[B+3]=EX(X[B+3]); PIN(X); SBAR(); }while(0)
  #define VRD(i) do{ vlo[i]=vtr(vp_+(((i)>>2)*4096+((i)&3)*1024)); vhi[i]=vtr(vp_+(((i)>>2)*4096+((i)&3)*1024+512)); }while(0)
  #define KRD(G,j) do{ if(G){ kload2(kf,kp0+sl_next,j); SBAR(); } }while(0)
  #define STEP(C0,C1,P0,P1,t,GK,GV,GL) do{ SBAR(); \
    const lds_cptr vp_=vp0+sl_prev; \
    VRD(0); SBAR(); float sacc=(P0[0]+P0[1]); \
    GAPA(C0=__builtin_amdgcn_mfma_f32_32x32x16_bf16(kf[0],qr[0],negm,0,0,0), P0[2],P0[3],P0[4],P0[5],     pw0[0]=PKW(P0,0), pw0[1]=PKW(P0,2), pw0); \
    VRD(4); SBAR(); GAPA(C1=__builtin_amdgcn_mfma_f32_32x32x16_bf16(kf[1],qr[0],negm,0,0,0), P0[6],P0[7],P0[8],P0[9],     pw0[2]=PKW(P0,4), pw0[3]=PKW(P0,6), pw0); \
    VRD(1); SBAR(); GAPA(C0=__builtin_amdgcn_mfma_f32_32x32x16_bf16(kf[2],qr[1],C0,0,0,0),   P0[10],P0[11],P0[12],P0[13], pw1[0]=PKW(P0,8), pw1[1]=PKW(P0,10), pw1); \
    VRD(5); SBAR(); GAPA(C1=__builtin_amdgcn_mfma_f32_32x32x16_bf16(kf[3],qr[1],C1,0,0,0),   P0[14],P0[15],P1[0],P1[1],   pw1[2]=PKW(P0,12),pw1[3]=PKW(P0,14), pw1); \
    VRD(2); SBAR(); GAPA(C0=__builtin_amdgcn_mfma_f32_32x32x16_bf16(kf[4],qr[2],C0,0,0,0),   P1[2],P1[3],P1[4],P1[5],     pw2[0]=PKW(P1,0), pw2[1]=PKW(P1,2), pw2); \
    VRD(6); SBAR(); GAPA(C1=__builtin_amdgcn_mfma_f32_32x32x16_bf16(kf[5],qr[2],C1,0,0,0),   P1[6],P1[7],P1[8],P1[9],     pw2[2]=PKW(P1,4), pw2[3]=PKW(P1,6), pw2); \
    VRD(3); SBAR(); GAPA(C0=__builtin_amdgcn_mfma_f32_32x32x16_bf16(kf[6],qr[3],C0,0,0,0),   P1[10],P1[11],P1[12],P1[13], pw3[0]=PKW(P1,8), pw3[1]=PKW(P1,10), pw3); \
    VRD(7); SBAR(); GAPA(C1=__builtin_amdgcn_mfma_f32_32x32x16_bf16(kf[7],qr[3],C1,0,0,0),   P1[14],P1[15],0.f,0.f,       pw3[2]=PKW(P1,12),pw3[3]=PKW(P1,14), pw3); \
    l_reg+=sacc; \
    if(GK){DMA_K((t)+3,sl_cur);} if(GV){DMA_V((t)+1,sl_next);} \
    CMASK(C0,C1,t); \
    if constexpr(!NOMAX){ float a=MX3(C0[0],C0[1],C1[0]),b=MX3(C0[2],C0[3],C1[1]); a=MX3(a,C1[2],C1[3]); \
      _Pragma("unroll") for(int r=4;r<16;r+=4){a=MX3(a,C0[r],C0[r+1]);b=MX3(b,C0[r+2],C0[r+3]);a=MX3(a,C1[r],C1[r+1]);b=MX3(b,C1[r+2],C1[r+3]);} \
      float rm=__builtin_fmaxf(a,b); { auto rr=__builtin_amdgcn_permlane32_swap(__float_as_uint(rm),__float_as_uint(rm),false,false); rm=__builtin_fmaxf(__uint_as_float(rr[0]),__uint_as_float(rr[1])); } \
      resc=false; \
      if(__builtin_expect(__any(rm>(float)THRL),0)){ const float dl=__builtin_fmaxf(rm,0.f); mhat+=dl; \
        _Pragma("unroll") for(int r=0;r<16;++r){C0[r]-=dl;C1[r]-=dl;} \
        _Pragma("unroll") for(int r=0;r<16;++r)negm[r]=-mhat; asm volatile("":"+v"(negm)); \
        const float f=__builtin_amdgcn_exp2f(-dl); l_reg*=f; if(hi==0)wsf[r32]=f; resc=true; } } \
    SBAR(); \
    GAPB(o[0]=__builtin_amdgcn_mfma_f32_32x32x16_bf16(PAF(0),VFR(0),o[0],0,0,0), C0,0); \
    GAPB(o[1]=__builtin_amdgcn_mfma_f32_32x32x16_bf16(PAF(0),VFR(4),o[1],0,0,0), C0,4); \
    KRD(GL,0); GAPB(o[0]=__builtin_amdgcn_mfma_f32_32x32x16_bf16(PAF(1),VFR(1),o[0],0,0,0), C0,8); \
    KRD(GL,1); GAPB(o[1]=__builtin_amdgcn_mfma_f32_32x32x16_bf16(PAF(1),VFR(5),o[1],0,0,0), C0,12); \
    KRD(GL,2); GAPB(o[0]=__builtin_amdgcn_mfma_f32_32x32x16_bf16(PAF(2),VFR(2),o[0],0,0,0), C1,0); \
    KRD(GL,3); GAPB(o[1]=__builtin_amdgcn_mfma_f32_32x32x16_bf16(PAF(2),VFR(6),o[1],0,0,0), C1,4); \
    GAPB(o[0]=__builtin_amdgcn_mfma_f32_32x32x16_bf16(PAF(3),VFR(3),o[0],0,0,0), C1,8); \
    GAPB(o[1]=__builtin_amdgcn_mfma_f32_32x32x16_bf16(PAF(3),VFR(7),o[1],0,0,0), C1,12); \
    }while(0)
  int t=1;
  #undef CMASK
  #define CMASK(P0,P1,t) do{}while(0)
  for(;t+5<NT;t+=2){
    STEP(pB0,pB1,pA0,pA1,t,true,true,true);     WAIT_BAR(2); RESC(); ROT();
    STEP(pA0,pA1,pB0,pB1,t+1,true,true,true);   WAIT_BAR(2); RESC(); ROT();
  }
  #undef CMASK
  #define CMASK(P0,P1,t) do{}while(0)
  #define ENDW(tt) do{ if((tt)+3<NT){WAIT_BAR(2);} else if((tt)+2<NT){WAIT_BAR(1);} else {WAIT_BAR(0);} }while(0)
  for(;t+1<NT;t+=2){
    STEP(pB0,pB1,pA0,pA1,t,(t+3<NT),(t+1<NT),(t+1<NT));       ENDW(t);   RESC(); ROT();
    STEP(pA0,pA1,pB0,pB1,t+1,(t+4<NT),(t+2<NT),(t+2<NT));     ENDW(t+1); RESC(); ROT();
  }
  STEP(pB0,pB1,pA0,pA1,NT-1,false,false,false); RESC();
  { float sacc=pB0[0]+pB0[1]; _Pragma("unroll") for(int r=2;r<16;++r)sacc+=pB0[r]; _Pragma("unroll") for(int r=0;r<16;++r)sacc+=pB1[r]; l_reg+=sacc;
    pw0=(u32x4){PKW(pB0,0),PKW(pB0,2),PKW(pB0,4),PKW(pB0,6)};pw1=(u32x4){PKW(pB0,8),PKW(pB0,10),PKW(pB0,12),PKW(pB0,14)};pw2=(u32x4){PKW(pB1,0),PKW(pB1,2),PKW(pB1,4),PKW(pB1,6)};pw3=(u32x4){PKW(pB1,8),PKW(pB1,10),PKW(pB1,12),PKW(pB1,14)};
    SBAR(); pv(o,vb0+sl_cur,PAF(0),PAF(1),PAF(2),PAF(3)); }
  #undef PKW
  #undef PAF
  #undef VFR
  #undef PIN
  #undef MX3
  #undef GAPA
  #undef GAPB
  #undef EX
  #undef VRD
  #undef KRD
  #undef STEP
  #undef ENDW
  {auto rr=__builtin_amdgcn_permlane32_swap(__float_as_uint(l_reg),__float_as_uint(l_reg),false,false);l_reg=__uint_as_float(rr[0])+__uint_as_float(rr[1]);}
  if(hi==0)wsf[32+r32]=l_reg;asm volatile("s_waitcnt lgkmcnt(0)":::"memory");
  float rli[16];
  #pragma unroll
  for(int r=0;r<16;++r)rli[r]=__builtin_amdgcn_rcpf(wsf[32+crow(r,hi)]);
  bf16*Ow=O+(qrow0+wid*QBLK)*OP+h*D;
  { bf16*stg=(bf16*)(shm+LDS_OST)+wid*2048;
    #pragma unroll
    for(int r=0;r<16;++r){const int orow=crow(r,hi);
      #pragma unroll
      for(int d0=0;d0<2;++d0)stg[orow*64+d0*32+r32]=__float2bfloat16(o[d0][r]*rli[r]);}
    asm volatile("s_waitcnt lgkmcnt(0)":::"memory");
    #pragma unroll
    for(int i=0;i<4;++i){const int row=i*8+(lane>>3),ch=lane&7; const u32x4 v=*(const u32x4*)(stg+row*64+ch*8); ATTN_STORE16(Ow+(long)row*OP+ch*8,v);} }
  asm volatile("s_waitcnt lgkmcnt(0)\n\ts_barrier":::"memory");
  #undef DMA_K
  #undef DMA_V
  #undef CMASK
  #undef START
  #undef RESC
  #undef ROT
}
constexpr int ATTN_LDS_BYTES=LDS_BYTES;
#undef SBAR
#undef WAIT_BAR
}
#define LAS __attribute__((address_space(3)))
#define INP(i) ((const GAS float*)a.in[i])
typedef unsigned short bf16;
typedef unsigned v4u __attribute__((ext_vector_type(4)));
typedef unsigned v2u __attribute__((ext_vector_type(2)));
typedef float f32x4 __attribute__((ext_vector_type(4)));
#ifndef DUP_S
#define DUP_S -1
#endif
#ifndef DUP_ATT
#define DUP_ATT 1
#endif
#ifndef DUP_SG
#define DUP_SG 1
#endif
#ifndef TIME_S
#define TIME_S -1
#endif
#ifndef TIME_MASK
#define TIME_MASK (TIME_S == 10 ? 0x1ff : (1 << (TIME_S < 0 ? 0 : TIME_S)))
#endif
#ifndef MK_MULTI
#define MK_MULTI 0
#endif
constexpr int NWAVES = 8, NTHREADS = 512;
constexpr int DMODEL = 1024, DEPTH = 4, ML = 16384, MC = 512, MT = ML + MC;
constexpr int INW = 5120, DFF = 2816, NMODW = 6144;
constexpr int NPHASE = 1 + 8 * DEPTH;
constexpr size_t MiB = 1u << 20;
constexpr size_t WS_MOD = 0, WS_COS = 1 * MiB, WS_SIN = 2 * MiB, WS_CTX = 3 * MiB, WS_W = 6 * MiB, WS_H = 38 * MiB, WS_Q = 72 * MiB, WS_K = 89 * MiB, WS_V = 94 * MiB,
                 WS_ZA = 99 * MiB, WS_ZB = 108 * MiB, WS_ZC = 125 * MiB, WS_ZF = 134 * MiB, WS_P = 200 * MiB;
constexpr size_t P_CONV = 0, P_SG = (size_t)MT * 768 * 2, P_G = P_SG + (size_t)MT * 512 * 2, WS_END = WS_P + P_G + (size_t)MT * 3072 * 2;
constexpr size_t WS_W2 = 342 * MiB, WS_END2 = WS_W2 + 32 * MiB;
static_assert(WS_END <= WS_W2, "ws map 3");
constexpr size_t WO_IN = 0, WO_A = WO_IN + 5120 * 1024  , WO_O = WO_A + 1024 * 1024, WO_13 = WO_O + 1024 * 1024,
                 WO_2 = WO_13 + 5632 * 1024, WO_END = WO_2 + 1024 * 2816;
static_assert(WO_END * 2 <= 32 * MiB && (size_t)MT * 1024 * 2 <= 34 * MiB && (size_t)MT * 1024 * 4 <= 66 * MiB && (size_t)MT * 2816 * 2 <= WS_END - WS_P, "ws map");
constexpr int LDS_BYTES = 147456;

__device__ __forceinline__ unsigned f2bf(float f) { unsigned u = __builtin_bit_cast(unsigned, f); return (u + 0x7fffu + ((u >> 16) & 1u)) >> 16; }
__device__ __forceinline__ unsigned pk2(float lo, float hi) { return f2bf(lo) | (f2bf(hi) << 16); }
__device__ __forceinline__ float bflo(unsigned w) { return __uint_as_float(w << 16); }
__device__ __forceinline__ float bfhi(unsigned w) { return __uint_as_float(w & 0xffff0000u); }
__device__ __forceinline__ float wave_sum(float v) {
#pragma unroll
    for (int o = 1; o < 64; o <<= 1) v += __shfl_xor(v, o);
    return v;
}
__device__ __forceinline__ int inproj_src_col(int nn) {
    if (nn >= 256 && nn < 768) { const int q = nn - 256, tile = q >> 8, p = q & 255; return 256 + (p >> 7) * 256 + tile * 128 + (p & 127); }
    if (nn < 768 || nn >= 1536) return nn;
    const int q = nn - 768, tile = q >> 8, p = q & 255, bj = p >> 7, wc = (p >> 5) & 3, fq = (p >> 3) & 3, n = (p >> 2) & 1, j = p & 3;
    return 768 + tile * 256 + wc * 64 + 32 * bj + 16 * n + 4 * fq + j;
}
template <int MODE> __device__ __forceinline__ void transpose_item(const GAS float* W, const GAS float* W3, int K, int N, GAS bf16* WT, LAS float* scr, int item, int nblk, int lane, int dpitch = 0, int koff = 0) {
    if (dpitch == 0) dpitch = K;
    const int kb = item / nblk, nb = item % nblk, k0 = 64 * kb, n0 = 32 * nb, nn = n0 + 4 * (lane & 7);
    const GAS float* src;
    if (MODE == 0) src = W + nn;
    else if (MODE == 1) src = W + inproj_src_col(nn);
    else { const int tile = nn >> 8, p = nn & 255; src = ((p >> 7) ? W3 : W) + 128 * tile + (p & 127); }
#pragma unroll
    for (int i = 0; i < 8; ++i) { const int kk = 8 * i + (lane >> 3); const f32x4 v = *(const GAS f32x4*)(src + (size_t)(k0 + kk) * N);
        LAS float* d = scr + kk * 33 + 4 * (lane & 7); d[0] = v[0]; d[1] = v[1]; d[2] = v[2]; d[3] = v[3]; }
    asm volatile("s_waitcnt lgkmcnt(0)" ::: "memory");
    const int c = lane & 7;
#pragma unroll
    for (int j = 0; j < 4; ++j) { const int n = (lane >> 3) + 8 * j; const LAS float* s = scr + (8 * c) * 33 + n;
        v4u o; o.x = pk2(s[0 * 33], s[1 * 33]); o.y = pk2(s[2 * 33], s[3 * 33]); o.z = pk2(s[4 * 33], s[5 * 33]); o.w = pk2(s[6 * 33], s[7 * 33]);
        *(GAS v4u*)(WT + (size_t)(n0 + n) * dpitch + koff + k0 + 8 * c) = o; }
    asm volatile("s_waitcnt lgkmcnt(0)" ::: "memory");
}
typedef GAS unsigned gu32;
#define RLX_AGENT __ATOMIC_RELAXED, __HIP_MEMORY_SCOPE_AGENT
#define XB_TMO      128
#define XB_XCNT(j)  (256  + 64 * (j))
#define XB_XSUB(j)  (1280 + 64 * (j))
#define XB_XGEN(j)  (2304 + 64 * (j))
#define XB_TOP      3328
#define XB_TOPGEN   3392
#define XCD_BAR_WORDS 3456
#define XB_SPIN_CAP (1u << 18)

__device__ __forceinline__ unsigned xb_ld(unsigned* p)              { return __hip_atomic_load(p, __ATOMIC_RELAXED, __HIP_MEMORY_SCOPE_AGENT); }
__device__ __forceinline__ unsigned xb_add(unsigned* p, unsigned v) { return __hip_atomic_fetch_add(p, v, __ATOMIC_RELAXED, __HIP_MEMORY_SCOPE_AGENT); }
__device__ __forceinline__ unsigned xb_xcc_id() { return (unsigned)__builtin_amdgcn_s_getreg((3 << 11) | 20) & 0xFu; }
#define XB_SPIN(cond, bar) do { unsigned _sp = 0; while (cond) { __builtin_amdgcn_s_sleep(1); \
    if ((++_sp & 255u) == 0u) { if (xb_ld(&(bar)[XB_TMO])) break; if (_sp > XB_SPIN_CAP) { atomicAdd(&(bar)[XB_TMO], 1u); break; } } } } while (0)

struct XcdBarrier {
    unsigned* bar; unsigned x;
    volatile LAS unsigned* st;
};

__device__ __forceinline__ XcdBarrier xcd_barrier_post(unsigned* bar, volatile LAS unsigned* st) {
    XcdBarrier b; b.bar = bar; b.x = xb_xcc_id(); b.st = st;
    if (threadIdx.x == 0) (void)xb_add(&bar[XB_XCNT(b.x)], 1u);
    return b;
}
__device__ __forceinline__ void xcd_barrier_complete(unsigned* bar, unsigned x, unsigned& nloc, unsigned& nx) {
    const unsigned G = gridDim.x * gridDim.y * gridDim.z;
    unsigned sum, cnt, mine, sp = 0u;
    for (;;) {
        sum = 0u; cnt = 0u; mine = 0u;
#pragma unroll
        for (unsigned j = 0; j < 16; ++j) { const unsigned c = xb_ld(&bar[XB_XCNT(j)]); sum += c; cnt += (c > 0u) ? 1u : 0u; mine = (j == x) ? c : mine; }
        if (sum == G) break;
        __builtin_amdgcn_s_sleep(1);
        if ((++sp & 255u) == 0u) { if (xb_ld(&bar[XB_TMO])) break; if (sp > XB_SPIN_CAP) { atomicAdd(&bar[XB_TMO], 1u); break; } }
    }
    nloc = mine > 0u ? mine : 1u; nx = cnt > 0u ? cnt : 1u;
}

__device__ __forceinline__ void xcd_barrier(const XcdBarrier& b) {
    asm volatile("s_waitcnt vmcnt(0)" ::: "memory");
    __syncthreads();
    if (threadIdx.x == 0) {
        unsigned* bar = b.bar;
        __builtin_amdgcn_s_waitcnt(0);
        unsigned nloc = b.st[0], nx = b.st[1];
        if (nloc == 0u) { xcd_barrier_complete(bar, b.x, nloc, nx); b.st[0] = nloc; b.st[1] = nx; }
        const unsigned old = xb_add(&bar[XB_XSUB(b.x)], 1u);
        const unsigned gen = old / nloc;
        if (old + 1u == (gen + 1u) * nloc) {
            __builtin_amdgcn_fence(__ATOMIC_RELEASE, "agent");
            asm volatile("s_waitcnt vmcnt(0)" ::: "memory");
            const unsigned og = xb_add(&bar[XB_TOP], 1u);
            const unsigned tg = og / nx;
            if (og + 1u == (tg + 1u) * nx) xb_add(&bar[XB_TOPGEN], 1u);
            else XB_SPIN(xb_ld(&bar[XB_TOPGEN]) == tg, bar);
            __builtin_amdgcn_fence(__ATOMIC_ACQUIRE, "agent");
            xb_add(&bar[XB_XGEN(b.x)], 1u);
            asm volatile("s_waitcnt vmcnt(0)" ::: "memory");
        } else {
            XB_SPIN(xb_ld(&bar[XB_XGEN(b.x)]) == gen, bar);
            __builtin_amdgcn_fence(__ATOMIC_ACQUIRE, "agent");
            asm volatile("s_waitcnt vmcnt(0)" ::: "memory");
        }
    }
    __syncthreads();
}

constexpr size_t WS_BAR = 512 * 1024, BAR_BYTES = 16384 + 16384 + 4096;
constexpr size_t WS_XCNT = WS_BAR + 16384, WS_XCNTC = WS_BAR + 32768  , WS_XBUF = 640 * 1024, WS_XBUFC = 896 * 1024  ;
static_assert(WS_XBUFC + 512 * 32 * 4 <= MiB, "ws map 5");
static_assert(WS_XBUF + (size_t)ML * 16 <= MiB, "ws map 4");
constexpr int LDS_BARST = 131072 + 64;

typedef short cbf16x8 __attribute__((ext_vector_type(8)));
typedef float cf32x16 __attribute__((ext_vector_type(16)));
__device__ __forceinline__ cf32x16 ctx_seg(const GAS bf16* Arow, const GAS bf16* Brow, int kbeg, int kend) {
    cf32x16 acc; for (int r = 0; r < 16; ++r) acc[r] = 0.f;
#pragma unroll 8
    for (int k = kbeg; k < kend; k += 16) { const cbf16x8 av = *(const GAS cbf16x8*)(Arow + k), bv = *(const GAS cbf16x8*)(Brow + k);
        acc = __builtin_amdgcn_mfma_f32_32x32x16_bf16(bv, av, acc, 0, 0, 0); }
    return acc;
}
__device__ __forceinline__ void ctx_reduce(cf32x16& tot, LAS float* red, int wave, int lane) {
    const int q = wave & 3, tsel = wave >> 2;
    LAS float* mine = red + ((tsel * 4 + q) * 64 + lane) * 16;
    if (q != 0) {
#pragma unroll
        for (int r = 0; r < 16; r += 4) *(LAS f32x4*)(mine + r) = (f32x4){tot[r], tot[r + 1], tot[r + 2], tot[r + 3]}; }
    __syncthreads();
    if (q == 0) {
#pragma unroll
        for (int p = 1; p < 4; ++p)
#pragma unroll
            for (int r = 0; r < 16; r += 4) { const f32x4 v = *(const LAS f32x4*)(red + ((tsel * 4 + p) * 64 + lane) * 16 + r); tot[r] += v[0]; tot[r + 1] += v[1]; tot[r + 2] += v[2]; tot[r + 3] += v[3]; } }
    __syncthreads();
}
struct Args { const float* in[22]; float* out; unsigned char* ws; int ph_lo, ph_hi; };

__global__ void __launch_bounds__(NTHREADS, 2) fwd_kernel(Args a) {
    extern __shared__ __attribute__((aligned(16))) unsigned char lds[];
#define PTRS() \
    int tid_ = threadIdx.x; asm volatile("" : "+v"(tid_)); const int tid = tid_, lane = tid & 63, wave = __builtin_amdgcn_readfirstlane(tid >> 6); \
    int bx = blockIdx.x, G = gridDim.x; asm volatile("" : "+s"(bx), "+s"(G)); const int vcu = (G % 8 == 0) ? (bx % 8) * (G / 8) + bx / 8 : bx; (void)vcu; (void)tid; \
    const int gw = bx * NWAVES + wave, NGW = G * NWAVES; (void)gw; (void)NGW; (void)lane; \
    GAS unsigned char* wsr_ = (GAS unsigned char*)a.ws; asm volatile("" : "+s"(wsr_)); GAS unsigned char* const ws = (GAS unsigned char*)wsr_; \
    GAS float* const modv = (GAS float*)(ws + WS_MOD); GAS float* const cosT = (GAS float*)(ws + WS_COS); GAS float* const sinT = (GAS float*)(ws + WS_SIN); GAS float* const xctx = (GAS float*)(ws + WS_CTX); \
    GAS bf16* const Wb = (GAS bf16*)(ws + ((((ph - 1) >> 3) & 1) ? WS_W2 : WS_W)); GAS bf16* const Wn = (GAS bf16*)(ws + ((((ph - 1) >> 3) & 1) ? WS_W : WS_W2)); (void)Wn; GAS bf16* const H = (GAS bf16*)(ws + WS_H); GAS bf16* const Qb = (GAS bf16*)(ws + WS_Q); GAS bf16* const Kb = (GAS bf16*)(ws + WS_K); GAS bf16* const Vb = (GAS bf16*)(ws + WS_V); \
    GAS bf16* const Zcat = (GAS bf16*)(ws + WS_ZA);      GAS float* const ZF = (GAS float*)(ws + WS_ZF); \
    GAS bf16* const PCONV = (GAS bf16*)(ws + WS_P + P_CONV); GAS bf16* const PSG = (GAS bf16*)(ws + WS_P + P_SG); GAS bf16* const PG = (GAS bf16*)(ws + WS_P + P_G); GAS bf16* const HFF = (GAS bf16*)(ws + WS_P); \
    GAS bf16* const Zb = H; GAS float* const xlat = (GAS float*)a.out; LAS unsigned char* const ldsl = (LAS unsigned char*)lds; \
    (void)modv; (void)cosT; (void)sinT; (void)xctx; (void)Wb; (void)Qb; (void)Kb; (void)Vb; (void)Zcat; (void)ZF; (void)PCONV; (void)PSG; (void)PG; (void)HFF; (void)Zb; (void)xlat; (void)ldsl; \
    const int l = (ph - 1) >> 3; const bool last = (l == DEPTH - 1); const GAS float* const modl = modv + (size_t)l * 3 * NMODW; const int Mrows = last ? ML : MT; (void)modl; (void)Mrows; (void)last;

#define CONVERT_WEIGHTS(l, Wd, gw0_, ngw_) do { \
        LAS float* scr = (LAS float*)ldsl + wave * (64 * 33); \
        for (int it = (gw0_); it < 7808; it += (ngw_)) { int r = it; \
            if (r < 2560) { transpose_item<1>(INP(7) + (size_t)(l) * 1024 * INW, nullptr, 1024, INW, (Wd) + WO_IN, scr, r, 160, lane); continue; } r -= 2560; \
            if (r < 128) { transpose_item<0>(INP(14) + (size_t)(l) * 256 * 1024, nullptr, 256, 1024, (Wd) + WO_A, scr, r, 32, lane, 1024, 0); continue; } r -= 128; \
            if (r < 256) { transpose_item<0>(INP(15) + (size_t)(l) * 512 * 1024, nullptr, 512, 1024, (Wd) + WO_A, scr, r, 32, lane, 1024, 256); continue; } r -= 256; \
            if (r < 128) { transpose_item<0>(INP(16) + (size_t)(l) * 256 * 1024, nullptr, 256, 1024, (Wd) + WO_A, scr, r, 32, lane, 1024, 768); continue; } r -= 128; \
            if (r < 512) { transpose_item<0>(INP(17) + (size_t)(l) * 1024 * 1024, nullptr, 1024, 1024, (Wd) + WO_O, scr, r, 32, lane); continue; } r -= 512; \
            if (r < 2816) { transpose_item<2>(INP(19) + (size_t)(l) * 1024 * DFF, INP(20) + (size_t)(l) * 1024 * DFF, 1024, DFF, (Wd) + WO_13, scr, r, 176, lane); continue; } r -= 2816; \
            transpose_item<0>(INP(21) + (size_t)(l) * DFF * 1024, nullptr, DFF, 1024, (Wd) + WO_2, scr, r, 32, lane); } \
        __syncthreads(); } while (0)

#define NORM_ROWS(xsrc_, normw, modl, shidx, scidx, r0_, nrows) do { \
        for (int r = (r0_) + gw; r < (nrows); r += NGW) { const bool latent = r < ML; const GAS float* xrow = latent ? (xsrc_) + (size_t)r * 1024 : xctx + (size_t)(r - ML) * 1024; \
            const int src = latent ? (r >> 13) : 2; const GAS float* shp = (modl) + src * NMODW + (shidx) * 1024; const GAS float* scp = (modl) + src * NMODW + (scidx) * 1024; \
            f32x4 v[4]; float ss = 0.f; \
            _Pragma("unroll") for (int j = 0; j < 4; ++j) { v[j] = *((const GAS f32x4*)xrow + lane + 64 * j); ss += (v[j][0] * v[j][0] + v[j][1] * v[j][1]) + (v[j][2] * v[j][2] + v[j][3] * v[j][3]); } \
            const float rinv = 1.0f / sqrtf(wave_sum(ss) * (1.0f / 1024.0f) + 1e-6f); \
            _Pragma("unroll") for (int j = 0; j < 4; ++j) { const f32x4 gg = *((const GAS f32x4*)(normw) + lane + 64 * j), s4 = *((const GAS f32x4*)scp + lane + 64 * j), h4 = *((const GAS f32x4*)shp + lane + 64 * j); \
                const f32x4 o = v[j] * rinv * gg * (s4 + 1.0f) + h4; v2u w; w.x = pk2(o[0], o[1]); w.y = pk2(o[2], o[3]); *((GAS v2u*)(H + (size_t)r * 1024) + lane + 64 * j) = w; } } } while (0)


#define CTX_MERGE() do { \
        for (int tile0 = bx * 2; tile0 < 512; tile0 += 2 * G) { const int tile = tile0 + (wave >> 2), q = wave & 3, r32 = lane & 31, hi = lane >> 5; \
            const int row0 = ML + (tile >> 5) * 32, col0 = (tile & 31) * 32; const size_t arow = (size_t)(row0 + r32); \
            cf32x16 tot; \
            { const cf32x16 sa = ctx_seg(Zcat + arow * 1024 + 8 * hi, Wb + WO_A + (size_t)(col0 + r32) * 1024 + 8 * hi, q * 64, q * 64 + 64); \
              const cf32x16 sb = ctx_seg(Zcat + arow * 1024 + 256 + 8 * hi, Wb + WO_A + (size_t)(col0 + r32) * 1024 + 256 + 8 * hi, q * 128, q * 128 + 128); \
              const cf32x16 sc = ctx_seg(Zcat + arow * 1024 + 768 + 8 * hi, Wb + WO_A + (size_t)(col0 + r32) * 1024 + 768 + 8 * hi, q * 64, q * 64 + 64); \
              _Pragma("unroll") for (int qq = 0; qq < 4; ++qq) { const GAS bf16* gp = PG + arow * 3072 + col0 + 8 * qq + 4 * hi; \
                  const v2u ga = *(const GAS v2u*)gp, gb = *(const GAS v2u*)(gp + 1024), gc = *(const GAS v2u*)(gp + 2048); \
                  tot[4 * qq + 0] = bflo(ga.x) * sa[4 * qq + 0] + bflo(gb.x) * sb[4 * qq + 0] + bflo(gc.x) * sc[4 * qq + 0]; \
                  tot[4 * qq + 1] = bfhi(ga.x) * sa[4 * qq + 1] + bfhi(gb.x) * sb[4 * qq + 1] + bfhi(gc.x) * sc[4 * qq + 1]; \
                  tot[4 * qq + 2] = bflo(ga.y) * sa[4 * qq + 2] + bflo(gb.y) * sb[4 * qq + 2] + bflo(gc.y) * sc[4 * qq + 2]; \
                  tot[4 * qq + 3] = bfhi(ga.y) * sa[4 * qq + 3] + bfhi(gb.y) * sb[4 * qq + 3] + bfhi(gc.y) * sc[4 * qq + 3]; } } \
            ctx_reduce(tot, (LAS float*)ldsl, wave, lane); \
            if (q == 0) { _Pragma("unroll") for (int qq = 0; qq < 4; ++qq) { v2u o; o.x = pk2(tot[4 * qq], tot[4 * qq + 1]); o.y = pk2(tot[4 * qq + 2], tot[4 * qq + 3]); \
                *(GAS v2u*)(Zb + arow * 1024 + col0 + 8 * qq + 4 * hi) = o; } } } } while (0)
#define CTX_RESID(Aptr, lda_, Woff, gidx_, NRM_, normw_, modn_, shidx_, scidx_, want_) do { \
        for (int tile0 = bx * 2; tile0 < 512; tile0 += 2 * G) { const int tile = tile0 + (wave >> 2), q = wave & 3, r32 = lane & 31, hi = lane >> 5; \
            const int row0 = ML + (tile >> 5) * 32, col0 = (tile & 31) * 32; const size_t arow = (size_t)(row0 + r32); \
            cf32x16 tot = ctx_seg((Aptr) + arow * (lda_) + 8 * hi, Wb + (Woff) + (size_t)(col0 + r32) * (lda_) + 8 * hi, q * ((lda_) / 4), (q + 1) * ((lda_) / 4)); \
            ctx_reduce(tot, (LAS float*)ldsl, wave, lane); \
            if (q == 0) { float ss = 0.f; \
                _Pragma("unroll") for (int qq = 0; qq < 4; ++qq) { const int c = col0 + 8 * qq + 4 * hi; const f32x4 gt = *(const GAS f32x4*)(modl + 2 * NMODW + (gidx_) * 1024 + c); \
                    GAS f32x4* xp = (GAS f32x4*)(xctx + (arow - ML) * 1024 + c); const f32x4 xn = *xp + gt * (f32x4){tot[4 * qq], tot[4 * qq + 1], tot[4 * qq + 2], tot[4 * qq + 3]}; *xp = xn; \
                    tot[4 * qq] = xn[0]; tot[4 * qq + 1] = xn[1]; tot[4 * qq + 2] = xn[2]; tot[4 * qq + 3] = xn[3]; ss += (xn[0] * xn[0] + xn[1] * xn[1]) + (xn[2] * xn[2] + xn[3] * xn[3]); } \
                if (NRM_) {     \
                    unsigned* slots = (unsigned*)(ws + WS_XBUFC); unsigned* cntc = (unsigned*)(ws + WS_XCNTC) + 64 * (tile >> 5); \
                    ss += __shfl_xor(ss, 32); \
                    if (hi == 0) __hip_atomic_store(slots + (arow - ML) * 32 + (tile & 31), __float_as_uint(ss), __ATOMIC_RELAXED, __HIP_MEMORY_SCOPE_AGENT); \
                    asm volatile("s_waitcnt vmcnt(0)" ::: "memory"); \
                    if (lane == 0) __hip_atomic_fetch_add(cntc, 1u, __ATOMIC_RELAXED, __HIP_MEMORY_SCOPE_AGENT); \
                    { unsigned sp = 0; while ((unsigned)__builtin_amdgcn_readfirstlane(__hip_atomic_load(cntc, __ATOMIC_RELAXED, __HIP_MEMORY_SCOPE_AGENT)) < (want_)) { __builtin_amdgcn_s_sleep(1); if (++sp > (1u << 22)) break; } } \
                    __builtin_amdgcn_fence(__ATOMIC_ACQUIRE, "agent"); \
                    float tsum = 0.f; \
                    _Pragma("unroll 8") for (int k = 0; k < 32; ++k) tsum += __uint_as_float(__hip_atomic_load(slots + (arow - ML) * 32 + k, __ATOMIC_RELAXED, __HIP_MEMORY_SCOPE_AGENT)); \
                    const float rinv = 1.0f / sqrtf(tsum * (1.0f / 1024.0f) + 1e-6f); \
                    _Pragma("unroll") for (int qq = 0; qq < 4; ++qq) { const int c = col0 + 8 * qq + 4 * hi; \
                        const f32x4 gm = *(const GAS f32x4*)((normw_) + c) * (*(const GAS f32x4*)((modn_) + 2 * NMODW + (scidx_) * 1024 + c) + 1.0f), sh = *(const GAS f32x4*)((modn_) + 2 * NMODW + (shidx_) * 1024 + c); \
                        const f32x4 hh = (f32x4){tot[4 * qq], tot[4 * qq + 1], tot[4 * qq + 2], tot[4 * qq + 3]} * rinv * gm + sh; \
                        v2u w; w.x = pk2(hh[0], hh[1]); w.y = pk2(hh[2], hh[3]); *(GAS v2u*)(H + arow * 1024 + c) = w; } } } } } while (0)

    const bool fused_ = (a.ph_hi - a.ph_lo) > 1;
    { volatile LAS unsigned* st_ = (volatile LAS unsigned*)((LAS unsigned char*)lds + LDS_BARST); if (threadIdx.x == 0) { st_[0] = 0u; st_[1] = 0u; } __syncthreads(); }
    XcdBarrier bar; bar.bar = (unsigned*)(a.ws + WS_BAR); bar.x = 0; bar.st = (volatile LAS unsigned*)((LAS unsigned char*)lds + LDS_BARST);
    if (fused_) bar = xcd_barrier_post((unsigned*)(a.ws + WS_BAR), (volatile LAS unsigned*)((LAS unsigned char*)lds + LDS_BARST));
    unsigned long long tacc_ = 0ull, tph_ = 0ull; (void)tph_;
#if DUP_S >= 0 && DUP_S != 9
    for (int it_ = a.ph_lo * 2; it_ < a.ph_hi * 2; ++it_) { const int ph = it_ >> 1;
      const bool dupm_ = (ph == 0 && DUP_S == 8) || (ph >= 1 && ((ph - 1) & 7) == DUP_S);
      if (!(it_ & 1) || dupm_) {
#else
    for (int ph = a.ph_lo; ph < a.ph_hi; ++ph) { const int it_ = (gridDim.x == 256 && ph >= 1 && (((ph - 1) & 7) == 5 || (((ph - 1) & 7) == 0 && ph > 1))) ? 0 : 1; if (it_) {
#endif
        if (TIME_S >= 0) { tph_ = __builtin_amdgcn_s_memrealtime(); asm volatile("s_waitcnt lgkmcnt(0)" : "+s"(tph_) :: "memory"); }
        if (ph == 0) { PTRS();
            if (bx < 192) {
                typedef float f32x2_ __attribute__((ext_vector_type(2)));
                LAS float* sil = (LAS float*)ldsl + 8 * 64 * 33; LAS float* red = sil + 3072;
                for (int i = tid; i < 3072; i += NTHREADS) { const int src = i >> 10, k = i & 1023; const float v = src < 2 ? INP(1)[src * 1024 + k] : INP(3)[k]; sil[i] = v / (1.0f + expf(-v)); }
                __syncthreads();
                const int j0 = bx * 128, l = j0 / NMODW, jj = j0 % NMODW;
                const GAS float* Wm = INP(4) + (size_t)l * 1024 * NMODW + jj + 2 * lane;
                f32x2_ a0 = {0.f, 0.f}, a1 = a0, a2 = a0;
#pragma unroll 8
                for (int k = wave * 128; k < wave * 128 + 128; ++k) { const f32x2_ w = *(const GAS f32x2_*)(Wm + (size_t)k * NMODW); a0 += w * sil[k]; a1 += w * sil[1024 + k]; a2 += w * sil[2048 + k]; }
#pragma unroll
                for (int j = 0; j < 2; ++j) { red[(wave * 3 + 0) * 128 + 2 * lane + j] = a0[j]; red[(wave * 3 + 1) * 128 + 2 * lane + j] = a1[j]; red[(wave * 3 + 2) * 128 + 2 * lane + j] = a2[j]; }
                __syncthreads();
                for (int i = tid; i < 384; i += NTHREADS) { const int src = i >> 7, ci = i & 127; float s = INP(5)[l * NMODW + jj + ci];
#pragma unroll
                    for (int w = 0; w < 8; ++w) s += red[(w * 3 + src) * 128 + ci];
                    modv[(l * 3 + src) * NMODW + jj + ci] = s; }
                __syncthreads();
            }
            CONVERT_WEIGHTS(0, (GAS bf16*)(ws + WS_W), gw, NGW);
            { const int gt = bx * NTHREADS + tid, NT_ = G * NTHREADS;
              const GAS f32x4* c4 = (const GAS f32x4*)INP(2); GAS f32x4* oc4 = (GAS f32x4*)xctx;
              for (int i = gt; i < MC * 1024 / 4; i += NT_) oc4[i] = c4[i];
              for (int i = gt; i < 8192 * 32; i += NT_) { const int t = i >> 5, ax = (i >> 4) & 1, f = i & 15; const float pos = (float)(ax ? (t & 63) : (t >> 6));
                  const float invf = powf(10000.0f, -(float)(2 * f) / 32.0f); const float ang = pos * invf; cosT[i] = cosf(ang); sinT[i] = sinf(ang); } }
        } else {
            const int s = (ph - 1) & 7;
            if (s == 0) { PTRS();
                NORM_ROWS((l == 0 ? INP(0) : (const GAS float*)xlat), INP(6) + l * 1024, modl, 0, 1, ((l > 0 && G == 256) ? ML : 0), MT);
            } else if (s == 1) { PTRS();
                pg8::Gemm g{(const pg8::bf16_t*)H, (const pg8::bf16_t*)(Wb + WO_IN), MT, INW, 1024}; pg8::StaticOrder S; S.init(MT, INW, G, bx);
                pg8::EpiInProj E{PCONV, Qb, Kb, Vb, PSG, PG, INP(8) + l * 64, INP(9) + l * 64, cosT, sinT};
                pg8::gemm_phase<pg8::EpiInProj, pg8::StaticOrder, true, true>(ldsl, g, S, E);
                if (!last) { const int nbusy = (MT / 256) * (INW / 256) - ((MT / 256) * (INW / 256) / G) * G;
                    if (G - nbusy >= G / 2) { if (bx >= nbusy) CONVERT_WEIGHTS(l + 1, Wn, (bx - nbusy) * NWAVES + wave, (G - nbusy) * NWAVES); } else CONVERT_WEIGHTS(l + 1, Wn, gw, NGW); }
            } else if (s == 2) { PTRS();
                for (int ra_ = 0; ra_ < DUP_ATT; ++ra_) {
                const int upb = (512 + G - 1) / G;
                float mq_ = __builtin_fabsf(INP(8)[l * 64 + lane]), mk_ = __builtin_fabsf(INP(9)[l * 64 + lane]);
#pragma unroll
                for (int o = 1; o < 64; o <<= 1) { mq_ = __builtin_fmaxf(mq_, __shfl_xor(mq_, o)); mk_ = __builtin_fmaxf(mk_, __shfl_xor(mk_, o)); }
                const bool nomax = __builtin_amdgcn_readfirstlane((int)(64.0f * attn_body::C2 * mq_ * mk_ < 48.0f)) != 0;
                for (int i = 0;; ++i) { long qrow0_, kvrow0_; int h_, nt_;
                    if (i < upb) { const int uid = vcu * upb + i; if (uid >= 512) continue;
                        const int bhk = uid >> 7, rem = uid & 127, hg = rem >> 5, qb = rem & 31, b = bhk >> 1; h_ = (bhk & 1) * 4 + hg; qrow0_ = (long)b * 8192 + qb * 256; kvrow0_ = (long)b * 8448; nt_ = 132; }
                    else { const int uid = vcu + (i - upb) * G; if (last || uid >= 16) break; const int b = uid >> 3; h_ = uid & 7; qrow0_ = (long)ML + b * 256; kvrow0_ = (long)b * 8448 + 8192; nt_ = 4; }
                    if (nomax) attn_body::attn_unit<8, true>(qrow0_, h_, kvrow0_, nt_, (const attn_body::bf16*)Qb, (const attn_body::bf16*)Kb, (const attn_body::bf16*)Vb, (attn_body::bf16*)(Zcat + 256), (char*)lds);
                    else attn_body::attn_unit<8, false>(qrow0_, h_, kvrow0_, nt_, (const attn_body::bf16*)Qb, (const attn_body::bf16*)Kb, (const attn_body::bf16*)Vb, (attn_body::bf16*)(Zcat + 256), (char*)lds); }
                }
                __syncthreads();
                for (int rs_ = 0; rs_ < DUP_SG; ++rs_) {
                { const GAS float* cw = INP(10) + l * 768 + 4 * lane; const f32x4 w0 = *(const GAS f32x4*)cw, w1 = *(const GAS f32x4*)(cw + 256), w2 = *(const GAS f32x4*)(cw + 512);
                  for (int r = gw; r < Mrows; r += NGW) { const bool latent = r < ML; const int pos = latent ? (r & 8191) : ((r - ML) & 255), len = latent ? 8192 : 256;
                      const GAS bf16* p = PCONV + (size_t)r * 512 + 4 * lane;
                      const v2u ab = *(const GAS v2u*)p, q0 = *(const GAS v2u*)(p + 256);
                      v2u qm = {0u, 0u}, qp = qm;
                      if (pos > 0) qm = *(const GAS v2u*)(p - 512 + 256);
                      if (pos < len - 1) qp = *(const GAS v2u*)(p + 512 + 256);
                      const f32x4 pm = {bflo(qm.x), bfhi(qm.x), bflo(qm.y), bfhi(qm.y)}, p0 = {bflo(q0.x), bfhi(q0.x), bflo(q0.y), bfhi(q0.y)}, pp = {bflo(qp.x), bfhi(qp.x), bflo(qp.y), bfhi(qp.y)};
                      const f32x4 av = {bflo(ab.x), bfhi(ab.x), bflo(ab.y), bfhi(ab.y)};
                      const f32x4 o = av * (w0 * pm + w1 * p0 + w2 * pp);
                      v2u w; w.x = pk2(o[0], o[1]); w.y = pk2(o[2], o[3]); *(GAS v2u*)(Zcat + (size_t)r * 1024 + 4 * lane) = w; } }
                { typedef short bf16x8_t __attribute__((ext_vector_type(8))); typedef float f32x16_t __attribute__((ext_vector_type(16)));
                  LAS unsigned short* VT = (LAS unsigned short*)ldsl;
                  const int nitems = (Mrows / 128) * 4;
                  for (int item = bx; item < nitems; item += G) { const int chunk = item >> 2, g = item & 3, rb = chunk * 128;
                      { const int sub = lane >> 4, li = lane & 15;
#pragma unroll
                        for (int i = 0; i < 4; ++i) { const int srow = 16 * wave + 4 * i + sub; const GAS bf16* sp = PSG + (size_t)(rb + srow) * 512 + 256 + 16 * li;
                            const v4u r0 = *(const GAS v4u*)sp, r1 = *(const GAS v4u*)(sp + 8);
                            const float fv[16] = {bflo(r0.x), bfhi(r0.x), bflo(r0.y), bfhi(r0.y), bflo(r0.z), bfhi(r0.z), bflo(r0.w), bfhi(r0.w), bflo(r1.x), bfhi(r1.x), bflo(r1.y), bfhi(r1.y), bflo(r1.z), bfhi(r1.z), bflo(r1.w), bfhi(r1.w)};
                            float ss = 0.f;
#pragma unroll
                            for (int j = 0; j < 16; ++j) ss += fv[j] * fv[j];
                            ss += __shfl_xor(ss, 1); ss += __shfl_xor(ss, 2); ss += __shfl_xor(ss, 4); ss += __shfl_xor(ss, 8);
                            const float rinv = 1.0f / sqrtf(ss * (1.0f / 256.0f) + 1e-6f);
                            if ((li >> 2) == g) { const int d0 = 16 * (li & 3); const GAS float* gp_ = INP(11) + l * 256 + g * 64 + d0;
#pragma unroll
                                for (int j4 = 0; j4 < 4; ++j4) { const f32x4 gn = *(const GAS f32x4*)(gp_ + 4 * j4);
#pragma unroll
                                    for (int j = 0; j < 4; ++j) VT[(d0 + 4 * j4 + j) * 136 + srow] = (unsigned short)f2bf(fv[4 * j4 + j] * rinv * gn[j]); } } } }
                      __syncthreads();
                      const int tm = wave >> 1, tn = wave & 1, r32 = lane & 31, hi = lane >> 5;
                      const GAS float* Wrow = INP(12) + (size_t)(l * 4 + g) * 128 * 128 + (size_t)(32 * tm + r32) * 128 + 8 * hi;
                      const LAS unsigned short* Vrow = VT + (32 * tn + r32) * 136 + 8 * hi;
                      f32x16_t acc; for (int r = 0; r < 16; ++r) acc[r] = 0.f;
#pragma unroll
                      for (int k0 = 0; k0 < 8; ++k0) { const f32x4 w0 = *(const GAS f32x4*)(Wrow + 16 * k0), w1 = *(const GAS f32x4*)(Wrow + 16 * k0 + 4);
                          const v4u wp = {pk2(w0[0], w0[1]), pk2(w0[2], w0[3]), pk2(w1[0], w1[1]), pk2(w1[2], w1[3])};
                          const bf16x8_t af = *(const LAS bf16x8_t*)(Vrow + 16 * k0);
                          acc = __builtin_amdgcn_mfma_f32_32x32x16_bf16(af, __builtin_bit_cast(bf16x8_t, wp), acc, 0, 0, 0); }
                      const int t = 32 * tm + r32; const float bias = INP(13)[(l * 4 + g) * 128 + t]; const size_t row = (size_t)(rb + t);
#pragma unroll
                      for (int q = 0; q < 4; ++q) { const int dcol = g * 64 + 32 * tn + 8 * q + 4 * hi;
                          const v2u uu = *(const GAS v2u*)(PSG + row * 512 + dcol);
                          v2u o; o.x = pk2(bflo(uu.x) * (acc[4 * q + 0] + bias), bfhi(uu.x) * (acc[4 * q + 1] + bias)); o.y = pk2(bflo(uu.y) * (acc[4 * q + 2] + bias), bfhi(uu.y) * (acc[4 * q + 3] + bias));
                          *(GAS v2u*)(Zcat + row * 1024 + 768 + dcol) = o; }
                      __syncthreads(); } }
                }
            } else if (s == 3) { PTRS();
                pg8::StaticOrder S; S.init(ML, 1024, G, bx);
                { pg8::Gemm g{(const pg8::bf16_t*)Zcat, (const pg8::bf16_t*)(Wb + WO_A), ML, 1024, 1024}; pg8::EpiMergeFused E{PG, Zb}; pg8::gemm_phase<pg8::EpiMergeFused, pg8::StaticOrder, true, true>(ldsl, g, S, E); }
                if (!last) CTX_MERGE();
            } else if (s == 4) { PTRS();
                pg8::Gemm g{(const pg8::bf16_t*)Zb, (const pg8::bf16_t*)(Wb + WO_O), ML, 1024, 1024}; pg8::StaticOrder S; S.init(ML, 1024, G, bx);
                if (G == 256) { pg8::EpiResidNorm E{(l == 0 ? INP(0) : (const GAS float*)xlat), xlat, modl, 2, H, INP(18) + l * 1024, modl, 3, 4, (unsigned*)(ws + WS_XBUF), (unsigned*)(ws + WS_XCNT), 32u * (unsigned)(2 * l + 1)};
                    pg8::gemm_phase<pg8::EpiResidNorm, pg8::StaticOrder, false, true>(ldsl, g, S, E); }
                else { pg8::EpiResid E{(l == 0 ? INP(0) : (const GAS float*)xlat), xlat, xctx, modl, 2}; pg8::gemm_phase<pg8::EpiResid, pg8::StaticOrder, true, true>(ldsl, g, S, E); }
                if (!last) { if (G == 256) CTX_RESID(Zb, 1024, WO_O, 2, 1, INP(18) + l * 1024, modl, 3, 4, 32u * (unsigned)(2 * l + 1)); else CTX_RESID(Zb, 1024, WO_O, 2, 0, INP(18), modl, 3, 4, 0u); }
            } else if (s == 5) { PTRS();
                NORM_ROWS((const GAS float*)xlat, INP(18) + l * 1024, modl, 3, 4, (G == 256 ? ML : 0), Mrows);
            } else if (s == 6) { PTRS();
                pg8::Gemm g{(const pg8::bf16_t*)H, (const pg8::bf16_t*)(Wb + WO_13), Mrows, 2 * DFF, 1024}; pg8::StaticOrder S; S.init(Mrows, 2 * DFF, G, bx);
                pg8::EpiSwiGLU E{HFF}; pg8::gemm_phase<pg8::EpiSwiGLU, pg8::StaticOrder, true, true>(ldsl, g, S, E);
            } else { PTRS();
                pg8::Gemm g{(const pg8::bf16_t*)HFF, (const pg8::bf16_t*)(Wb + WO_2), ML, 1024, DFF}; pg8::StaticOrder S; S.init(ML, 1024, G, bx);
                if (G == 256 && !last) { pg8::EpiResidNorm E{(const GAS float*)xlat, xlat, modl, 5, H, INP(6) + (l + 1) * 1024, modv + (size_t)(l + 1) * 3 * NMODW, 0, 1, (unsigned*)(ws + WS_XBUF), (unsigned*)(ws + WS_XCNT), 32u * (unsigned)(2 * l + 2)};
                    pg8::gemm_phase<pg8::EpiResidNorm, pg8::StaticOrder, false, true>(ldsl, g, S, E); }
                else { pg8::EpiResid E{(const GAS float*)xlat, xlat, xctx, modl, 5}; pg8::gemm_phase<pg8::EpiResid, pg8::StaticOrder, true, true>(ldsl, g, S, E); }
                if (!last) { if (G == 256) CTX_RESID(HFF, DFF, WO_2, 5, 1, INP(6) + (l + 1) * 1024, modv + (size_t)(l + 1) * 3 * NMODW, 0, 1, 32u * (unsigned)(2 * l + 2)); else CTX_RESID(HFF, DFF, WO_2, 5, 0, INP(6), modl, 0, 1, 0u); }
            }
        }
      }
        if ((it_ & 1) && ph + 1 < a.ph_hi) { if (a.ph_hi > NPHASE) { asm volatile("s_waitcnt vmcnt(0)" ::: "memory"); cg::this_grid().sync(); } xcd_barrier(bar); if (DUP_S == 9) xcd_barrier(bar); }
        if (TIME_S >= 0 && (((TIME_MASK) >> (ph == 0 ? 8 : ((ph - 1) & 7))) & 1)) tacc_ += __builtin_amdgcn_s_memrealtime() - tph_;
    }
    if (TIME_S >= 0 && blockIdx.x == 0) { const unsigned long long te_ = __builtin_amdgcn_s_memrealtime() + tacc_; while (__builtin_amdgcn_s_memrealtime() < te_) __builtin_amdgcn_s_sleep(8); }
}

extern "C" void kernel_launch(void* const* d_in, const int* in_sizes, int n_in, void* d_out, int out_size, void* d_ws, size_t ws_size, hipStream_t stream) {
    static int grid = 0;
    if (grid == 0) {
        if (n_in != 22 || ws_size < WS_END) { fprintf(stderr, "kernel_launch: unexpected n_in %d / ws %zu (need %zu)\n", n_in, ws_size, (size_t)WS_END); grid = -1; return; }
        int dev = 0, cus = 0, per_cu = 0;
        (void)hipGetDevice(&dev); (void)hipDeviceGetAttribute(&cus, hipDeviceAttributeMultiprocessorCount, dev);
        if (hipFuncSetAttribute((const void*)fwd_kernel, hipFuncAttributeMaxDynamicSharedMemorySize, LDS_BYTES) != hipSuccess) { fprintf(stderr, "kernel_launch: hipFuncSetAttribute failed\n"); grid = -1; return; }
        if (hipOccupancyMaxActiveBlocksPerMultiprocessor(&per_cu, (const void*)fwd_kernel, NTHREADS, LDS_BYTES) != hipSuccess || per_cu < 1) { (void)hipGetLastError(); per_cu = 1; }
        grid = cus * per_cu; if (grid <= 0) grid = 256;
    }
    if (grid < 0) return;
    (void)hipMemsetAsync((char*)d_ws + WS_BAR, 0, BAR_BYTES, stream);
    Args a{};
    for (int i = 0; i < 22; ++i) a.in[i] = (const float*)d_in[i];
    a.out = (float*)d_out; a.ws = (unsigned char*)d_ws;
#if MK_MULTI
    for (int ph = 0; ph < NPHASE; ++ph) { a.ph_lo = ph; a.ph_hi = ph + 1; hipLaunchKernelGGL(fwd_kernel, dim3(grid), dim3(NTHREADS), LDS_BYTES, stream, a); }
#else
    a.ph_lo = 0; a.ph_hi = NPHASE;
    void* args[] = {&a};
    hipError_t e = hipLaunchCooperativeKernel((const void*)fwd_kernel, dim3(grid), dim3(NTHREADS), args, LDS_BYTES, stream);
    if (e != hipSuccess) fprintf(stderr, "cooperative launch failed: %s (grid %d)\n", hipGetErrorString(e), grid);
#endif
}
```

```cpp
#include <hip/hip_runtime.h>
#include <hip/hip_cooperative_groups.h>
#include <hip/hip_bf16.h>
#include <cstdio>
#include <cstdint>
#include <cmath>
namespace cg = cooperative_groups;

namespace pg8 {
#define PG8_LAS __attribute__((address_space(3)))
typedef unsigned short bf16_t;
typedef short bf16x8 __attribute__((ext_vector_type(8)));
typedef float f32x4 __attribute__((ext_vector_type(4)));
typedef unsigned u32x4 __attribute__((ext_vector_type(4)));
constexpr int BM = 256, BK = 64, HALF = 128, HTB = HALF * BK * 2  , STAGE_BYTES = 8 * HTB, NXCD = 8, WGM = 8;

__host__ __device__ __forceinline__ int lds_byte(int r, int c) { const int st = (r >> 4) * 2 + (c >> 5), rr = r & 15, cc = c & 31, ob = rr * 64 + cc * 2; return st * 1024 + (ob ^ (((ob >> 9) & 1) << 5)); }
__host__ __device__ __forceinline__ void stage_rc(int b, int& R, int& C) { const int st = b / 1024, sb = b % 1024, swz = sb ^ (((sb >> 9) & 1) << 5); R = (st >> 1) * 16 + swz / 64; C = (st & 1) * 32 + (swz % 64) / 2; }
__host__ __device__ __forceinline__ int perm32(int rho) { const int n = rho >> 4, i = rho & 15; return 8 * (i >> 2) + 4 * n + (i & 3); }

struct Unit { int pm, pn; };
struct Gemm { const bf16_t* A; const bf16_t* Bt; int M, N, K; };

struct StaticOrder {
    int nM, nN, nwg, G, c;
    __host__ __device__ void init(int M, int N, int G_, int c_) { nM = M / BM; nN = N / BM; nwg = nM * nN; G = G_; c = c_; }
    __host__ __device__ bool next(int i, Unit& u) const {
        const long L = (long)i * G + c; if (L >= nwg) return false;
        int wgid = (int)L; { const int q = nwg / NXCD, r = nwg % NXCD, xcd = wgid % NXCD, off = wgid / NXCD; wgid = (xcd < r ? xcd * (q + 1) : r * (q + 1) + (xcd - r) * q) + off; }
        const int nig = WGM * nN, gid = wgid / nig, fm = gid * WGM, gsz = (nM - fm) < WGM ? (nM - fm) : WGM;
        u.pm = fm + ((wgid % nig) % gsz); u.pn = (wgid % nig) / gsz; return true;
    }
    __device__ __forceinline__ void a_ready(const Unit&) const {}
    __device__ __forceinline__ void done(const Unit&) const {}
};

__device__ __forceinline__ unsigned cvt_pk_bf16(float lo, float hi) { unsigned r; asm volatile("v_cvt_pk_bf16_f32 %0, %1, %2" : "=v"(r) : "v"(lo), "v"(hi)); return r; }
typedef float f32x2 __attribute__((ext_vector_type(2)));
__device__ __forceinline__ float bf_lo(unsigned w) { return __uint_as_float(w << 16); }
__device__ __forceinline__ float bf_hi(unsigned w) { return __uint_as_float(w & 0xffff0000u); }
__device__ __forceinline__ float sigmoid_f(float x) { return __builtin_amdgcn_rcpf(1.0f + __builtin_amdgcn_exp2f(-1.4426950408889634f * x)); }
__device__ __forceinline__ float gelu_tanh_f(float x) { const float in2 = 1.5957691216057308f * (x + 0.044715f * x * x * x); return x * sigmoid_f(in2); }
__device__ __forceinline__ f32x4 act4(f32x4 v, int act) {
    if (act == 1) return (f32x4){gelu_tanh_f(v[0]), gelu_tanh_f(v[1]), gelu_tanh_f(v[2]), gelu_tanh_f(v[3])};
    if (act == 2) return (f32x4){sigmoid_f(v[0]), sigmoid_f(v[1]), sigmoid_f(v[2]), sigmoid_f(v[3])};
    return v;
}
constexpr float ATT_C2 = 0.125f * 1.4426950408889634f;
typedef unsigned u32x2 __attribute__((ext_vector_type(2)));
#define GAS __attribute__((address_space(1)))
struct EpiInProj {
    static constexpr bool PERM = true, AFTER_DRAIN = false, HAS_HOOK = false;
    GAS bf16_t *PCONV, *Q, *Kb, *Vb, *PSG, *PG; const GAS float *qg, *kg, *cosT, *sinT;
    __device__ __forceinline__ void operator()(const f32x4 (&acc)[2][2][4][2], const Unit& u, int wr, int wc, int fr, int fq) const {
        const int row0 = u.pm * BM + wr * 64 + fr, pn = u.pn;
        if (pn >= 3 && pn < 6) {
            const bool isq = pn < 5, isv = (pn == 5) && (wc >= 2), latent = u.pm < 64;
            const GAS float* gp = isq ? qg : kg;
            f32x4 gn[2][2];
#pragma unroll
            for (int bj = 0; bj < 2; ++bj)
#pragma unroll
                for (int n = 0; n < 2; ++n) gn[bj][n] = *(const GAS f32x4*)(gp + 32 * bj + 16 * n + 4 * fq);
#pragma unroll
            for (int ai = 0; ai < 2; ++ai)
#pragma unroll
                for (int m = 0; m < 4; ++m) {
                    const int row = row0 + ai * HALF + m * 16;
                    f32x4 v[2][2];
#pragma unroll
                    for (int bj = 0; bj < 2; ++bj)
#pragma unroll
                        for (int n = 0; n < 2; ++n) v[bj][n] = acc[ai][bj][m][n];
                    if (!isv) {
                        float ss = 0.f;
#pragma unroll
                        for (int bj = 0; bj < 2; ++bj)
#pragma unroll
                            for (int n = 0; n < 2; ++n) { const f32x4 x = v[bj][n]; ss += (x[0] * x[0] + x[1] * x[1]) + (x[2] * x[2] + x[3] * x[3]); }
                        ss += __shfl_xor(ss, 16); ss += __shfl_xor(ss, 32);
                        const float r = (1.0f / sqrtf(ss * (1.0f / 64.0f) + 1e-6f)) * (isq ? ATT_C2 : 1.0f);
#pragma unroll
                        for (int bj = 0; bj < 2; ++bj)
#pragma unroll
                            for (int n = 0; n < 2; ++n) v[bj][n] = v[bj][n] * gn[bj][n] * r;
                        if (latent) {
                            const int t = row & 8191;
#pragma unroll
                            for (int bj = 0; bj < 2; ++bj) {
                                const f32x4 c = *(const GAS f32x4*)(cosT + t * 32 + bj * 16 + 4 * fq), s = *(const GAS f32x4*)(sinT + t * 32 + bj * 16 + 4 * fq);
                                const f32x4 x1 = v[bj][0], x2 = v[bj][1];
                                v[bj][0] = x1 * c - x2 * s; v[bj][1] = x2 * c + x1 * s;
                            }
                        }
                    }
                    GAS bf16_t* dst;
                    if (isq) dst = Q + (size_t)row * 512 + (pn - 3) * 256 + wc * 64;
                    else {
                        const int rc = row - 16384;
                        const size_t kvrow = latent ? (size_t)((row >> 13) * 8448 + (row & 8191)) : (size_t)((rc >> 8) * 8448 + 8192 + (rc & 255));
                        dst = isv ? Vb + kvrow * 128 + (wc - 2) * 64 : Kb + kvrow * 128 + wc * 64;
                    }
#pragma unroll
                    for (int bj = 0; bj < 2; ++bj)
#pragma unroll
                        for (int n = 0; n < 2; ++n) { u32x2 w; w.x = cvt_pk_bf16(v[bj][n][0], v[bj][n][1]); w.y = cvt_pk_bf16(v[bj][n][2], v[bj][n][3]);
                            *(GAS u32x2*)(dst + 32 * bj + 16 * n + 4 * fq) = w; }
                }
        } else if (pn == 1 || pn == 2) {
            const int col0 = 256 + (pn - 1) * 128 + wc * 32 + 8 * fq;
#pragma unroll
            for (int ai = 0; ai < 2; ++ai)
#pragma unroll
                for (int m = 0; m < 4; ++m) { const f32x4 v0 = acc[ai][0][m][0] * acc[ai][1][m][0], v1 = acc[ai][0][m][1] * acc[ai][1][m][1];
                    u32x4 w; w.x = cvt_pk_bf16(v0[0], v0[1]); w.y = cvt_pk_bf16(v0[2], v0[3]); w.z = cvt_pk_bf16(v1[0], v1[1]); w.w = cvt_pk_bf16(v1[2], v1[3]);
                    *(GAS u32x4*)(PCONV + (size_t)(row0 + ai * HALF + m * 16) * 512 + col0) = w; }
        } else {
            GAS bf16_t* base; int ld, colt, act;
            if (pn < 3) { base = PCONV; ld = 512; colt = 0; act = 0; }
            else if (pn < 8) { base = PSG; ld = 512; colt = (pn - 6) * 256; act = 1; }
            else { base = PG; ld = 3072; colt = (pn - 8) * 256; act = 2; }
            const int col0 = colt + wc * 32 + 8 * fq;
#pragma unroll
            for (int ai = 0; ai < 2; ++ai)
#pragma unroll
                for (int m = 0; m < 4; ++m) { GAS bf16_t* rowp = base + (size_t)(row0 + ai * HALF + m * 16) * ld + col0;
#pragma unroll
                    for (int bj = 0; bj < 2; ++bj) { const f32x4 v0 = act4(acc[ai][bj][m][0], act), v1 = act4(acc[ai][bj][m][1], act);
                        u32x4 w; w.x = cvt_pk_bf16(v0[0], v0[1]); w.y = cvt_pk_bf16(v0[2], v0[3]); w.z = cvt_pk_bf16(v1[0], v1[1]); w.w = cvt_pk_bf16(v1[2], v1[3]);
                        *(GAS u32x4*)(rowp + bj * HALF) = w; } }
        }
    }
};
struct EpiMergeFused {
    static constexpr bool PERM = true, AFTER_DRAIN = false, HAS_HOOK = true; static constexpr int T1 = 4, T2 = 12;
    const GAS bf16_t* PG; GAS bf16_t* z;
    __device__ __forceinline__ void hook(f32x4 (&acc)[2][2][4][2], const Unit& u, int t, int wr, int wc, int fr, int fq) const {
        asm volatile("" : "+v"(fr), "+v"(fq));
        const int row0 = u.pm * BM + wr * 64 + fr, col0 = u.pn * BM + wc * 32 + 8 * fq, goff = (t == T1) ? 0 : 1024;
#pragma unroll
        for (int ai = 0; ai < 2; ++ai)
#pragma unroll
            for (int m = 0; m < 4; ++m) { const size_t row = (size_t)(row0 + ai * HALF + m * 16);
#pragma unroll
                for (int bj = 0; bj < 2; ++bj) { const GAS bf16_t* gp = PG + row * 3072 + goff + col0 + bj * HALF;
                    const u32x4 gn = *(const GAS u32x4*)gp, gd = *(const GAS u32x4*)(gp + 1024);
                    const f32x4 n0 = {bf_lo(gn.x), bf_hi(gn.x), bf_lo(gn.y), bf_hi(gn.y)}, n1 = {bf_lo(gn.z), bf_hi(gn.z), bf_lo(gn.w), bf_hi(gn.w)};
                    f32x4 d0 = {bf_lo(gd.x), bf_hi(gd.x), bf_lo(gd.y), bf_hi(gd.y)}, d1 = {bf_lo(gd.z), bf_hi(gd.z), bf_lo(gd.w), bf_hi(gd.w)};
#pragma unroll
                    for (int j = 0; j < 4; ++j) { d0[j] = __builtin_amdgcn_rcpf(__builtin_fmaxf(d0[j], 1e-30f)); d1[j] = __builtin_amdgcn_rcpf(__builtin_fmaxf(d1[j], 1e-30f)); }
                    acc[ai][bj][m][0] = acc[ai][bj][m][0] * (n0 * d0); acc[ai][bj][m][1] = acc[ai][bj][m][1] * (n1 * d1); } }
    }
    __device__ __forceinline__ void operator()(const f32x4 (&acc)[2][2][4][2], const Unit& u, int wr, int wc, int fr, int fq) const {
        asm volatile("" : "+v"(fr), "+v"(fq));
        const int row0 = u.pm * BM + wr * 64 + fr, col0 = u.pn * BM + wc * 32 + 8 * fq;
#pragma unroll
        for (int ai = 0; ai < 2; ++ai)
#pragma unroll
            for (int m = 0; m < 4; ++m) { const size_t row = (size_t)(row0 + ai * HALF + m * 16);
#pragma unroll
                for (int bj = 0; bj < 2; ++bj) { const int col = col0 + bj * HALF;
                    const u32x4 gw = *(const GAS u32x4*)(PG + row * 3072 + 2048 + col);
                    const f32x4 v0 = acc[ai][bj][m][0] * (f32x4){bf_lo(gw.x), bf_hi(gw.x), bf_lo(gw.y), bf_hi(gw.y)};
                    const f32x4 v1 = acc[ai][bj][m][1] * (f32x4){bf_lo(gw.z), bf_hi(gw.z), bf_lo(gw.w), bf_hi(gw.w)};
                    u32x4 w; w.x = cvt_pk_bf16(v0[0], v0[1]); w.y = cvt_pk_bf16(v0[2], v0[3]); w.z = cvt_pk_bf16(v1[0], v1[1]); w.w = cvt_pk_bf16(v1[2], v1[3]);
                    *(GAS u32x4*)(z + row * 1024 + col) = w; } }
    }
};
struct EpiResid {
    static constexpr bool PERM = false, AFTER_DRAIN = false, HAS_HOOK = false;
    const GAS float* xsrc; GAS float* xlat; GAS float* xctx; const GAS float* modl; int gidx;
    __device__ __forceinline__ void operator()(const f32x4 (&acc)[2][2][4][2], const Unit& u, int wr, int wc, int fr, int fq) const {
        const int row0 = u.pm * BM + wr * 64 + fr, col0 = u.pn * BM + wc * 32 + 4 * fq;
        const bool latent = u.pm < 64; const int src = latent ? (u.pm >> 5) : 2;
        f32x4 gt[2][2];
#pragma unroll
        for (int bj = 0; bj < 2; ++bj)
#pragma unroll
            for (int n = 0; n < 2; ++n) gt[bj][n] = *(const GAS f32x4*)(modl + src * 6144 + gidx * 1024 + col0 + bj * HALF + n * 16);
#pragma unroll
        for (int ai = 0; ai < 2; ++ai)
#pragma unroll
            for (int m = 0; m < 4; ++m) { const int row = row0 + ai * HALF + m * 16;
                GAS float* xp = (latent ? xlat + (size_t)row * 1024 : xctx + (size_t)(row - 16384) * 1024) + col0;
                const GAS float* xs = (latent ? xsrc + (size_t)row * 1024 : xctx + (size_t)(row - 16384) * 1024) + col0;
#pragma unroll
                for (int bj = 0; bj < 2; ++bj)
#pragma unroll
                    for (int n = 0; n < 2; ++n) { *(GAS f32x4*)(xp + bj * HALF + n * 16) = *(const GAS f32x4*)(xs + bj * HALF + n * 16) + gt[bj][n] * acc[ai][bj][m][n]; } }
    }
};
struct EpiResidNorm {
    static constexpr bool PERM = true, AFTER_DRAIN = true, HAS_HOOK = false;
    const GAS float* xsrc; GAS float* xlat; const GAS float* modl; int gidx; GAS bf16_t* Hout; const GAS float* normw; const GAS float* modn; int shidx, scidx;
    unsigned* xbuf; unsigned* cnt; unsigned want;
    __device__ __forceinline__ void operator()(const f32x4 (&)[2][2][4][2], const Unit&, int, int, int, int) const {}
    __device__ __forceinline__ void fused(f32x4 (&acc)[2][2][4][2], const Unit& u, int wr, int wc, int fr, int fq, PG8_LAS unsigned char* lds, int wid, int lane) const {
        asm volatile("" : "+v"(fr), "+v"(fq));
        PG8_LAS float* P = (PG8_LAS float*)lds;
        PG8_LAS float* S = (PG8_LAS float*)(lds + 4096);
        const int row0 = u.pm * BM + wr * 64 + fr, col0 = u.pn * BM + wc * 32 + 8 * fq, src = u.pm >> 5;
        f32x4 gt[2][2];
#pragma unroll
        for (int bj = 0; bj < 2; ++bj)
#pragma unroll
            for (int n = 0; n < 2; ++n) gt[bj][n] = *(const GAS f32x4*)(modl + src * 6144 + gidx * 1024 + col0 + bj * HALF + n * 4);
#pragma unroll
        for (int ai = 0; ai < 2; ++ai)
#pragma unroll
            for (int m = 0; m < 4; ++m) { const int row = row0 + ai * HALF + m * 16; float ss = 0.f;
                GAS float* xp = xlat + (size_t)row * 1024 + col0; const GAS float* xs = xsrc + (size_t)row * 1024 + col0;
#pragma unroll
                for (int bj = 0; bj < 2; ++bj)
#pragma unroll
                    for (int n = 0; n < 2; ++n) { const f32x4 xn = *(const GAS f32x4*)(xs + bj * HALF + n * 4) + gt[bj][n] * acc[ai][bj][m][n]; acc[ai][bj][m][n] = xn;
                        *(GAS f32x4*)(xp + bj * HALF + n * 4) = xn; ss += (xn[0] * xn[0] + xn[1] * xn[1]) + (xn[2] * xn[2] + xn[3] * xn[3]); }
                ss += __shfl_xor(ss, 16); ss += __shfl_xor(ss, 32);
                if (fq == 0) P[(ai * HALF + wr * 64 + m * 16 + fr) * 4 + wc] = ss; }
        asm volatile("s_waitcnt lgkmcnt(0)" ::: "memory"); __builtin_amdgcn_s_barrier(); asm volatile("" ::: "memory");
        const int rl = wid * 32 + (lane & 31);
        if (lane < 32) { const float t = (P[rl * 4 + 0] + P[rl * 4 + 1]) + (P[rl * 4 + 2] + P[rl * 4 + 3]);
            __hip_atomic_store(xbuf + ((size_t)(u.pm * BM + rl) * 4 + u.pn), __float_as_uint(t), __ATOMIC_RELAXED, __HIP_MEMORY_SCOPE_AGENT); }
        asm volatile("s_waitcnt vmcnt(0)" ::: "memory");
        if (lane == 0) __hip_atomic_fetch_add(cnt + 64 * u.pm, 1u, __ATOMIC_RELAXED, __HIP_MEMORY_SCOPE_AGENT);
        if (wid == 0) { unsigned sp = 0;
            while ((unsigned)__builtin_amdgcn_readfirstlane(__hip_atomic_load(cnt + 64 * u.pm, __ATOMIC_RELAXED, __HIP_MEMORY_SCOPE_AGENT)) < want) { __builtin_amdgcn_s_sleep(1); if (++sp > (1u << 22)) break; }
            __builtin_amdgcn_fence(__ATOMIC_ACQUIRE, "agent"); }
        asm volatile("s_waitcnt vmcnt(0) lgkmcnt(0)" ::: "memory"); __builtin_amdgcn_s_barrier(); asm volatile("" ::: "memory");
        if (lane < 32) { const unsigned* sl = xbuf + (size_t)(u.pm * BM + rl) * 4; float t = 0.f;
#pragma unroll
            for (int k = 0; k < 4; ++k) t += __uint_as_float(__hip_atomic_load(sl + k, __ATOMIC_RELAXED, __HIP_MEMORY_SCOPE_AGENT));
            S[rl] = 1.0f / sqrtf(t * (1.0f / 1024.0f) + 1e-6f); }
        asm volatile("s_waitcnt vmcnt(0) lgkmcnt(0)" ::: "memory"); __builtin_amdgcn_s_barrier(); asm volatile("" ::: "memory");
        const GAS float* shp = modn + src * 6144 + shidx * 1024 + col0; const GAS float* scp = modn + src * 6144 + scidx * 1024 + col0; const GAS float* nwp = normw + col0;
#pragma unroll
        for (int bj = 0; bj < 2; ++bj) { const int co = bj * HALF;
            const f32x4 gm0 = *(const GAS f32x4*)(nwp + co) * (*(const GAS f32x4*)(scp + co) + 1.0f), sh0 = *(const GAS f32x4*)(shp + co);
            const f32x4 gm1 = *(const GAS f32x4*)(nwp + co + 4) * (*(const GAS f32x4*)(scp + co + 4) + 1.0f), sh1 = *(const GAS f32x4*)(shp + co + 4);
#pragma unroll
            for (int ai = 0; ai < 2; ++ai)
#pragma unroll
                for (int m = 0; m < 4; ++m) { const int rloc = ai * HALF + wr * 64 + m * 16 + fr; const float rinv = S[rloc];
                    const f32x4 h0 = acc[ai][bj][m][0] * rinv * gm0 + sh0, h1 = acc[ai][bj][m][1] * rinv * gm1 + sh1;
                    u32x4 w; w.x = cvt_pk_bf16(h0[0], h0[1]); w.y = cvt_pk_bf16(h0[2], h0[3]); w.z = cvt_pk_bf16(h1[0], h1[1]); w.w = cvt_pk_bf16(h1[2], h1[3]);
                    *(GAS u32x4*)(Hout + (size_t)(u.pm * BM + rloc) * 1024 + col0 + co) = w; } }
    }
};
struct EpiSwiGLU {
    static constexpr bool PERM = true, AFTER_DRAIN = false, HAS_HOOK = false;
    GAS bf16_t* HFF;
    __device__ __forceinline__ void operator()(const f32x4 (&acc)[2][2][4][2], const Unit& u, int wr, int wc, int fr, int fq) const {
        const int row0 = u.pm * BM + wr * 64 + fr, col0 = u.pn * HALF + wc * 32 + 8 * fq;
#pragma unroll
        for (int ai = 0; ai < 2; ++ai)
#pragma unroll
            for (int m = 0; m < 4; ++m) { const size_t row = (size_t)(row0 + ai * HALF + m * 16);
                const f32x4 a0 = acc[ai][0][m][0], a1 = acc[ai][0][m][1], b0 = acc[ai][1][m][0], b1 = acc[ai][1][m][1];
                f32x4 h0, h1;
#pragma unroll
                for (int j = 0; j < 4; ++j) { h0[j] = a0[j] * sigmoid_f(a0[j]) * b0[j]; h1[j] = a1[j] * sigmoid_f(a1[j]) * b1[j]; }
                u32x4 w; w.x = cvt_pk_bf16(h0[0], h0[1]); w.y = cvt_pk_bf16(h0[2], h0[3]); w.z = cvt_pk_bf16(h1[0], h1[1]); w.w = cvt_pk_bf16(h1[2], h1[3]);
                *(GAS u32x4*)(HFF + row * 2816 + col0) = w; }
    }
};
template <class Epi, class Sched, bool ALIGN_EPI = false, bool SP2 = false>
__device__ __forceinline__ void gemm_phase(PG8_LAS unsigned char* lds, const Gemm g, const Sched& S, const Epi& E) {
    int tid_ = threadIdx.x; asm volatile("" : "+v"(tid_)); const int tid = tid_, wid = __builtin_amdgcn_readfirstlane(tid >> 6), lane = tid & 63, wr = wid >> 2, wc = wid & 3, fr = lane & 15, fq = lane >> 4;
    int K_ = g.K; asm volatile("" : "+s"(K_)); const int K = K_, nt = K / BK;
    unsigned voffA[2], voffB[2];
#pragma unroll
    for (int i = 0; i < 2; ++i) { int R, C; stage_rc(tid * 16 + i * 8192, R, C); const int Rb = Epi::PERM ? ((R & ~31) + perm32(R & 31)) : R;
        voffA[i] = (unsigned)(R * K + C) * 2u; voffB[i] = (unsigned)(Rb * K + C) * 2u; }
    const size_t kstep = (size_t)(BK * 2);
    const size_t hstep = (size_t)HALF * K * 2;
    const size_t tstep = 2 * hstep;
    const unsigned ldsw = (unsigned)wid * 1024u;
    const int aoff = lds_byte(wr * 64 + fr, fq * 8), boff = lds_byte(wc * 32 + fr, fq * 8);
#define PG8_SA(b, h) (((b) * 2 + (h)) * HTB)
#define PG8_SB(b, h) ((4 + (b) * 2 + (h)) * HTB)
#define PG8_STAGE(bufoff, gbase, voff) do { _Pragma("unroll") for (int _i = 0; _i < 2; ++_i) \
        __builtin_amdgcn_global_load_lds((const unsigned*)((const char*)(gbase) + (voff)[_i]), (PG8_LAS unsigned*)(lds + (bufoff) + ldsw + _i * 8192), 16, 0, 0); } while (0)
#define PG8_LDA(dst, b, h) do { _Pragma("unroll") for (int m = 0; m < 4; ++m) _Pragma("unroll") for (int k = 0; k < 2; ++k) dst[m][k] = *(const PG8_LAS bf16x8*)(lds + PG8_SA(b, h) + aoff + m * 2048 + k * 1024); } while (0)
#define PG8_LDB(dst, b, h) do { _Pragma("unroll") for (int n = 0; n < 2; ++n) _Pragma("unroll") for (int k = 0; k < 2; ++k) dst[n][k] = *(const PG8_LAS bf16x8*)(lds + PG8_SB(b, h) + boff + n * 2048 + k * 1024); } while (0)
#define PG8_MMA(ai, bj, At, Bt) do { __builtin_amdgcn_s_setprio(1); _Pragma("unroll") for (int m = 0; m < 4; ++m) _Pragma("unroll") for (int n = 0; n < 2; ++n) _Pragma("unroll") for (int k = 0; k < 2; ++k) \
        acc[ai][bj][m][n] = __builtin_amdgcn_mfma_f32_16x16x32_bf16(Bt[n][k], At[m][k], acc[ai][bj][m][n], 0, 0, 0); __builtin_amdgcn_s_setprio(0); } while (0)
#define PG8_WAIT_V(n) asm volatile("s_waitcnt vmcnt(" #n ")" ::: "memory")
#define PG8_WAIT_L(n) asm volatile("s_waitcnt lgkmcnt(" #n ")" ::: "memory")
#define PG8_BAR __builtin_amdgcn_s_barrier()
#define PG8_SCHED __builtin_amdgcn_sched_barrier(0)
    Unit cur, nxt; int ui = 0;
    if (!S.next(0, cur)) return;
    f32x4 acc[2][2][4][2];
#pragma unroll
    for (int a = 0; a < 2; ++a)
#pragma unroll
        for (int b = 0; b < 2; ++b)
#pragma unroll
            for (int m = 0; m < 4; ++m)
#pragma unroll
                for (int n = 0; n < 2; ++n) acc[a][b][m][n] = (f32x4){0.f, 0.f, 0.f, 0.f};
    bf16x8 At[4][2], B0[2][2], B1[2][2];
    const char* cA = (const char*)g.A + (size_t)cur.pm * tstep; const char* cB = (const char*)g.Bt + (size_t)cur.pn * tstep;
    S.a_ready(cur);
    if constexpr (SP2) {
        PG8_STAGE(PG8_SB(0, 0), cB, voffB); PG8_STAGE(PG8_SB(0, 1), cB + hstep, voffB); PG8_STAGE(PG8_SA(0, 0), cA, voffA); PG8_STAGE(PG8_SA(0, 1), cA + hstep, voffA);
        if (wr == 1) PG8_BAR;
        PG8_WAIT_V(2); PG8_BAR;
        PG8_STAGE(PG8_SB(1, 0), cB + kstep, voffB); PG8_STAGE(PG8_SA(1, 0), cA + kstep, voffA); PG8_STAGE(PG8_SB(1, 1), cB + hstep + kstep, voffB);
        PG8_WAIT_V(6); PG8_BAR;
    } else {
        PG8_STAGE(PG8_SB(0, 0), cB, voffB); PG8_STAGE(PG8_SA(0, 0), cA, voffA); PG8_STAGE(PG8_SB(0, 1), cB + hstep, voffB); PG8_STAGE(PG8_SA(0, 1), cA + hstep, voffA);
        if (wr == 1) PG8_BAR;
        PG8_WAIT_V(4); PG8_BAR;
        PG8_STAGE(PG8_SB(1, 0), cB + kstep, voffB); PG8_STAGE(PG8_SA(1, 0), cA + kstep, voffA); PG8_STAGE(PG8_SB(1, 1), cB + hstep + kstep, voffB);
        PG8_WAIT_V(6); PG8_BAR;
    }
    for (;;) {
        const bool has_next = S.next(ui + 1, nxt);
        const char* nA = has_next ? (const char*)g.A + (size_t)nxt.pm * tstep : cA; const char* nB = has_next ? (const char*)g.Bt + (size_t)nxt.pn * tstep : cB;
        for (int t = 0; t < nt; t += 2) {
            if constexpr (Epi::HAS_HOOK) { if (t == Epi::T1 || t == Epi::T2) E.hook(acc, cur, t, wr, wc, fr, fq); }
            const bool last = (t == nt - 2);
            const char* a1 = cA + (size_t)(t + 1) * kstep;
            const char* a2 = last ? nA : cA + (size_t)(t + 2) * kstep; const char* b2 = last ? nB : cB + (size_t)(t + 2) * kstep;
            const char* a3 = a2 + kstep; const char* b3 = b2 + kstep;
            if (last && has_next) S.a_ready(nxt);
            if constexpr (SP2) {
            PG8_LDB(B0, 0, 0); PG8_LDB(B1, 0, 1); PG8_SCHED; PG8_LDA(At, 0, 0); PG8_STAGE(PG8_SA(1, 1), a1 + hstep, voffA);
            PG8_WAIT_V(8); PG8_WAIT_L(0); PG8_BAR; PG8_MMA(0, 0, At, B0); PG8_MMA(0, 1, At, B1); PG8_BAR; PG8_SCHED;
            PG8_LDA(At, 0, 1); PG8_STAGE(PG8_SB(0, 0), b2, voffB); PG8_STAGE(PG8_SB(0, 1), b2 + hstep, voffB); PG8_STAGE(PG8_SA(0, 0), a2, voffA);
            PG8_WAIT_V(8); PG8_WAIT_L(0); PG8_BAR; PG8_MMA(1, 0, At, B0); PG8_MMA(1, 1, At, B1); PG8_BAR; PG8_SCHED;
            PG8_LDB(B0, 1, 0); PG8_LDB(B1, 1, 1); PG8_SCHED; PG8_LDA(At, 1, 0); PG8_STAGE(PG8_SA(0, 1), a2 + hstep, voffA);
            PG8_WAIT_V(8); PG8_WAIT_L(0); PG8_BAR; PG8_MMA(0, 0, At, B0); PG8_MMA(0, 1, At, B1); PG8_BAR; PG8_SCHED;
            PG8_LDA(At, 1, 1); PG8_STAGE(PG8_SB(1, 0), b3, voffB); PG8_STAGE(PG8_SB(1, 1), b3 + hstep, voffB); PG8_STAGE(PG8_SA(1, 0), a3, voffA);
            PG8_WAIT_V(8); PG8_WAIT_L(0); PG8_BAR; PG8_MMA(1, 0, At, B0); PG8_MMA(1, 1, At, B1); PG8_BAR; PG8_SCHED;
            } else {
            PG8_LDB(B0, 0, 0); PG8_SCHED; PG8_LDA(At, 0, 0); PG8_STAGE(PG8_SA(1, 1), a1 + hstep, voffA);
            PG8_WAIT_L(8); PG8_BAR; PG8_WAIT_L(0); PG8_MMA(0, 0, At, B0); PG8_BAR; PG8_SCHED;
            PG8_LDB(B1, 0, 1); PG8_STAGE(PG8_SB(0, 0), b2, voffB);
            PG8_BAR; PG8_WAIT_L(0); PG8_MMA(0, 1, At, B1); PG8_BAR;
            PG8_LDA(At, 0, 1); PG8_STAGE(PG8_SA(0, 0), a2, voffA);
            PG8_BAR; PG8_WAIT_L(0); PG8_MMA(1, 0, At, B0); PG8_BAR; PG8_SCHED;
            PG8_STAGE(PG8_SB(0, 1), b2 + hstep, voffB);
            PG8_WAIT_V(6); PG8_BAR; PG8_MMA(1, 1, At, B1); PG8_BAR;
            PG8_LDB(B0, 1, 0); PG8_SCHED; PG8_LDA(At, 1, 0); PG8_STAGE(PG8_SA(0, 1), a2 + hstep, voffA);
            PG8_WAIT_L(8); PG8_BAR; PG8_WAIT_L(0); PG8_MMA(0, 0, At, B0); PG8_BAR; PG8_SCHED;
            PG8_LDB(B1, 1, 1); PG8_STAGE(PG8_SB(1, 0), b3, voffB);
            PG8_BAR; PG8_WAIT_L(0); PG8_MMA(0, 1, At, B1); PG8_BAR;
            PG8_LDA(At, 1, 1); PG8_STAGE(PG8_SA(1, 0), a3, voffA);
            PG8_BAR; PG8_WAIT_L(0); PG8_MMA(1, 0, At, B0); PG8_BAR; PG8_SCHED;
            PG8_STAGE(PG8_SB(1, 1), b3 + hstep, voffB);
            PG8_WAIT_V(6); PG8_BAR; PG8_MMA(1, 1, At, B1); PG8_BAR;
            }
        }
        if constexpr (ALIGN_EPI) { if (wr == 0) PG8_BAR; }
        if constexpr (!Epi::AFTER_DRAIN) { E(acc, cur, wr, wc, fr, fq); S.done(cur); __builtin_amdgcn_s_waitcnt(0x0F70);   }
        if (!has_next) break;
#pragma unroll
        for (int a = 0; a < 2; ++a)
#pragma unroll
            for (int b = 0; b < 2; ++b)
#pragma unroll
                for (int m = 0; m < 4; ++m)
#pragma unroll
                    for (int n = 0; n < 2; ++n) acc[a][b][m][n] = (f32x4){0.f, 0.f, 0.f, 0.f};
        cur = nxt; cA = nA; cB = nB; ++ui;
        if constexpr (ALIGN_EPI) { if (wr == 1) PG8_BAR; }
    }
    PG8_WAIT_V(0);
    if constexpr (!ALIGN_EPI) { if (wr == 0) PG8_BAR; }
    PG8_BAR;
    if constexpr (Epi::AFTER_DRAIN) { E.fused(acc, cur, wr, wc, fr, fq, lds, wid, lane); S.done(cur); }
#undef PG8_SA
#undef PG8_SB
#undef PG8_STAGE
#undef PG8_LDA
#undef PG8_LDB
#undef PG8_MMA
#undef PG8_WAIT_V
#undef PG8_WAIT_L
#undef PG8_BAR
#undef PG8_SCHED
}
}
#include <hip/hip_bf16.h>
#include <cmath>
namespace attn_body {
using bf16=__hip_bfloat16;
using bf16x8=__attribute__((ext_vector_type(8)))short;
using s16x4=__attribute__((ext_vector_type(4)))short;
using f32x16=__attribute__((ext_vector_type(16)))float;
using u32x4=__attribute__((ext_vector_type(4)))unsigned;
constexpr int D=64,QP=512,KP=128,OP=1024;
constexpr int NW=8,QBLK=32,QB=QBLK*NW,KVBLK=64;
constexpr int ATTN_UNIT_ROWS=QB;
__device__ __forceinline__ int crow(int r,int hi){return (r&3)+8*(r>>2)+4*hi;}
#define SBAR() __builtin_amdgcn_sched_barrier(0)
__device__ __forceinline__ void cmask(f32x16&p0,f32x16&p1,int jb,int qrel,int hi){
  const float NEG=-INFINITY; int kb=64*jb+4*hi;
  #pragma unroll
  for(int r=0;r<16;++r){int kv=kb+(r&3)+8*(r>>2); if(kv>qrel)p0[r]=NEG; if(kv+32>qrel)p1[r]=NEG;}
}

constexpr int NSLOT=3, SLOTB=8192;
constexpr int LDS_K=0, LDS_V=NSLOT*SLOTB, LDS_WS=2*NSLOT*SLOTB, LDS_OST=LDS_WS+NW*64*4, LDS_BYTES=LDS_OST+NW*4096;
constexpr float C2=0.125f*1.4426950408889634f;
__device__ __forceinline__ void glds16(const void*gsrc,unsigned lds_dst){unsigned keep;
  asm volatile("s_mov_b32 %0, m0\n\ts_mov_b32 m0, %2\n\ts_nop 0\n\tglobal_load_lds_dwordx4 %1, off\n\ts_mov_b32 m0, %0":"=&s"(keep):"v"(gsrc),"s"(lds_dst):"memory");}
__device__ __forceinline__ float max3f(float a,float b,float c){float r;asm("v_max3_f32 %0, %1, %2, %3":"=v"(r):"v"(a),"v"(b),"v"(c));return r;}
__device__ __forceinline__ float max2f(float a,float b){float r;asm("v_max_f32_e32 %0, %1, %2":"=v"(r):"v"(a),"v"(b));return r;}
__device__ __forceinline__ float fadd_s(float a,float b){float r;asm("v_add_f32_e32 %0, %1, %2":"=v"(r):"v"(a),"v"(b));return r;}
__device__ __forceinline__ float fsub_s(float a,float b){float r;asm("v_sub_f32_e32 %0, %1, %2":"=v"(r):"v"(a),"v"(b));return r;}
typedef float f32x2_t __attribute__((ext_vector_type(2))); typedef __bf16 bf16x2_t __attribute__((ext_vector_type(2)));
__device__ __forceinline__ unsigned cvtpk_s(float lo,float hi){f32x2_t v={lo,hi};bf16x2_t b=__builtin_convertvector(v,bf16x2_t);return __builtin_bit_cast(unsigned,b);}
#define WAIT_BAR(N) asm volatile("s_waitcnt vmcnt(" #N ") lgkmcnt(0)\n\ts_barrier":::"memory")

__device__ __forceinline__ void qkt(f32x16&p0,f32x16&p1,const char*Kslot,const bf16x8*qr,const f32x16&negm,int r32,int hi){
  const char*kb=Kslot+hi*1024+r32*16;
  #pragma unroll
  for(int d0=0;d0<4;++d0){
    const bf16x8 b0=*reinterpret_cast<const bf16x8*>(kb+d0*2048);
    const bf16x8 b1=*reinterpret_cast<const bf16x8*>(kb+d0*2048+512);
    if(d0==0){p0=__builtin_amdgcn_mfma_f32_32x32x16_bf16(b0,qr[0],negm,0,0,0);p1=__builtin_amdgcn_mfma_f32_32x32x16_bf16(b1,qr[0],negm,0,0,0);}
    else{p0=__builtin_amdgcn_mfma_f32_32x32x16_bf16(b0,qr[d0],p0,0,0,0);p1=__builtin_amdgcn_mfma_f32_32x32x16_bf16(b1,qr[d0],p1,0,0,0);}}
}
typedef __attribute__((address_space(3))) const char* lds_cptr;
typedef short v4i16_t __attribute__((ext_vector_type(4)));
__device__ __forceinline__ void kload8(bf16x8*kf,lds_cptr kp){
  kf[0]=*(const __attribute__((address_space(3))) bf16x8*)(kp);      kf[1]=*(const __attribute__((address_space(3))) bf16x8*)(kp+512);
  kf[2]=*(const __attribute__((address_space(3))) bf16x8*)(kp+2048); kf[3]=*(const __attribute__((address_space(3))) bf16x8*)(kp+2560);
  kf[4]=*(const __attribute__((address_space(3))) bf16x8*)(kp+4096); kf[5]=*(const __attribute__((address_space(3))) bf16x8*)(kp+4608);
  kf[6]=*(const __attribute__((address_space(3))) bf16x8*)(kp+6144); kf[7]=*(const __attribute__((address_space(3))) bf16x8*)(kp+6656);
}
__device__ __forceinline__ void kload2(bf16x8*kf,lds_cptr kp,int j){ kf[2*j]=*(const __attribute__((address_space(3))) bf16x8*)(kp+j*2048); kf[2*j+1]=*(const __attribute__((address_space(3))) bf16x8*)(kp+j*2048+512); }
__device__ __forceinline__ s16x4 vtr(lds_cptr p){ return __builtin_bit_cast(s16x4,__builtin_amdgcn_ds_read_tr16_b64_v4i16((__attribute__((address_space(3))) v4i16_t*)p)); }
__device__ __forceinline__ float rowmax(const f32x16&p0,const f32x16&p1){
  float a=max3f(p0[0],p0[1],p1[0]),b=max3f(p0[2],p0[3],p1[1]);a=max3f(a,p1[2],p1[3]);
  #pragma unroll
  for(int r=4;r<16;r+=4){a=max3f(a,p0[r],p0[r+1]);b=max3f(b,p0[r+2],p0[r+3]);a=max3f(a,p1[r],p1[r+1]);b=max3f(b,p1[r+2],p1[r+3]);}
  const float m=max2f(a,b);
  auto rr=__builtin_amdgcn_permlane32_swap(__float_as_uint(m),__float_as_uint(m),false,false);
  return max2f(__uint_as_float(rr[0]),__uint_as_float(rr[1]));
}
__device__ __forceinline__ void pv(f32x16*o,int vb,bf16x8 pa0,bf16x8 pa1,bf16x8 pa2,bf16x8 pa3){
  #pragma unroll
  for(int d0=0;d0<2;++d0){s16x4 lo[4],hi[4];
    #pragma unroll
    for(int ks=0;ks<4;++ks){
      asm volatile("ds_read_b64_tr_b16 %0,%1 offset:%c2":"=&v"(lo[ks]):"v"(vb),"i"(d0*4096+ks*1024):"memory");
      asm volatile("ds_read_b64_tr_b16 %0,%1 offset:%c2":"=&v"(hi[ks]):"v"(vb),"i"(d0*4096+ks*1024+512):"memory");}
    asm volatile("s_waitcnt lgkmcnt(0)":::"memory");SBAR();
    #define PK(k) (bf16x8){lo[k][0],lo[k][1],lo[k][2],lo[k][3],hi[k][0],hi[k][1],hi[k][2],hi[k][3]}
    o[d0]=__builtin_amdgcn_mfma_f32_32x32x16_bf16(pa0,PK(0),o[d0],0,0,0);
    o[d0]=__builtin_amdgcn_mfma_f32_32x32x16_bf16(pa1,PK(1),o[d0],0,0,0);
    o[d0]=__builtin_amdgcn_mfma_f32_32x32x16_bf16(pa2,PK(2),o[d0],0,0,0);
    o[d0]=__builtin_amdgcn_mfma_f32_32x32x16_bf16(pa3,PK(3),o[d0],0,0,0);
    #undef PK
  }
}

#ifndef ATTN_STORE16
#define ATTN_STORE16(p,v) (*(u32x4*)(p)=(v))
#endif
template<int THRL,bool NOMAX> __device__ __forceinline__ void attn_unit(long qrow0,int h,long kvrow0,int NT,const bf16*Q,const bf16*__restrict__ K,const bf16*__restrict__ V,bf16*O,char*shm){
  int tid_=threadIdx.x; asm volatile("":"+v"(tid_)); const int tid=tid_,lane=tid&63,r32=lane&31,hi=lane>>5; const int wid=__builtin_amdgcn_readfirstlane(tid>>6);
  const bf16*Qw=Q+(qrow0+wid*QBLK)*QP+h*D;
  const bf16*Kh=K+kvrow0*KP+(h>>2)*D,*Vh=V+kvrow0*KP+(h>>2)*D;
  const unsigned lds0=(unsigned)(uintptr_t)shm;
  float*wsf=(float*)(shm+LDS_WS)+wid*64;
  const bf16*ksrc=Kh+(long)lane*KP+wid*8;
  const bf16*vsrc=Vh+(long)(16*(wid&3)+(lane>>2))*KP+(wid>>2)*32+(lane&3)*8;
  const unsigned kdst=lds0+LDS_K+wid*1024, vdst=lds0+LDS_V+wid*1024;
  #define DMA_K(t,slot) glds16(ksrc+(long)(t)*KVBLK*KP,(unsigned)__builtin_amdgcn_readfirstlane(kdst+(slot)))
  #define DMA_V(t,slot) glds16(vsrc+(long)(t)*KVBLK*KP,(unsigned)__builtin_amdgcn_readfirstlane(vdst+(slot)))
  const int vb0=(int)(lds0+LDS_V)+((lane>>4)&1)*32+(lane&3)*8+(4*hi+((lane&15)>>2))*64;
  const char*Kbase=shm+LDS_K; bf16x8 kf[8];
  const lds_cptr shm3=(lds_cptr)shm; const lds_cptr kp0=shm3+LDS_K+hi*1024+r32*16; const lds_cptr vp0=shm3+LDS_V+((lane>>4)&1)*32+(lane&3)*8+(4*hi+((lane&15)>>2))*64;
  DMA_K(0,0);DMA_V(0,0);DMA_K(1,SLOTB);
  bf16x8 qr[4];
  #pragma unroll
  for(int d0=0;d0<4;++d0)qr[d0]=*reinterpret_cast<const bf16x8*>(&Qw[(long)r32*QP+d0*16+hi*8]);
  float mhat=0.f,l_reg=0.f;f32x16 o[2];o[0]=f32x16{};o[1]=f32x16{};f32x16 negm=f32x16{};asm volatile("":"+v"(negm));
  #define CMASK(P0,P1,t) do{}while(0)
  bool resc=false;
  #define START(P0,P1) do{ resc=false; if constexpr(!NOMAX) \
    { const float rm=rowmax(P0,P1); const float dl=rm; mhat=fadd_s(mhat,dl); \
      _Pragma("unroll") for(int r=0;r<16;++r){P0[r]=fsub_s(P0[r],dl);P1[r]=fsub_s(P1[r],dl);} \
      _Pragma("unroll") for(int r=0;r<16;++r)negm[r]=-mhat; asm volatile("":"+v"(negm)); } \
    _Pragma("unroll") for(int r=0;r<16;++r)P0[r]=__builtin_amdgcn_exp2f(P0[r]); }while(0)
  #define RESC() do{ if constexpr(!NOMAX) if(resc){ asm volatile("s_waitcnt lgkmcnt(0)":::"memory"); \
      _Pragma("unroll") for(int d_=0;d_<2;++d_) _Pragma("unroll") for(int r=0;r<16;++r)o[d_][r]*=wsf[crow(r,hi)]; } }while(0)
  f32x16 pA0,pA1,pB0,pB1;
  int sl_prev=0,sl_cur=0,sl_next=SLOTB;
  #define ROT() do{sl_prev=sl_cur;sl_cur=sl_next;sl_next=(sl_next==(NSLOT-1)*SLOTB)?0:sl_next+SLOTB;}while(0)
  DMA_K(2,2*SLOTB);
  WAIT_BAR(3);
  qkt(pA0,pA1,Kbase,qr,negm,r32,hi);asm volatile("s_nop 15\n\ts_nop 7":"+v"(pA0),"+v"(pA1));CMASK(pA0,pA1,0);
  START(pA0,pA1);
  _Pragma("unroll") for(int r=0;r<16;++r)pA1[r]=__builtin_amdgcn_exp2f(pA1[r]);
  WAIT_BAR(0);
  DMA_K(3,0);DMA_V(1,SLOTB);
  ROT();
  kload8(kf,kp0+sl_cur);
  WAIT_BAR(2);
  s16x4 vlo[8],vhi[8]; u32x4 pw0,pw1,pw2,pw3;
  #define PKW(P,B) cvtpk_s(P[B],P[B+1])
  #define PAF(k) __builtin_bit_cast(bf16x8,pw##k)
  #define VFR(i) (bf16x8){vlo[i][0],vlo[i][1],vlo[i][2],vlo[i][3],vhi[i][0],vhi[i][1],vhi[i][2],vhi[i][3]}
  #define PIN(x) asm volatile("":"+v"(x))
  #define MX3(a,b,c) __builtin_fmaxf(__builtin_fmaxf((a),(b)),(c))
  #define GAPA(MF,A0,A1,A2,A3,W0,W1,PW) do{ MF; sacc+=A0; sacc+=A1; sacc+=A2; sacc+=A3; PIN(sacc); W0; W1; PIN(PW); SBAR(); }while(0)
  #define EX(v) __builtin_amdgcn_exp2f(v)
  #define GAPB(MF,X,B) do{ MF; X[B]=EX(X[B]); X[B+1]=EX(X[B+1]); X[B+2]=EX(X[B+2]); X[B+3]=EX(X[B+3]); PIN(X); SBAR(); }while(0)
  #define VRD(i) do{ vlo[i]=vtr(vp_+(((i)>>2)*4096+((i)&3)*1024)); vhi[i]=vtr(vp_+(((i)>>2)*4096+((i)&3)*1024+512)); }while(0)
  #define KRD(G,j) do{ if(G){ kload2(kf,kp0+sl_next,j); SBAR(); } }while(0)
  #define STEP(C0,C1,P0,P1,t,GK,GV,GL) do{ SBAR(); \
    const lds_cptr vp_=vp0+sl_prev; \
    VRD(0); SBAR(); float sacc=(P0[0]+P0[1]); \
    GAPA(C0=__builtin_amdgcn_mfma_f32_32x32x16_bf16(kf[0],qr[0],negm,0,0,0), P0[2],P0[3],P0[4],P0[5],     pw0[0]=PKW(P0,0), pw0[1]=PKW(P0,2), pw0); \
    VRD(4); SBAR(); GAPA(C1=__builtin_amdgcn_mfma_f32_32x32x16_bf16(kf[1],qr[0],negm,0,0,0), P0[6],P0[7],P0[8],P0[9],     pw0[2]=PKW(P0,4), pw0[3]=PKW(P0,6), pw0); \
    VRD(1); SBAR(); GAPA(C0=__builtin_amdgcn_mfma_f32_32x32x16_bf16(kf[2],qr[1],C0,0,0,0),   P0[10],P0[11],P0[12],P0[13], pw1[0]=PKW(P0,8), pw1[1]=PKW(P0,10), pw1); \
    VRD(5); SBAR(); GAPA(C1=__builtin_amdgcn_mfma_f32_32x32x16_bf16(kf[3],qr[1],C1,0,0,0),   P0[14],P0[15],P1[0],P1[1],   pw1[2]=PKW(P0,12),pw1[3]=PKW(P0,14), pw1); \
    VRD(2); SBAR(); GAPA(C0=__builtin_amdgcn_mfma_f32_32x32x16_bf16(kf[4],qr[2],C0,0,0,0),   P1[2],P1[3],P1[4],P1[5],     pw2[0]=PKW(P1,0), pw2[1]=PKW(P1,2), pw2); \
    VRD(6); SBAR(); GAPA(C1=__builtin_amdgcn_mfma_f32_32x32x16_bf16(kf[5],qr[2],C1,0,0,0),   P1[6],P1[7],P1[8],P1[9],     pw2[2]=PKW(P1,4), pw2[3]=PKW(P1,6), pw2); \
    VRD(3); SBAR(); GAPA(C0=__builtin_amdgcn_mfma_f32_32x32x16_bf16(kf[6],qr[3],C0,0,0,0),   P1[10],P1[11],P1[12],P1[13], pw3[0]=PKW(P1,8), pw3[1]=PKW(P1,10), pw3); \
    VRD(7); SBAR(); GAPA(C1=__builtin_amdgcn_mfma_f32_32x32x16_bf16(kf[7],qr[3],C1,0,0,0),   P1[14],P1[15],0.f,0.f,       pw3[2]=PKW(P1,12),pw3[3]=PKW(P1,14), pw3); \
    l_reg+=sacc; \
    if(GK){DMA_K((t)+3,sl_cur);} if(GV){DMA_V((t)+1,sl_next);} \
    CMASK(C0,C1,t); \
    if constexpr(!NOMAX){ float a=MX3(C0[0],C0[1],C1[0]),b=MX3(C0[2],C0[3],C1[1]); a=MX3(a,C1[2],C1[3]); \
      _Pragma("unroll") for(int r=4;r<16;r+=4){a=MX3(a,C0[r],C0[r+1]);b=MX3(b,C0[r+2],C0[r+3]);a=MX3(a,C1[r],C1[r+1]);b=MX3(b,C1[r+2],C1[r+3]);} \
      float rm=__builtin_fmaxf(a,b); { auto rr=__builtin_amdgcn_permlane32_swap(__float_as_uint(rm),__float_as_uint(rm),false,false); rm=__builtin_fmaxf(__uint_as_float(rr[0]),__uint_as_float(rr[1])); } \
      resc=false; \
      if(__builtin_expect(__any(rm>(float)THRL),0)){ const float dl=__builtin_fmaxf(rm,0.f); mhat+=dl; \
        _Pragma("unroll") for(int r=0;r<16;++r){C0[r]-=dl;C1[r]-=dl;} \
        _Pragma("unroll") for(int r=0;r<16;++r)negm[r]=-mhat; asm volatile("":"+v"(negm)); \
        const float f=__builtin_amdgcn_exp2f(-dl); l_reg*=f; if(hi==0)wsf[r32]=f; resc=true; } } \
    SBAR(); \
    GAPB(o[0]=__builtin_amdgcn_mfma_f32_32x32x16_bf16(PAF(0),VFR(0),o[0],0,0,0), C0,0); \
    GAPB(o[1]=__builtin_amdgcn_mfma_f32_32x32x16_bf16(PAF(0),VFR(4),o[1],0,0,0), C0,4); \
    KRD(GL,0); GAPB(o[0]=__builtin_amdgcn_mfma_f32_32x32x16_bf16(PAF(1),VFR(1),o[0],0,0,0), C0,8); \
    KRD(GL,1); GAPB(o[1]=__builtin_amdgcn_mfma_f32_32x32x16_bf16(PAF(1),VFR(5),o[1],0,0,0), C0,12); \
    KRD(GL,2); GAPB(o[0]=__builtin_amdgcn_mfma_f32_32x32x16_bf16(PAF(2),VFR(2),o[0],0,0,0), C1,0); \
    KRD(GL,3); GAPB(o[1]=__builtin_amdgcn_mfma_f32_32x32x16_bf16(PAF(2),VFR(6),o[1],0,0,0), C1,4); \
    GAPB(o[0]=__builtin_amdgcn_mfma_f32_32x32x16_bf16(PAF(3),VFR(3),o[0],0,0,0), C1,8); \
    GAPB(o[1]=__builtin_amdgcn_mfma_f32_32x32x16_bf16(PAF(3),VFR(7),o[1],0,0,0), C1,12); \
    }while(0)
  int t=1;
  #undef CMASK
  #define CMASK(P0,P1,t) do{}while(0)
  for(;t+5<NT;t+=2){
    STEP(pB0,pB1,pA0,pA1,t,true,true,true);     WAIT_BAR(2); RESC(); ROT();
    STEP(pA0,pA1,pB0,pB1,t+1,true,true,true);   WAIT_BAR(2); RESC(); ROT();
  }
  #undef CMASK
  #define CMASK(P0,P1,t) do{}while(0)
  #define ENDW(tt) do{ if((tt)+3<NT){WAIT_BAR(2);} else if((tt)+2<NT){WAIT_BAR(1);} else {WAIT_BAR(0);} }while(0)
  for(;t+1<NT;t+=2){
    STEP(pB0,pB1,pA0,pA1,t,(t+3<NT),(t+1<NT),(t+1<NT));       ENDW(t);   RESC(); ROT();
    STEP(pA0,pA1,pB0,pB1,t+1,(t+4<NT),(t+2<NT),(t+2<NT));     ENDW(t+1); RESC(); ROT();
  }
  STEP(pB0,pB1,pA0,pA1,NT-1,false,false,false); RESC();
  { float sacc=pB0[0]+pB0[1]; _Pragma("unroll") for(int r=2;r<16;++r)sacc+=pB0[r]; _Pragma("unroll") for(int r=0;r<16;++r)sacc+=pB1[r]; l_reg+=sacc;
    pw0=(u32x4){PKW(pB0,0),PKW(pB0,2),PKW(pB0,4),PKW(pB0,6)};pw1=(u32x4){PKW(pB0,8),PKW(pB0,10),PKW(pB0,12),PKW(pB0,14)};pw2=(u32x4){PKW(pB1,0),PKW(pB1,2),PKW(pB1,4),PKW(pB1,6)};pw3=(u32x4){PKW(pB1,8),PKW(pB1,10),PKW(pB1,12),PKW(pB1,14)};
    SBAR(); pv(o,vb0+sl_cur,PAF(0),PAF(1),PAF(2),PAF(3)); }
  #undef PKW
  #undef PAF
  #undef VFR
  #undef PIN
  #undef MX3
  #undef GAPA
  #undef GAPB
  #undef EX
  #undef VRD
  #undef KRD
  #undef STEP
  #undef ENDW
  {auto rr=__builtin_amdgcn_permlane32_swap(__float_as_uint(l_reg),__float_as_uint(l_reg),false,false);l_reg=__uint_as_float(rr[0])+__uint_as_float(rr[1]);}
  if(hi==0)wsf[32+r32]=l_reg;asm volatile("s_waitcnt lgkmcnt(0)":::"memory");
  float rli[16];
  #pragma unroll
  for(int r=0;r<16;++r)rli[r]=__builtin_amdgcn_rcpf(wsf[32+crow(r,hi)]);
  bf16*Ow=O+(qrow0+wid*QBLK)*OP+h*D;
  { bf16*stg=(bf16*)(shm+LDS_OST)+wid*2048;
    #pragma unroll
    for(int r=0;r<16;++r){const int orow=crow(r,hi);
      #pragma unroll
      for(int d0=0;d0<2;++d0)stg[orow*64+d0*32+r32]=__float2bfloat16(o[d0][r]*rli[r]);}
    asm volatile("s_waitcnt lgkmcnt(0)":::"memory");
    #pragma unroll
    for(int i=0;i<4;++i){const int row=i*8+(lane>>3),ch=lane&7; const u32x4 v=*(const u32x4*)(stg+row*64+ch*8); ATTN_STORE16(Ow+(long)row*OP+ch*8,v);} }
  asm volatile("s_waitcnt lgkmcnt(0)\n\ts_barrier":::"memory");
  #undef DMA_K
  #undef DMA_V
  #undef CMASK
  #undef START
  #undef RESC
  #undef ROT
}
constexpr int ATTN_LDS_BYTES=LDS_BYTES;
#undef SBAR
#undef WAIT_BAR
}
#define LAS __attribute__((address_space(3)))
#define INP(i) ((const GAS float*)a.in[i])
typedef unsigned short bf16;
typedef unsigned v4u __attribute__((ext_vector_type(4)));
typedef unsigned v2u __attribute__((ext_vector_type(2)));
typedef float f32x4 __attribute__((ext_vector_type(4)));
#ifndef DUP_S
#define DUP_S -1
#endif
#ifndef DUP_ATT
#define DUP_ATT 1
#endif
#ifndef DUP_SG
#define DUP_SG 1
#endif
#ifndef TIME_S
#define TIME_S -1
#endif
#ifndef TIME_MASK
#define TIME_MASK (TIME_S == 10 ? 0x1ff : (1 << (TIME_S < 0 ? 0 : TIME_S)))
#endif
#ifndef MK_MULTI
#define MK_MULTI 0
#endif
constexpr int NWAVES = 8, NTHREADS = 512;
constexpr int DMODEL = 1024, DEPTH = 4, ML = 16384, MC = 512, MT = ML + MC;
constexpr int INW = 5120, DFF = 2816, NMODW = 6144;
constexpr int NPHASE = 1 + 8 * DEPTH;
constexpr size_t MiB = 1u << 20;
constexpr size_t WS_MOD = 0, WS_COS = 1 * MiB, WS_SIN = 2 * MiB, WS_CTX = 3 * MiB, WS_W = 6 * MiB, WS_H = 38 * MiB, WS_Q = 72 * MiB, WS_K = 89 * MiB, WS_V = 94 * MiB,
                 WS_ZA = 99 * MiB, WS_ZB = 108 * MiB, WS_ZC = 125 * MiB, WS_ZF = 134 * MiB, WS_P = 200 * MiB;
constexpr size_t P_CONV = 0, P_SG = (size_t)MT * 768 * 2, P_G = P_SG + (size_t)MT * 512 * 2, WS_END = WS_P + P_G + (size_t)MT * 3072 * 2;
constexpr size_t WS_W2 = 342 * MiB, WS_END2 = WS_W2 + 32 * MiB;
static_assert(WS_END <= WS_W2, "ws map 3");
constexpr size_t WO_IN = 0, WO_A = WO_IN + 5120 * 1024  , WO_O = WO_A + 1024 * 1024, WO_13 = WO_O + 1024 * 1024,
                 WO_2 = WO_13 + 5632 * 1024, WO_END = WO_2 + 1024 * 2816;
static_assert(WO_END * 2 <= 32 * MiB && (size_t)MT * 1024 * 2 <= 34 * MiB && (size_t)MT * 1024 * 4 <= 66 * MiB && (size_t)MT * 2816 * 2 <= WS_END - WS_P, "ws map");
constexpr int LDS_BYTES = 147456;

__device__ __forceinline__ unsigned f2bf(float f) { unsigned u = __builtin_bit_cast(unsigned, f); return (u + 0x7fffu + ((u >> 16) & 1u)) >> 16; }
__device__ __forceinline__ unsigned pk2(float lo, float hi) { unsigned r; asm("v_cvt_pk_bf16_f32 %0, %1, %2" : "=v"(r) : "v"(lo), "v"(hi)); return r; }
__device__ __forceinline__ float bflo(unsigned w) { return __uint_as_float(w << 16); }
__device__ __forceinline__ float bfhi(unsigned w) { return __uint_as_float(w & 0xffff0000u); }
__device__ __forceinline__ float wave_sum(float v) {
#pragma unroll
    for (int o = 1; o < 64; o <<= 1) v += __shfl_xor(v, o);
    return v;
}
__device__ __forceinline__ int inproj_src_col(int nn) {
    if (nn >= 256 && nn < 768) { const int q = nn - 256, tile = q >> 8, p = q & 255; return 256 + (p >> 7) * 256 + tile * 128 + (p & 127); }
    if (nn < 768 || nn >= 1536) return nn;
    const int q = nn - 768, tile = q >> 8, p = q & 255, bj = p >> 7, wc = (p >> 5) & 3, fq = (p >> 3) & 3, n = (p >> 2) & 1, j = p & 3;
    return 768 + tile * 256 + wc * 64 + 32 * bj + 16 * n + 4 * fq + j;
}
template <int MODE> __device__ __forceinline__ void transpose_item(const GAS float* W, const GAS float* W3, int K, int N, GAS bf16* WT, LAS float* scr, int item, int nblk, int lane, int dpitch = 0, int koff = 0) {
    if (dpitch == 0) dpitch = K;
    const int kb = item / nblk, nb = item % nblk, k0 = 64 * kb, n0 = 32 * nb, nn = n0 + 4 * (lane & 7);
    const GAS float* src;
    if (MODE == 0) src = W + nn;
    else if (MODE == 1) src = W + inproj_src_col(nn);
    else { const int tile = nn >> 8, p = nn & 255; src = ((p >> 7) ? W3 : W) + 128 * tile + (p & 127); }
#pragma unroll
    for (int i = 0; i < 8; ++i) { const int kk = 8 * i + (lane >> 3); const f32x4 v = *(const GAS f32x4*)(src + (size_t)(k0 + kk) * N);
        LAS float* d = scr + kk * 33 + 4 * (lane & 7); d[0] = v[0]; d[1] = v[1]; d[2] = v[2]; d[3] = v[3]; }
    asm volatile("s_waitcnt lgkmcnt(0)" ::: "memory");
    const int c = lane & 7;
#pragma unroll
    for (int j = 0; j < 4; ++j) { const int n = (lane >> 3) + 8 * j; const LAS float* s = scr + (8 * c) * 33 + n;
        v4u o; o.x = pk2(s[0 * 33], s[1 * 33]); o.y = pk2(s[2 * 33], s[3 * 33]); o.z = pk2(s[4 * 33], s[5 * 33]); o.w = pk2(s[6 * 33], s[7 * 33]);
        *(GAS v4u*)(WT + (size_t)(n0 + n) * dpitch + koff + k0 + 8 * c) = o; }
    asm volatile("s_waitcnt lgkmcnt(0)" ::: "memory");
}
typedef GAS unsigned gu32;
#define RLX_AGENT __ATOMIC_RELAXED, __HIP_MEMORY_SCOPE_AGENT
#define XB_TMO      128
#define XB_XCNT(j)  (256  + 64 * (j))
#define XB_XSUB(j)  (1280 + 64 * (j))
#define XB_XGEN(j)  (2304 + 64 * (j))
#define XB_TOP      3328
#define XB_TOPGEN   3392
#define XCD_BAR_WORDS 3456
#define XB_SPIN_CAP (1u << 18)

__device__ __forceinline__ unsigned xb_ld(unsigned* p)              { return __hip_atomic_load(p, __ATOMIC_RELAXED, __HIP_MEMORY_SCOPE_AGENT); }
__device__ __forceinline__ unsigned xb_add(unsigned* p, unsigned v) { return __hip_atomic_fetch_add(p, v, __ATOMIC_RELAXED, __HIP_MEMORY_SCOPE_AGENT); }
__device__ __forceinline__ unsigned xb_xcc_id() { return (unsigned)__builtin_amdgcn_s_getreg((3 << 11) | 20) & 0xFu; }
#define XB_SPIN(cond, bar) do { unsigned _sp = 0; while (cond) { __builtin_amdgcn_s_sleep(1); \
    if ((++_sp & 255u) == 0u) { if (xb_ld(&(bar)[XB_TMO])) break; if (_sp > XB_SPIN_CAP) { atomicAdd(&(bar)[XB_TMO], 1u); break; } } } } while (0)

struct XcdBarrier {
    unsigned* bar; unsigned x;
    volatile LAS unsigned* st;
};

__device__ __forceinline__ XcdBarrier xcd_barrier_post(unsigned* bar, volatile LAS unsigned* st) {
    XcdBarrier b; b.bar = bar; b.x = xb_xcc_id(); b.st = st;
    if (threadIdx.x == 0) (void)xb_add(&bar[XB_XCNT(b.x)], 1u);
    return b;
}
__device__ __forceinline__ void xcd_barrier_complete(unsigned* bar, unsigned x, unsigned& nloc, unsigned& nx) {
    const unsigned G = gridDim.x * gridDim.y * gridDim.z;
    unsigned sum, cnt, mine, sp = 0u;
    for (;;) {
        sum = 0u; cnt = 0u; mine = 0u;
#pragma unroll
        for (unsigned j = 0; j < 16; ++j) { const unsigned c = xb_ld(&bar[XB_XCNT(j)]); sum += c; cnt += (c > 0u) ? 1u : 0u; mine = (j == x) ? c : mine; }
        if (sum == G) break;
        __builtin_amdgcn_s_sleep(1);
        if ((++sp & 255u) == 0u) { if (xb_ld(&bar[XB_TMO])) break; if (sp > XB_SPIN_CAP) { atomicAdd(&bar[XB_TMO], 1u); break; } }
    }
    nloc = mine > 0u ? mine : 1u; nx = cnt > 0u ? cnt : 1u;
}

__device__ __forceinline__ void xcd_barrier(const XcdBarrier& b) {
    asm volatile("s_waitcnt vmcnt(0)" ::: "memory");
    __syncthreads();
    if (threadIdx.x == 0) {
        unsigned* bar = b.bar;
        __builtin_amdgcn_s_waitcnt(0);
        unsigned nloc = b.st[0], nx = b.st[1];
        if (nloc == 0u) { xcd_barrier_complete(bar, b.x, nloc, nx); b.st[0] = nloc; b.st[1] = nx; }
        const unsigned old = xb_add(&bar[XB_XSUB(b.x)], 1u);
        const unsigned gen = old / nloc;
        if (old + 1u == (gen + 1u) * nloc) {
            __builtin_amdgcn_fence(__ATOMIC_RELEASE, "agent");
            asm volatile("s_waitcnt vmcnt(0)" ::: "memory");
            const unsigned og = xb_add(&bar[XB_TOP], 1u);
            const unsigned tg = og / nx;
            if (og + 1u == (tg + 1u) * nx) xb_add(&bar[XB_TOPGEN], 1u);
            else XB_SPIN(xb_ld(&bar[XB_TOPGEN]) == tg, bar);
            __builtin_amdgcn_fence(__ATOMIC_ACQUIRE, "agent");
            xb_add(&bar[XB_XGEN(b.x)], 1u);
            asm volatile("s_waitcnt vmcnt(0)" ::: "memory");
        } else {
            XB_SPIN(xb_ld(&bar[XB_XGEN(b.x)]) == gen, bar);
            __builtin_amdgcn_fence(__ATOMIC_ACQUIRE, "agent");
            asm volatile("s_waitcnt vmcnt(0)" ::: "memory");
        }
    }
    __syncthreads();
}

constexpr size_t WS_BAR = 512 * 1024, BAR_BYTES = 16384 + 16384 + 4096;
constexpr size_t WS_XCNT = WS_BAR + 16384, WS_XCNTC = WS_BAR + 32768  , WS_XBUF = 640 * 1024, WS_XBUFC = 896 * 1024  ;
static_assert(WS_XBUFC + 512 * 32 * 4 <= MiB, "ws map 5");
static_assert(WS_XBUF + (size_t)ML * 16 <= MiB, "ws map 4");
constexpr int LDS_BARST = 131072 + 64;

typedef short cbf16x8 __attribute__((ext_vector_type(8)));
typedef float cf32x16 __attribute__((ext_vector_type(16)));
__device__ __forceinline__ cf32x16 ctx_seg(const GAS bf16* Arow, const GAS bf16* Brow, int kbeg, int kend) {
    cf32x16 acc; for (int r = 0; r < 16; ++r) acc[r] = 0.f;
#pragma unroll 8
    for (int k = kbeg; k < kend; k += 16) { const cbf16x8 av = *(const GAS cbf16x8*)(Arow + k), bv = *(const GAS cbf16x8*)(Brow + k);
        acc = __builtin_amdgcn_mfma_f32_32x32x16_bf16(bv, av, acc, 0, 0, 0); }
    return acc;
}
__device__ __forceinline__ void ctx_reduce(cf32x16& tot, LAS float* red, int wave, int lane) {
    const int q = wave & 3, tsel = wave >> 2;
    LAS float* mine = red + ((tsel * 4 + q) * 64 + lane) * 16;
    if (q != 0) {
#pragma unroll
        for (int r = 0; r < 16; r += 4) *(LAS f32x4*)(mine + r) = (f32x4){tot[r], tot[r + 1], tot[r + 2], tot[r + 3]}; }
    __syncthreads();
    if (q == 0) {
#pragma unroll
        for (int p = 1; p < 4; ++p)
#pragma unroll
            for (int r = 0; r < 16; r += 4) { const f32x4 v = *(const LAS f32x4*)(red + ((tsel * 4 + p) * 64 + lane) * 16 + r); tot[r] += v[0]; tot[r + 1] += v[1]; tot[r + 2] += v[2]; tot[r + 3] += v[3]; } }
    __syncthreads();
}
struct Args { const float* in[22]; float* out; unsigned char* ws; int ph_lo, ph_hi; };

__global__ void __launch_bounds__(NTHREADS, 2) fwd_kernel(Args a) {
    extern __shared__ __attribute__((aligned(16))) unsigned char lds[];
#define PTRS() \
    int tid_ = threadIdx.x; asm volatile("" : "+v"(tid_)); const int tid = tid_, lane = tid & 63, wave = __builtin_amdgcn_readfirstlane(tid >> 6); \
    int bx = blockIdx.x, G = gridDim.x; asm volatile("" : "+s"(bx), "+s"(G)); const int vcu = (G % 8 == 0) ? (bx % 8) * (G / 8) + bx / 8 : bx; (void)vcu; (void)tid; \
    const int gw = bx * NWAVES + wave, NGW = G * NWAVES; (void)gw; (void)NGW; (void)lane; \
    GAS unsigned char* wsr_ = (GAS unsigned char*)a.ws; asm volatile("" : "+s"(wsr_)); GAS unsigned char* const ws = (GAS unsigned char*)wsr_; \
    GAS float* const modv = (GAS float*)(ws + WS_MOD); GAS float* const cosT = (GAS float*)(ws + WS_COS); GAS float* const sinT = (GAS float*)(ws + WS_SIN); GAS float* const xctx = (GAS float*)(ws + WS_CTX); \
    GAS bf16* const Wb = (GAS bf16*)(ws + ((((ph - 1) >> 3) & 1) ? WS_W2 : WS_W)); GAS bf16* const Wn = (GAS bf16*)(ws + ((((ph - 1) >> 3) & 1) ? WS_W : WS_W2)); (void)Wn; GAS bf16* const H = (GAS bf16*)(ws + WS_H); GAS bf16* const Qb = (GAS bf16*)(ws + WS_Q); GAS bf16* const Kb = (GAS bf16*)(ws + WS_K); GAS bf16* const Vb = (GAS bf16*)(ws + WS_V); \
    GAS bf16* const Zcat = (GAS bf16*)(ws + WS_ZA);      GAS float* const ZF = (GAS float*)(ws + WS_ZF); \
    GAS bf16* const PCONV = (GAS bf16*)(ws + WS_P + P_CONV); GAS bf16* const PSG = (GAS bf16*)(ws + WS_P + P_SG); GAS bf16* const PG = (GAS bf16*)(ws + WS_P + P_G); GAS bf16* const HFF = (GAS bf16*)(ws + WS_P); \
    GAS bf16* const Zb = H; GAS float* const xlat = (GAS float*)a.out; LAS unsigned char* const ldsl = (LAS unsigned char*)lds; \
    (void)modv; (void)cosT; (void)sinT; (void)xctx; (void)Wb; (void)Qb; (void)Kb; (void)Vb; (void)Zcat; (void)ZF; (void)PCONV; (void)PSG; (void)PG; (void)HFF; (void)Zb; (void)xlat; (void)ldsl; \
    const int l = (ph - 1) >> 3; const bool last = (l == DEPTH - 1); const GAS float* const modl = modv + (size_t)l * 3 * NMODW; const int Mrows = last ? ML : MT; (void)modl; (void)Mrows; (void)last;

#define CONVERT_WEIGHTS(l, Wd, gw0_, ngw_) do { \
        LAS float* scr = (LAS float*)ldsl + wave * (64 * 33); \
        for (int it = (gw0_); it < 7808; it += (ngw_)) { int r = it; \
            if (r < 2560) { transpose_item<1>(INP(7) + (size_t)(l) * 1024 * INW, nullptr, 1024, INW, (Wd) + WO_IN, scr, r, 160, lane); continue; } r -= 2560; \
            if (r < 128) { transpose_item<0>(INP(14) + (size_t)(l) * 256 * 1024, nullptr, 256, 1024, (Wd) + WO_A, scr, r, 32, lane, 1024, 0); continue; } r -= 128; \
            if (r < 256) { transpose_item<0>(INP(15) + (size_t)(l) * 512 * 1024, nullptr, 512, 1024, (Wd) + WO_A, scr, r, 32, lane, 1024, 256); continue; } r -= 256; \
            if (r < 128) { transpose_item<0>(INP(16) + (size_t)(l) * 256 * 1024, nullptr, 256, 1024, (Wd) + WO_A, scr, r, 32, lane, 1024, 768); continue; } r -= 128; \
            if (r < 512) { transpose_item<0>(INP(17) + (size_t)(l) * 1024 * 1024, nullptr, 1024, 1024, (Wd) + WO_O, scr, r, 32, lane); continue; } r -= 512; \
            if (r < 2816) { transpose_item<2>(INP(19) + (size_t)(l) * 1024 * DFF, INP(20) + (size_t)(l) * 1024 * DFF, 1024, DFF, (Wd) + WO_13, scr, r, 176, lane); continue; } r -= 2816; \
            transpose_item<0>(INP(21) + (size_t)(l) * DFF * 1024, nullptr, DFF, 1024, (Wd) + WO_2, scr, r, 32, lane); } \
        __syncthreads(); } while (0)

#define NORM_ROWS(xsrc_, normw, modl, shidx, scidx, r0_, nrows) do { \
        for (int r = (r0_) + gw; r < (nrows); r += NGW) { const bool latent = r < ML; const GAS float* xrow = latent ? (xsrc_) + (size_t)r * 1024 : xctx + (size_t)(r - ML) * 1024; \
            const int src = latent ? (r >> 13) : 2; const GAS float* shp = (modl) + src * NMODW + (shidx) * 1024; const GAS float* scp = (modl) + src * NMODW + (scidx) * 1024; \
            f32x4 v[4]; float ss = 0.f; \
            _Pragma("unroll") for (int j = 0; j < 4; ++j) { v[j] = *((const GAS f32x4*)xrow + lane + 64 * j); ss += (v[j][0] * v[j][0] + v[j][1] * v[j][1]) + (v[j][2] * v[j][2] + v[j][3] * v[j][3]); } \
            const float rinv = 1.0f / sqrtf(wave_sum(ss) * (1.0f / 1024.0f) + 1e-6f); \
            _Pragma("unroll") for (int j = 0; j < 4; ++j) { const f32x4 gg = *((const GAS f32x4*)(normw) + lane + 64 * j), s4 = *((const GAS f32x4*)scp + lane + 64 * j), h4 = *((const GAS f32x4*)shp + lane + 64 * j); \
                const f32x4 o = v[j] * rinv * gg * (s4 + 1.0f) + h4; v2u w; w.x = pk2(o[0], o[1]); w.y = pk2(o[2], o[3]); *((GAS v2u*)(H + (size_t)r * 1024) + lane + 64 * j) = w; } } } while (0)


#define CTX_MERGE() do { \
        for (int tile0 = bx * 2; tile0 < 512; tile0 += 2 * G) { const int tile = tile0 + (wave >> 2), q = wave & 3, r32 = lane & 31, hi = lane >> 5; \
            const int row0 = ML + (tile >> 5) * 32, col0 = (tile & 31) * 32; const size_t arow = (size_t)(row0 + r32); \
            cf32x16 tot; \
            { const cf32x16 sa = ctx_seg(Zcat + arow * 1024 + 8 * hi, Wb + WO_A + (size_t)(col0 + r32) * 1024 + 8 * hi, q * 64, q * 64 + 64); \
              const cf32x16 sb = ctx_seg(Zcat + arow * 1024 + 256 + 8 * hi, Wb + WO_A + (size_t)(col0 + r32) * 1024 + 256 + 8 * hi, q * 128, q * 128 + 128); \
              const cf32x16 sc = ctx_seg(Zcat + arow * 1024 + 768 + 8 * hi, Wb + WO_A + (size_t)(col0 + r32) * 1024 + 768 + 8 * hi, q * 64, q * 64 + 64); \
              _Pragma("unroll") for (int qq = 0; qq < 4; ++qq) { const GAS bf16* gp = PG + arow * 3072 + col0 + 8 * qq + 4 * hi; \
                  const v2u ga = *(const GAS v2u*)gp, gb = *(const GAS v2u*)(gp + 1024), gc = *(const GAS v2u*)(gp + 2048); \
                  tot[4 * qq + 0] = bflo(ga.x) * sa[4 * qq + 0] + bflo(gb.x) * sb[4 * qq + 0] + bflo(gc.x) * sc[4 * qq + 0]; \
                  tot[4 * qq + 1] = bfhi(ga.x) * sa[4 * qq + 1] + bfhi(gb.x) * sb[4 * qq + 1] + bfhi(gc.x) * sc[4 * qq + 1]; \
                  tot[4 * qq + 2] = bflo(ga.y) * sa[4 * qq + 2] + bflo(gb.y) * sb[4 * qq + 2] + bflo(gc.y) * sc[4 * qq + 2]; \
                  tot[4 * qq + 3] = bfhi(ga.y) * sa[4 * qq + 3] + bfhi(gb.y) * sb[4 * qq + 3] + bfhi(gc.y) * sc[4 * qq + 3]; } } \
            ctx_reduce(tot, (LAS float*)ldsl, wave, lane); \
            if (q == 0) { _Pragma("unroll") for (int qq = 0; qq < 4; ++qq) { v2u o; o.x = pk2(tot[4 * qq], tot[4 * qq + 1]); o.y = pk2(tot[4 * qq + 2], tot[4 * qq + 3]); \
                *(GAS v2u*)(Zb + arow * 1024 + col0 + 8 * qq + 4 * hi) = o; } } } } while (0)
#define CTX_RESID(Aptr, lda_, Woff, gidx_, NRM_, normw_, modn_, shidx_, scidx_, want_) do { \
        for (int tile0 = bx * 2; tile0 < 512; tile0 += 2 * G) { const int tile = tile0 + (wave >> 2), q = wave & 3, r32 = lane & 31, hi = lane >> 5; \
            const int row0 = ML + (tile >> 5) * 32, col0 = (tile & 31) * 32; const size_t arow = (size_t)(row0 + r32); \
            cf32x16 tot = ctx_seg((Aptr) + arow * (lda_) + 8 * hi, Wb + (Woff) + (size_t)(col0 + r32) * (lda_) + 8 * hi, q * ((lda_) / 4), (q + 1) * ((lda_) / 4)); \
            ctx_reduce(tot, (LAS float*)ldsl, wave, lane); \
            if (q == 0) { float ss = 0.f; \
                _Pragma("unroll") for (int qq = 0; qq < 4; ++qq) { const int c = col0 + 8 * qq + 4 * hi; const f32x4 gt = *(const GAS f32x4*)(modl + 2 * NMODW + (gidx_) * 1024 + c); \
                    GAS f32x4* xp = (GAS f32x4*)(xctx + (arow - ML) * 1024 + c); const f32x4 xn = *xp + gt * (f32x4){tot[4 * qq], tot[4 * qq + 1], tot[4 * qq + 2], tot[4 * qq + 3]}; *xp = xn; \
                    tot[4 * qq] = xn[0]; tot[4 * qq + 1] = xn[1]; tot[4 * qq + 2] = xn[2]; tot[4 * qq + 3] = xn[3]; ss += (xn[0] * xn[0] + xn[1] * xn[1]) + (xn[2] * xn[2] + xn[3] * xn[3]); } \
                if (NRM_) {     \
                    unsigned* slots = (unsigned*)(ws + WS_XBUFC); unsigned* cntc = (unsigned*)(ws + WS_XCNTC) + 64 * (tile >> 5); \
                    ss += __shfl_xor(ss, 32); \
                    if (hi == 0) __hip_atomic_store(slots + (arow - ML) * 32 + (tile & 31), __float_as_uint(ss), __ATOMIC_RELAXED, __HIP_MEMORY_SCOPE_AGENT); \
                    asm volatile("s_waitcnt vmcnt(0)" ::: "memory"); \
                    if (lane == 0) __hip_atomic_fetch_add(cntc, 1u, __ATOMIC_RELAXED, __HIP_MEMORY_SCOPE_AGENT); \
                    { unsigned sp = 0; while ((unsigned)__builtin_amdgcn_readfirstlane(__hip_atomic_load(cntc, __ATOMIC_RELAXED, __HIP_MEMORY_SCOPE_AGENT)) < (want_)) { __builtin_amdgcn_s_sleep(1); if (++sp > (1u << 22)) break; } } \
                    __builtin_amdgcn_fence(__ATOMIC_ACQUIRE, "agent"); \
                    float tsum = 0.f; \
                    _Pragma("unroll 8") for (int k = 0; k < 32; ++k) tsum += __uint_as_float(__hip_atomic_load(slots + (arow - ML) * 32 + k, __ATOMIC_RELAXED, __HIP_MEMORY_SCOPE_AGENT)); \
                    const float rinv = 1.0f / sqrtf(tsum * (1.0f / 1024.0f) + 1e-6f); \
                    _Pragma("unroll") for (int qq = 0; qq < 4; ++qq) { const int c = col0 + 8 * qq + 4 * hi; \
                        const f32x4 gm = *(const GAS f32x4*)((normw_) + c) * (*(const GAS f32x4*)((modn_) + 2 * NMODW + (scidx_) * 1024 + c) + 1.0f), sh = *(const GAS f32x4*)((modn_) + 2 * NMODW + (shidx_) * 1024 + c); \
                        const f32x4 hh = (f32x4){tot[4 * qq], tot[4 * qq + 1], tot[4 * qq + 2], tot[4 * qq + 3]} * rinv * gm + sh; \
                        v2u w; w.x = pk2(hh[0], hh[1]); w.y = pk2(hh[2], hh[3]); *(GAS v2u*)(H + arow * 1024 + c) = w; } } } } } while (0)

    const bool fused_ = (a.ph_hi - a.ph_lo) > 1;
    { volatile LAS unsigned* st_ = (volatile LAS unsigned*)((LAS unsigned char*)lds + LDS_BARST); if (threadIdx.x == 0) { st_[0] = 0u; st_[1] = 0u; } __syncthreads(); }
    XcdBarrier bar; bar.bar = (unsigned*)(a.ws + WS_BAR); bar.x = 0; bar.st = (volatile LAS unsigned*)((LAS unsigned char*)lds + LDS_BARST);
    if (fused_) bar = xcd_barrier_post((unsigned*)(a.ws + WS_BAR), (volatile LAS unsigned*)((LAS unsigned char*)lds + LDS_BARST));
    unsigned long long tacc_ = 0ull, tph_ = 0ull; (void)tph_;
#if DUP_S >= 0 && DUP_S != 9
    for (int it_ = a.ph_lo * 2; it_ < a.ph_hi * 2; ++it_) { const int ph = it_ >> 1;
      const bool dupm_ = (ph == 0 && DUP_S == 8) || (ph >= 1 && ((ph - 1) & 7) == DUP_S);
      if (!(it_ & 1) || dupm_) {
#else
    for (int ph = a.ph_lo; ph < a.ph_hi; ++ph) { const int it_ = (gridDim.x == 256 && ph >= 1 && (((ph - 1) & 7) == 5 || (((ph - 1) & 7) == 0 && ph > 1))) ? 0 : 1; if (it_) {
#endif
        if (TIME_S >= 0) { tph_ = __builtin_amdgcn_s_memrealtime(); asm volatile("s_waitcnt lgkmcnt(0)" : "+s"(tph_) :: "memory"); }
        if (ph == 0) { PTRS();
            if (bx < 192) {
                typedef float f32x2_ __attribute__((ext_vector_type(2)));
                LAS float* sil = (LAS float*)ldsl + 8 * 64 * 33; LAS float* red = sil + 3072;
                for (int i = tid; i < 3072; i += NTHREADS) { const int src = i >> 10, k = i & 1023; const float v = src < 2 ? INP(1)[src * 1024 + k] : INP(3)[k]; sil[i] = v / (1.0f + expf(-v)); }
                __syncthreads();
                const int j0 = bx * 128, l = j0 / NMODW, jj = j0 % NMODW;
                const GAS float* Wm = INP(4) + (size_t)l * 1024 * NMODW + jj + 2 * lane;
                f32x2_ a0 = {0.f, 0.f}, a1 = a0, a2 = a0;
#pragma unroll 8
                for (int k = wave * 128; k < wave * 128 + 128; ++k) { const f32x2_ w = *(const GAS f32x2_*)(Wm + (size_t)k * NMODW); a0 += w * sil[k]; a1 += w * sil[1024 + k]; a2 += w * sil[2048 + k]; }
#pragma unroll
                for (int j = 0; j < 2; ++j) { red[(wave * 3 + 0) * 128 + 2 * lane + j] = a0[j]; red[(wave * 3 + 1) * 128 + 2 * lane + j] = a1[j]; red[(wave * 3 + 2) * 128 + 2 * lane + j] = a2[j]; }
                __syncthreads();
                for (int i = tid; i < 384; i += NTHREADS) { const int src = i >> 7, ci = i & 127; float s = INP(5)[l * NMODW + jj + ci];
#pragma unroll
                    for (int w = 0; w < 8; ++w) s += red[(w * 3 + src) * 128 + ci];
                    modv[(l * 3 + src) * NMODW + jj + ci] = s; }
                __syncthreads();
            }
            CONVERT_WEIGHTS(0, (GAS bf16*)(ws + WS_W), gw, NGW);
            { const int gt = bx * NTHREADS + tid, NT_ = G * NTHREADS;
              const GAS f32x4* c4 = (const GAS f32x4*)INP(2); GAS f32x4* oc4 = (GAS f32x4*)xctx;
              for (int i = gt; i < MC * 1024 / 4; i += NT_) oc4[i] = c4[i];
              for (int i = gt; i < 8192 * 32; i += NT_) { const int t = i >> 5, ax = (i >> 4) & 1, f = i & 15; const float pos = (float)(ax ? (t & 63) : (t >> 6));
                  const float invf = powf(10000.0f, -(float)(2 * f) / 32.0f); const float ang = pos * invf; cosT[i] = cosf(ang); sinT[i] = sinf(ang); } }
        } else {
            const int s = (ph - 1) & 7;
            if (s == 0) { PTRS();
                NORM_ROWS((l == 0 ? INP(0) : (const GAS float*)xlat), INP(6) + l * 1024, modl, 0, 1, ((l > 0 && G == 256) ? ML : 0), MT);
            } else if (s == 1) { PTRS();
                pg8::Gemm g{(const pg8::bf16_t*)H, (const pg8::bf16_t*)(Wb + WO_IN), MT, INW, 1024}; pg8::StaticOrder S; S.init(MT, INW, G, bx);
                pg8::EpiInProj E{PCONV, Qb, Kb, Vb, PSG, PG, INP(8) + l * 64, INP(9) + l * 64, cosT, sinT};
                pg8::gemm_phase<pg8::EpiInProj, pg8::StaticOrder, true, true>(ldsl, g, S, E);
                if (!last) { const int nbusy = (MT / 256) * (INW / 256) - ((MT / 256) * (INW / 256) / G) * G;
                    if (G - nbusy >= G / 2) { if (bx >= nbusy) CONVERT_WEIGHTS(l + 1, Wn, (bx - nbusy) * NWAVES + wave, (G - nbusy) * NWAVES); } else CONVERT_WEIGHTS(l + 1, Wn, gw, NGW); }
            } else if (s == 2) { PTRS();
                for (int ra_ = 0; ra_ < DUP_ATT; ++ra_) {
                const int upb = (512 + G - 1) / G;
                float mq_ = __builtin_fabsf(INP(8)[l * 64 + lane]), mk_ = __builtin_fabsf(INP(9)[l * 64 + lane]);
#pragma unroll
                for (int o = 1; o < 64; o <<= 1) { mq_ = __builtin_fmaxf(mq_, __shfl_xor(mq_, o)); mk_ = __builtin_fmaxf(mk_, __shfl_xor(mk_, o)); }
                const bool nomax = __builtin_amdgcn_readfirstlane((int)(64.0f * attn_body::C2 * mq_ * mk_ < 48.0f)) != 0;
                for (int i = 0;; ++i) { long qrow0_, kvrow0_; int h_, nt_;
                    if (i < upb) { const int uid = vcu * upb + i; if (uid >= 512) continue;
                        const int bhk = uid >> 7, rem = uid & 127, hg = rem >> 5, qb = rem & 31, b = bhk >> 1; h_ = (bhk & 1) * 4 + hg; qrow0_ = (long)b * 8192 + qb * 256; kvrow0_ = (long)b * 8448; nt_ = 132; }
                    else { const int uid = vcu + (i - upb) * G; if (last || uid >= 16) break; const int b = uid >> 3; h_ = uid & 7; qrow0_ = (long)ML + b * 256; kvrow0_ = (long)b * 8448 + 8192; nt_ = 4; }
                    if (nomax) attn_body::attn_unit<8, true>(qrow0_, h_, kvrow0_, nt_, (const attn_body::bf16*)Qb, (const attn_body::bf16*)Kb, (const attn_body::bf16*)Vb, (attn_body::bf16*)(Zcat + 256), (char*)lds);
                    else attn_body::attn_unit<8, false>(qrow0_, h_, kvrow0_, nt_, (const attn_body::bf16*)Qb, (const attn_body::bf16*)Kb, (const attn_body::bf16*)Vb, (attn_body::bf16*)(Zcat + 256), (char*)lds); }
                }
                __syncthreads();
                for (int rs_ = 0; rs_ < DUP_SG; ++rs_) {
                { const GAS float* cw = INP(10) + l * 768 + 4 * lane; const f32x4 w0 = *(const GAS f32x4*)cw, w1 = *(const GAS f32x4*)(cw + 256), w2 = *(const GAS f32x4*)(cw + 512);
                  for (int r = gw; r < Mrows; r += NGW) { const bool latent = r < ML; const int pos = latent ? (r & 8191) : ((r - ML) & 255), len = latent ? 8192 : 256;
                      const GAS bf16* p = PCONV + (size_t)r * 512 + 4 * lane;
                      const v2u ab = *(const GAS v2u*)p, q0 = *(const GAS v2u*)(p + 256);
                      v2u qm = {0u, 0u}, qp = qm;
                      if (pos > 0) qm = *(const GAS v2u*)(p - 512 + 256);
                      if (pos < len - 1) qp = *(const GAS v2u*)(p + 512 + 256);
                      const f32x4 pm = {bflo(qm.x), bfhi(qm.x), bflo(qm.y), bfhi(qm.y)}, p0 = {bflo(q0.x), bfhi(q0.x), bflo(q0.y), bfhi(q0.y)}, pp = {bflo(qp.x), bfhi(qp.x), bflo(qp.y), bfhi(qp.y)};
                      const f32x4 av = {bflo(ab.x), bfhi(ab.x), bflo(ab.y), bfhi(ab.y)};
                      const f32x4 o = av * (w0 * pm + w1 * p0 + w2 * pp);
                      v2u w; w.x = pk2(o[0], o[1]); w.y = pk2(o[2], o[3]); *(GAS v2u*)(Zcat + (size_t)r * 1024 + 4 * lane) = w; } }
                { typedef short bf16x8_t __attribute__((ext_vector_type(8))); typedef float f32x16_t __attribute__((ext_vector_type(16)));
                  LAS unsigned short* VT = (LAS unsigned short*)ldsl;
                  const int nitems = (Mrows / 128) * 4;
                  for (int item = bx; item < nitems; item += G) { const int chunk = item >> 2, g = item & 3, rb = chunk * 128;
                      { const int sub = lane >> 4, li = lane & 15;
#pragma unroll
                        for (int i = 0; i < 4; ++i) { const int srow = 16 * wave + 4 * i + sub; const GAS bf16* sp = PSG + (size_t)(rb + srow) * 512 + 256 + 16 * li;
                            const v4u r0 = *(const GAS v4u*)sp, r1 = *(const GAS v4u*)(sp + 8);
                            const float fv[16] = {bflo(r0.x), bfhi(r0.x), bflo(r0.y), bfhi(r0.y), bflo(r0.z), bfhi(r0.z), bflo(r0.w), bfhi(r0.w), bflo(r1.x), bfhi(r1.x), bflo(r1.y), bfhi(r1.y), bflo(r1.z), bfhi(r1.z), bflo(r1.w), bfhi(r1.w)};
                            float ss = 0.f;
#pragma unroll
                            for (int j = 0; j < 16; ++j) ss += fv[j] * fv[j];
                            ss += __shfl_xor(ss, 1); ss += __shfl_xor(ss, 2); ss += __shfl_xor(ss, 4); ss += __shfl_xor(ss, 8);
                            const float rinv = 1.0f / sqrtf(ss * (1.0f / 256.0f) + 1e-6f);
                            if ((li >> 2) == g) { const int d0 = 16 * (li & 3); const GAS float* gp_ = INP(11) + l * 256 + g * 64 + d0;
#pragma unroll
                                for (int j4 = 0; j4 < 4; ++j4) { const f32x4 gn = *(const GAS f32x4*)(gp_ + 4 * j4);
#pragma unroll
                                    for (int j = 0; j < 4; ++j) VT[(d0 + 4 * j4 + j) * 136 + srow] = (unsigned short)f2bf(fv[4 * j4 + j] * rinv * gn[j]); } } } }
                      __syncthreads();
                      const int tm = wave >> 1, tn = wave & 1, r32 = lane & 31, hi = lane >> 5;
                      const GAS float* Wrow = INP(12) + (size_t)(l * 4 + g) * 128 * 128 + (size_t)(32 * tm + r32) * 128 + 8 * hi;
                      const LAS unsigned short* Vrow = VT + (32 * tn + r32) * 136 + 8 * hi;
                      f32x16_t acc; for (int r = 0; r < 16; ++r) acc[r] = 0.f;
#pragma unroll
                      for (int k0 = 0; k0 < 8; ++k0) { const f32x4 w0 = *(const GAS f32x4*)(Wrow + 16 * k0), w1 = *(const GAS f32x4*)(Wrow + 16 * k0 + 4);
                          const v4u wp = {pk2(w0[0], w0[1]), pk2(w0[2], w0[3]), pk2(w1[0], w1[1]), pk2(w1[2], w1[3])};
                          const bf16x8_t af = *(const LAS bf16x8_t*)(Vrow + 16 * k0);
                          acc = __builtin_amdgcn_mfma_f32_32x32x16_bf16(af, __builtin_bit_cast(bf16x8_t, wp), acc, 0, 0, 0); }
                      const int t = 32 * tm + r32; const float bias = INP(13)[(l * 4 + g) * 128 + t]; const size_t row = (size_t)(rb + t);
#pragma unroll
                      for (int q = 0; q < 4; ++q) { const int dcol = g * 64 + 32 * tn + 8 * q + 4 * hi;
                          const v2u uu = *(const GAS v2u*)(PSG + row * 512 + dcol);
                          v2u o; o.x = pk2(bflo(uu.x) * (acc[4 * q + 0] + bias), bfhi(uu.x) * (acc[4 * q + 1] + bias)); o.y = pk2(bflo(uu.y) * (acc[4 * q + 2] + bias), bfhi(uu.y) * (acc[4 * q + 3] + bias));
                          *(GAS v2u*)(Zcat + row * 1024 + 768 + dcol) = o; }
                      __syncthreads(); } }
                }
            } else if (s == 3) { PTRS();
                pg8::StaticOrder S; S.init(ML, 1024, G, bx);
                { pg8::Gemm g{(const pg8::bf16_t*)Zcat, (const pg8::bf16_t*)(Wb + WO_A), ML, 1024, 1024}; pg8::EpiMergeFused E{PG, Zb}; pg8::gemm_phase<pg8::EpiMergeFused, pg8::StaticOrder, true, true>(ldsl, g, S, E); }
                if (!last) CTX_MERGE();
            } else if (s == 4) { PTRS();
                pg8::Gemm g{(const pg8::bf16_t*)Zb, (const pg8::bf16_t*)(Wb + WO_O), ML, 1024, 1024}; pg8::StaticOrder S; S.init(ML, 1024, G, bx);
                if (G == 256) { pg8::EpiResidNorm E{(l == 0 ? INP(0) : (const GAS float*)xlat), xlat, modl, 2, H, INP(18) + l * 1024, modl, 3, 4, (unsigned*)(ws + WS_XBUF), (unsigned*)(ws + WS_XCNT), 32u * (unsigned)(2 * l + 1)};
                    pg8::gemm_phase<pg8::EpiResidNorm, pg8::StaticOrder, false, true>(ldsl, g, S, E); }
                else { pg8::EpiResid E{(l == 0 ? INP(0) : (const GAS float*)xlat), xlat, xctx, modl, 2}; pg8::gemm_phase<pg8::EpiResid, pg8::StaticOrder, true, true>(ldsl, g, S, E); }
                if (!last) { if (G == 256) CTX_RESID(Zb, 1024, WO_O, 2, 1, INP(18) + l * 1024, modl, 3, 4, 32u * (unsigned)(2 * l + 1)); else CTX_RESID(Zb, 1024, WO_O, 2, 0, INP(18), modl, 3, 4, 0u); }
            } else if (s == 5) { PTRS();
                NORM_ROWS((const GAS float*)xlat, INP(18) + l * 1024, modl, 3, 4, (G == 256 ? ML : 0), Mrows);
            } else if (s == 6) { PTRS();
                pg8::Gemm g{(const pg8::bf16_t*)H, (const pg8::bf16_t*)(Wb + WO_13), Mrows, 2 * DFF, 1024}; pg8::StaticOrder S; S.init(Mrows, 2 * DFF, G, bx);
                pg8::EpiSwiGLU E{HFF}; pg8::gemm_phase<pg8::EpiSwiGLU, pg8::StaticOrder, true, true>(ldsl, g, S, E);
            } else { PTRS();
                pg8::Gemm g{(const pg8::bf16_t*)HFF, (const pg8::bf16_t*)(Wb + WO_2), ML, 1024, DFF}; pg8::StaticOrder S; S.init(ML, 1024, G, bx);
                if (G == 256 && !last) { pg8::EpiResidNorm E{(const GAS float*)xlat, xlat, modl, 5, H, INP(6) + (l + 1) * 1024, modv + (size_t)(l + 1) * 3 * NMODW, 0, 1, (unsigned*)(ws + WS_XBUF), (unsigned*)(ws + WS_XCNT), 32u * (unsigned)(2 * l + 2)};
                    pg8::gemm_phase<pg8::EpiResidNorm, pg8::StaticOrder, false, true>(ldsl, g, S, E); }
                else { pg8::EpiResid E{(const GAS float*)xlat, xlat, xctx, modl, 5}; pg8::gemm_phase<pg8::EpiResid, pg8::StaticOrder, true, true>(ldsl, g, S, E); }
                if (!last) { if (G == 256) CTX_RESID(HFF, DFF, WO_2, 5, 1, INP(6) + (l + 1) * 1024, modv + (size_t)(l + 1) * 3 * NMODW, 0, 1, 32u * (unsigned)(2 * l + 2)); else CTX_RESID(HFF, DFF, WO_2, 5, 0, INP(6), modl, 0, 1, 0u); }
            }
        }
      }
        if ((it_ & 1) && ph + 1 < a.ph_hi) { if (a.ph_hi > NPHASE) { asm volatile("s_waitcnt vmcnt(0)" ::: "memory"); cg::this_grid().sync(); } xcd_barrier(bar); if (DUP_S == 9) xcd_barrier(bar); }
        if (TIME_S >= 0 && (((TIME_MASK) >> (ph == 0 ? 8 : ((ph - 1) & 7))) & 1)) tacc_ += __builtin_amdgcn_s_memrealtime() - tph_;
    }
    if (TIME_S >= 0 && blockIdx.x == 0) { const unsigned long long te_ = __builtin_amdgcn_s_memrealtime() + tacc_; while (__builtin_amdgcn_s_memrealtime() < te_) __builtin_amdgcn_s_sleep(8); }
}

extern "C" void kernel_launch(void* const* d_in, const int* in_sizes, int n_in, void* d_out, int out_size, void* d_ws, size_t ws_size, hipStream_t stream) {
    static int grid = 0;
    if (grid == 0) {
        if (n_in != 22 || ws_size < WS_END) { fprintf(stderr, "kernel_launch: unexpected n_in %d / ws %zu (need %zu)\n", n_in, ws_size, (size_t)WS_END); grid = -1; return; }
        int dev = 0, cus = 0, per_cu = 0;
        (void)hipGetDevice(&dev); (void)hipDeviceGetAttribute(&cus, hipDeviceAttributeMultiprocessorCount, dev);
        if (hipFuncSetAttribute((const void*)fwd_kernel, hipFuncAttributeMaxDynamicSharedMemorySize, LDS_BYTES) != hipSuccess) { fprintf(stderr, "kernel_launch: hipFuncSetAttribute failed\n"); grid = -1; return; }
        if (hipOccupancyMaxActiveBlocksPerMultiprocessor(&per_cu, (const void*)fwd_kernel, NTHREADS, LDS_BYTES) != hipSuccess || per_cu < 1) { (void)hipGetLastError(); per_cu = 1; }
        grid = cus * per_cu; if (grid <= 0) grid = 256;
    }
    if (grid < 0) return;
    (void)hipMemsetAsync((char*)d_ws + WS_BAR, 0, BAR_BYTES, stream);
    Args a{};
    for (int i = 0; i < 22; ++i) a.in[i] = (const float*)d_in[i];
    a.out = (float*)d_out; a.ws = (unsigned char*)d_ws;
#if MK_MULTI
    for (int ph = 0; ph < NPHASE; ++ph) { a.ph_lo = ph; a.ph_hi = ph + 1; hipLaunchKernelGGL(fwd_kernel, dim3(grid), dim3(NTHREADS), LDS_BYTES, stream, a); }
#else
    a.ph_lo = 0; a.ph_hi = NPHASE;
    void* args[] = {&a};
    hipError_t e = hipLaunchCooperativeKernel((const void*)fwd_kernel, dim3(grid), dim3(NTHREADS), args, LDS_BYTES, stream);
    if (e != hipSuccess) fprintf(stderr, "cooperative launch failed: %s (grid %d)\n", hipGetErrorString(e), grid);
#endif
}
```

```cpp
#include <hip/hip_runtime.h>
#include <hip/hip_cooperative_groups.h>
#include <hip/hip_bf16.h>
#include <cstdio>
#include <cstdint>
#include <cmath>
namespace cg = cooperative_groups;

namespace pg8 {
#define PG8_LAS __attribute__((address_space(3)))
typedef unsigned short bf16_t;
typedef short bf16x8 __attribute__((ext_vector_type(8)));
typedef float f32x4 __attribute__((ext_vector_type(4)));
typedef unsigned u32x4 __attribute__((ext_vector_type(4)));
constexpr int BM = 256, BK = 64, HALF = 128, HTB = HALF * BK * 2  , STAGE_BYTES = 8 * HTB, NXCD = 8, WGM = 8;

__host__ __device__ __forceinline__ int lds_byte(int r, int c) { const int st = (r >> 4) * 2 + (c >> 5), rr = r & 15, cc = c & 31, ob = rr * 64 + cc * 2; return st * 1024 + (ob ^ (((ob >> 9) & 1) << 5)); }
__host__ __device__ __forceinline__ void stage_rc(int b, int& R, int& C) { const int st = b / 1024, sb = b % 1024, swz = sb ^ (((sb >> 9) & 1) << 5); R = (st >> 1) * 16 + swz / 64; C = (st & 1) * 32 + (swz % 64) / 2; }
__host__ __device__ __forceinline__ int perm32(int rho) { const int n = rho >> 4, i = rho & 15; return 8 * (i >> 2) + 4 * n + (i & 3); }

struct Unit { int pm, pn; };
struct Gemm { const bf16_t* A; const bf16_t* Bt; int M, N, K; };

struct StaticOrder {
    int nM, nN, nwg, G, c;
    __host__ __device__ void init(int M, int N, int G_, int c_) { nM = M / BM; nN = N / BM; nwg = nM * nN; G = G_; c = c_; }
    __host__ __device__ bool next(int i, Unit& u) const {
        const long L = (long)i * G + c; if (L >= nwg) return false;
        int wgid = (int)L; { const int q = nwg / NXCD, r = nwg % NXCD, xcd = wgid % NXCD, off = wgid / NXCD; wgid = (xcd < r ? xcd * (q + 1) : r * (q + 1) + (xcd - r) * q) + off; }
        const int nig = WGM * nN, gid = wgid / nig, fm = gid * WGM, gsz = (nM - fm) < WGM ? (nM - fm) : WGM;
        u.pm = fm + ((wgid % nig) % gsz); u.pn = (wgid % nig) / gsz; return true;
    }
    __device__ __forceinline__ void a_ready(const Unit&) const {}
    __device__ __forceinline__ void done(const Unit&) const {}
};

__device__ __forceinline__ unsigned cvt_pk_bf16(float lo, float hi) { unsigned r; asm volatile("v_cvt_pk_bf16_f32 %0, %1, %2" : "=v"(r) : "v"(lo), "v"(hi)); return r; }
typedef float f32x2 __attribute__((ext_vector_type(2)));
__device__ __forceinline__ float bf_lo(unsigned w) { return __uint_as_float(w << 16); }
__device__ __forceinline__ float bf_hi(unsigned w) { return __uint_as_float(w & 0xffff0000u); }
__device__ __forceinline__ float sigmoid_f(float x) { return __builtin_amdgcn_rcpf(1.0f + __builtin_amdgcn_exp2f(-1.4426950408889634f * x)); }
__device__ __forceinline__ float gelu_tanh_f(float x) { const float in2 = 1.5957691216057308f * (x + 0.044715f * x * x * x); return x * sigmoid_f(in2); }
__device__ __forceinline__ f32x4 act4(f32x4 v, int act) {
    if (act == 1) return (f32x4){gelu_tanh_f(v[0]), gelu_tanh_f(v[1]), gelu_tanh_f(v[2]), gelu_tanh_f(v[3])};
    if (act == 2) return (f32x4){sigmoid_f(v[0]), sigmoid_f(v[1]), sigmoid_f(v[2]), sigmoid_f(v[3])};
    return v;
}
constexpr float ATT_C2 = 0.125f * 1.4426950408889634f;
typedef unsigned u32x2 __attribute__((ext_vector_type(2)));
#define GAS __attribute__((address_space(1)))
struct EpiInProj {
    static constexpr bool PERM = true, AFTER_DRAIN = false, HAS_HOOK = false;
    GAS bf16_t *PCONV, *Q, *Kb, *Vb, *PSG, *PG; const GAS float *qg, *kg, *cosT, *sinT;
    __device__ __forceinline__ void operator()(const f32x4 (&acc)[2][2][4][2], const Unit& u, int wr, int wc, int fr, int fq) const {
        const int row0 = u.pm * BM + wr * 64 + fr, pn = u.pn;
        if (pn >= 3 && pn < 6) {
            const bool isq = pn < 5, isv = (pn == 5) && (wc >= 2), latent = u.pm < 64;
            const GAS float* gp = isq ? qg : kg;
            f32x4 gn[2][2];
#pragma unroll
            for (int bj = 0; bj < 2; ++bj)
#pragma unroll
                for (int n = 0; n < 2; ++n) gn[bj][n] = *(const GAS f32x4*)(gp + 32 * bj + 16 * n + 4 * fq);
#pragma unroll
            for (int ai = 0; ai < 2; ++ai)
#pragma unroll
                for (int m = 0; m < 4; ++m) {
                    const int row = row0 + ai * HALF + m * 16;
                    f32x4 v[2][2];
#pragma unroll
                    for (int bj = 0; bj < 2; ++bj)
#pragma unroll
                        for (int n = 0; n < 2; ++n) v[bj][n] = acc[ai][bj][m][n];
                    if (!isv) {
                        float ss = 0.f;
#pragma unroll
                        for (int bj = 0; bj < 2; ++bj)
#pragma unroll
                            for (int n = 0; n < 2; ++n) { const f32x4 x = v[bj][n]; ss += (x[0] * x[0] + x[1] * x[1]) + (x[2] * x[2] + x[3] * x[3]); }
                        ss += __shfl_xor(ss, 16); ss += __shfl_xor(ss, 32);
                        const float r = (1.0f / sqrtf(ss * (1.0f / 64.0f) + 1e-6f)) * (isq ? ATT_C2 : 1.0f);
#pragma unroll
                        for (int bj = 0; bj < 2; ++bj)
#pragma unroll
                            for (int n = 0; n < 2; ++n) v[bj][n] = v[bj][n] * gn[bj][n] * r;
                        if (latent) {
                            const int t = row & 8191;
#pragma unroll
                            for (int bj = 0; bj < 2; ++bj) {
                                const f32x4 c = *(const GAS f32x4*)(cosT + t * 32 + bj * 16 + 4 * fq), s = *(const GAS f32x4*)(sinT + t * 32 + bj * 16 + 4 * fq);
                                const f32x4 x1 = v[bj][0], x2 = v[bj][1];
                                v[bj][0] = x1 * c - x2 * s; v[bj][1] = x2 * c + x1 * s;
                            }
                        }
                    }
                    GAS bf16_t* dst;
                    if (isq) dst = Q + (size_t)row * 512 + (pn - 3) * 256 + wc * 64;
                    else {
                        const int rc = row - 16384;
                        const size_t kvrow = latent ? (size_t)((row >> 13) * 8448 + (row & 8191)) : (size_t)((rc >> 8) * 8448 + 8192 + (rc & 255));
                        dst = isv ? Vb + kvrow * 128 + (wc - 2) * 64 : Kb + kvrow * 128 + wc * 64;
                    }
#pragma unroll
                    for (int bj = 0; bj < 2; ++bj)
#pragma unroll
                        for (int n = 0; n < 2; ++n) { u32x2 w; w.x = cvt_pk_bf16(v[bj][n][0], v[bj][n][1]); w.y = cvt_pk_bf16(v[bj][n][2], v[bj][n][3]);
                            *(GAS u32x2*)(dst + 32 * bj + 16 * n + 4 * fq) = w; }
                }
        } else if (pn == 1 || pn == 2) {
            const int col0 = 256 + (pn - 1) * 128 + wc * 32 + 8 * fq;
#pragma unroll
            for (int ai = 0; ai < 2; ++ai)
#pragma unroll
                for (int m = 0; m < 4; ++m) { const f32x4 v0 = acc[ai][0][m][0] * acc[ai][1][m][0], v1 = acc[ai][0][m][1] * acc[ai][1][m][1];
                    u32x4 w; w.x = cvt_pk_bf16(v0[0], v0[1]); w.y = cvt_pk_bf16(v0[2], v0[3]); w.z = cvt_pk_bf16(v1[0], v1[1]); w.w = cvt_pk_bf16(v1[2], v1[3]);
                    *(GAS u32x4*)(PCONV + (size_t)(row0 + ai * HALF + m * 16) * 512 + col0) = w; }
        } else {
            GAS bf16_t* base; int ld, colt, act;
            if (pn < 3) { base = PCONV; ld = 512; colt = 0; act = 0; }
            else if (pn < 8) { base = PSG; ld = 512; colt = (pn - 6) * 256; act = 1; }
            else { base = PG; ld = 3072; colt = (pn - 8) * 256; act = 2; }
            const int col0 = colt + wc * 32 + 8 * fq;
#pragma unroll
            for (int ai = 0; ai < 2; ++ai)
#pragma unroll
                for (int m = 0; m < 4; ++m) { GAS bf16_t* rowp = base + (size_t)(row0 + ai * HALF + m * 16) * ld + col0;
#pragma unroll
                    for (int bj = 0; bj < 2; ++bj) { const f32x4 v0 = act4(acc[ai][bj][m][0], act), v1 = act4(acc[ai][bj][m][1], act);
                        u32x4 w; w.x = cvt_pk_bf16(v0[0], v0[1]); w.y = cvt_pk_bf16(v0[2], v0[3]); w.z = cvt_pk_bf16(v1[0], v1[1]); w.w = cvt_pk_bf16(v1[2], v1[3]);
                        *(GAS u32x4*)(rowp + bj * HALF) = w; } }
        }
    }
};
struct EpiMergeFused {
    static constexpr bool PERM = true, AFTER_DRAIN = false, HAS_HOOK = true; static constexpr int T1 = 4, T2 = 12;
    const GAS bf16_t* PG; GAS bf16_t* z;
    __device__ __forceinline__ void hook(f32x4 (&acc)[2][2][4][2], const Unit& u, int t, int wr, int wc, int fr, int fq) const {
        asm volatile("" : "+v"(fr), "+v"(fq));
        const int row0 = u.pm * BM + wr * 64 + fr, col0 = u.pn * BM + wc * 32 + 8 * fq, goff = (t == T1) ? 0 : 1024;
#pragma unroll
        for (int ai = 0; ai < 2; ++ai)
#pragma unroll
            for (int m = 0; m < 4; ++m) { const size_t row = (size_t)(row0 + ai * HALF + m * 16);
#pragma unroll
                for (int bj = 0; bj < 2; ++bj) { const GAS bf16_t* gp = PG + row * 3072 + goff + col0 + bj * HALF;
                    const u32x4 gn = *(const GAS u32x4*)gp, gd = *(const GAS u32x4*)(gp + 1024);
                    const f32x4 n0 = {bf_lo(gn.x), bf_hi(gn.x), bf_lo(gn.y), bf_hi(gn.y)}, n1 = {bf_lo(gn.z), bf_hi(gn.z), bf_lo(gn.w), bf_hi(gn.w)};
                    f32x4 d0 = {bf_lo(gd.x), bf_hi(gd.x), bf_lo(gd.y), bf_hi(gd.y)}, d1 = {bf_lo(gd.z), bf_hi(gd.z), bf_lo(gd.w), bf_hi(gd.w)};
#pragma unroll
                    for (int j = 0; j < 4; ++j) { d0[j] = __builtin_amdgcn_rcpf(__builtin_fmaxf(d0[j], 1e-30f)); d1[j] = __builtin_amdgcn_rcpf(__builtin_fmaxf(d1[j], 1e-30f)); }
                    acc[ai][bj][m][0] = acc[ai][bj][m][0] * (n0 * d0); acc[ai][bj][m][1] = acc[ai][bj][m][1] * (n1 * d1); } }
    }
    __device__ __forceinline__ void operator()(const f32x4 (&acc)[2][2][4][2], const Unit& u, int wr, int wc, int fr, int fq) const {
        asm volatile("" : "+v"(fr), "+v"(fq));
        const int row0 = u.pm * BM + wr * 64 + fr, col0 = u.pn * BM + wc * 32 + 8 * fq;
#pragma unroll
        for (int ai = 0; ai < 2; ++ai)
#pragma unroll
            for (int m = 0; m < 4; ++m) { const size_t row = (size_t)(row0 + ai * HALF + m * 16);
#pragma unroll
                for (int bj = 0; bj < 2; ++bj) { const int col = col0 + bj * HALF;
                    const u32x4 gw = *(const GAS u32x4*)(PG + row * 3072 + 2048 + col);
                    const f32x4 v0 = acc[ai][bj][m][0] * (f32x4){bf_lo(gw.x), bf_hi(gw.x), bf_lo(gw.y), bf_hi(gw.y)};
                    const f32x4 v1 = acc[ai][bj][m][1] * (f32x4){bf_lo(gw.z), bf_hi(gw.z), bf_lo(gw.w), bf_hi(gw.w)};
                    u32x4 w; w.x = cvt_pk_bf16(v0[0], v0[1]); w.y = cvt_pk_bf16(v0[2], v0[3]); w.z = cvt_pk_bf16(v1[0], v1[1]); w.w = cvt_pk_bf16(v1[2], v1[3]);
                    *(GAS u32x4*)(z + row * 1024 + col) = w; } }
    }
};
struct EpiResid {
    static constexpr bool PERM = false, AFTER_DRAIN = false, HAS_HOOK = false;
    const GAS float* xsrc; GAS float* xlat; GAS float* xctx; const GAS float* modl; int gidx;
    __device__ __forceinline__ void operator()(const f32x4 (&acc)[2][2][4][2], const Unit& u, int wr, int wc, int fr, int fq) const {
        const int row0 = u.pm * BM + wr * 64 + fr, col0 = u.pn * BM + wc * 32 + 4 * fq;
        const bool latent = u.pm < 64; const int src = latent ? (u.pm >> 5) : 2;
        f32x4 gt[2][2];
#pragma unroll
        for (int bj = 0; bj < 2; ++bj)
#pragma unroll
            for (int n = 0; n < 2; ++n) gt[bj][n] = *(const GAS f32x4*)(modl + src * 6144 + gidx * 1024 + col0 + bj * HALF + n * 16);
#pragma unroll
        for (int ai = 0; ai < 2; ++ai)
#pragma unroll
            for (int m = 0; m < 4; ++m) { const int row = row0 + ai * HALF + m * 16;
                GAS float* xp = (latent ? xlat + (size_t)row * 1024 : xctx + (size_t)(row - 16384) * 1024) + col0;
                const GAS float* xs = (latent ? xsrc + (size_t)row * 1024 : xctx + (size_t)(row - 16384) * 1024) + col0;
#pragma unroll
                for (int bj = 0; bj < 2; ++bj)
#pragma unroll
                    for (int n = 0; n < 2; ++n) { *(GAS f32x4*)(xp + bj * HALF + n * 16) = *(const GAS f32x4*)(xs + bj * HALF + n * 16) + gt[bj][n] * acc[ai][bj][m][n]; } }
    }
};
struct EpiResidNorm {
    static constexpr bool PERM = true, AFTER_DRAIN = true, HAS_HOOK = false;
    const GAS float* xsrc; GAS float* xlat; const GAS float* modl; int gidx; GAS bf16_t* Hout; const GAS float* normw; const GAS float* modn; int shidx, scidx;
    unsigned* xbuf; unsigned* cnt; unsigned want;
    __device__ __forceinline__ void operator()(const f32x4 (&)[2][2][4][2], const Unit&, int, int, int, int) const {}
    __device__ __forceinline__ void fused(f32x4 (&acc)[2][2][4][2], const Unit& u, int wr, int wc, int fr, int fq, PG8_LAS unsigned char* lds, int wid, int lane) const {
        asm volatile("" : "+v"(fr), "+v"(fq));
        PG8_LAS float* P = (PG8_LAS float*)lds;
        PG8_LAS float* S = (PG8_LAS float*)(lds + 4096);
        const int row0 = u.pm * BM + wr * 64 + fr, col0 = u.pn * BM + wc * 32 + 8 * fq, src = u.pm >> 5;
        f32x4 gt[2][2];
#pragma unroll
        for (int bj = 0; bj < 2; ++bj)
#pragma unroll
            for (int n = 0; n < 2; ++n) gt[bj][n] = *(const GAS f32x4*)(modl + src * 6144 + gidx * 1024 + col0 + bj * HALF + n * 4);
#pragma unroll
        for (int ai = 0; ai < 2; ++ai)
#pragma unroll
            for (int m = 0; m < 4; ++m) { const int row = row0 + ai * HALF + m * 16; float ss = 0.f;
                GAS float* xp = xlat + (size_t)row * 1024 + col0; const GAS float* xs = xsrc + (size_t)row * 1024 + col0;
#pragma unroll
                for (int bj = 0; bj < 2; ++bj)
#pragma unroll
                    for (int n = 0; n < 2; ++n) { const f32x4 xn = *(const GAS f32x4*)(xs + bj * HALF + n * 4) + gt[bj][n] * acc[ai][bj][m][n]; acc[ai][bj][m][n] = xn;
                        *(GAS f32x4*)(xp + bj * HALF + n * 4) = xn; ss += (xn[0] * xn[0] + xn[1] * xn[1]) + (xn[2] * xn[2] + xn[3] * xn[3]); }
                ss += __shfl_xor(ss, 16); ss += __shfl_xor(ss, 32);
                if (fq == 0) P[(ai * HALF + wr * 64 + m * 16 + fr) * 4 + wc] = ss; }
        asm volatile("s_waitcnt lgkmcnt(0)" ::: "memory"); __builtin_amdgcn_s_barrier(); asm volatile("" ::: "memory");
        const int rl = wid * 32 + (lane & 31);
        if (lane < 32) { const float t = (P[rl * 4 + 0] + P[rl * 4 + 1]) + (P[rl * 4 + 2] + P[rl * 4 + 3]);
            __hip_atomic_store(xbuf + ((size_t)(u.pm * BM + rl) * 4 + u.pn), __float_as_uint(t), __ATOMIC_RELAXED, __HIP_MEMORY_SCOPE_AGENT); }
        asm volatile("s_waitcnt vmcnt(0)" ::: "memory");
        if (lane == 0) __hip_atomic_fetch_add(cnt + 64 * u.pm, 1u, __ATOMIC_RELAXED, __HIP_MEMORY_SCOPE_AGENT);
        if (wid == 0) { unsigned sp = 0;
            while ((unsigned)__builtin_amdgcn_readfirstlane(__hip_atomic_load(cnt + 64 * u.pm, __ATOMIC_RELAXED, __HIP_MEMORY_SCOPE_AGENT)) < want) { __builtin_amdgcn_s_sleep(1); if (++sp > (1u << 22)) break; }
            __builtin_amdgcn_fence(__ATOMIC_ACQUIRE, "agent"); }
        asm volatile("s_waitcnt vmcnt(0) lgkmcnt(0)" ::: "memory"); __builtin_amdgcn_s_barrier(); asm volatile("" ::: "memory");
        if (lane < 32) { const unsigned* sl = xbuf + (size_t)(u.pm * BM + rl) * 4; float t = 0.f;
#pragma unroll
            for (int k = 0; k < 4; ++k) t += __uint_as_float(__hip_atomic_load(sl + k, __ATOMIC_RELAXED, __HIP_MEMORY_SCOPE_AGENT));
            S[rl] = 1.0f / sqrtf(t * (1.0f / 1024.0f) + 1e-6f); }
        asm volatile("s_waitcnt vmcnt(0) lgkmcnt(0)" ::: "memory"); __builtin_amdgcn_s_barrier(); asm volatile("" ::: "memory");
        const GAS float* shp = modn + src * 6144 + shidx * 1024 + col0; const GAS float* scp = modn + src * 6144 + scidx * 1024 + col0; const GAS float* nwp = normw + col0;
#pragma unroll
        for (int bj = 0; bj < 2; ++bj) { const int co = bj * HALF;
            const f32x4 gm0 = *(const GAS f32x4*)(nwp + co) * (*(const GAS f32x4*)(scp + co) + 1.0f), sh0 = *(const GAS f32x4*)(shp + co);
            const f32x4 gm1 = *(const GAS f32x4*)(nwp + co + 4) * (*(const GAS f32x4*)(scp + co + 4) + 1.0f), sh1 = *(const GAS f32x4*)(shp + co + 4);
#pragma unroll
            for (int ai = 0; ai < 2; ++ai)
#pragma unroll
                for (int m = 0; m < 4; ++m) { const int rloc = ai * HALF + wr * 64 + m * 16 + fr; const float rinv = S[rloc];
                    const f32x4 h0 = acc[ai][bj][m][0] * rinv * gm0 + sh0, h1 = acc[ai][bj][m][1] * rinv * gm1 + sh1;
                    u32x4 w; w.x = cvt_pk_bf16(h0[0], h0[1]); w.y = cvt_pk_bf16(h0[2], h0[3]); w.z = cvt_pk_bf16(h1[0], h1[1]); w.w = cvt_pk_bf16(h1[2], h1[3]);
                    *(GAS u32x4*)(Hout + (size_t)(u.pm * BM + rloc) * 1024 + col0 + co) = w; } }
    }
};
struct EpiSwiGLU {
    static constexpr bool PERM = true, AFTER_DRAIN = false, HAS_HOOK = false;
    GAS bf16_t* HFF;
    __device__ __forceinline__ void operator()(const f32x4 (&acc)[2][2][4][2], const Unit& u, int wr, int wc, int fr, int fq) const {
        const int row0 = u.pm * BM + wr * 64 + fr, col0 = u.pn * HALF + wc * 32 + 8 * fq;
#pragma unroll
        for (int ai = 0; ai < 2; ++ai)
#pragma unroll
            for (int m = 0; m < 4; ++m) { const size_t row = (size_t)(row0 + ai * HALF + m * 16);
                const f32x4 a0 = acc[ai][0][m][0], a1 = acc[ai][0][m][1], b0 = acc[ai][1][m][0], b1 = acc[ai][1][m][1];
                f32x4 h0, h1;
#pragma unroll
                for (int j = 0; j < 4; ++j) { h0[j] = a0[j] * sigmoid_f(a0[j]) * b0[j]; h1[j] = a1[j] * sigmoid_f(a1[j]) * b1[j]; }
                u32x4 w; w.x = cvt_pk_bf16(h0[0], h0[1]); w.y = cvt_pk_bf16(h0[2], h0[3]); w.z = cvt_pk_bf16(h1[0], h1[1]); w.w = cvt_pk_bf16(h1[2], h1[3]);
                *(GAS u32x4*)(HFF + row * 2816 + col0) = w; }
    }
};
template <class Epi, class Sched, bool ALIGN_EPI = false, bool SP2 = false>
__device__ __forceinline__ void gemm_phase(PG8_LAS unsigned char* lds, const Gemm g, const Sched& S, const Epi& E) {
    int tid_ = threadIdx.x; asm volatile("" : "+v"(tid_)); const int tid = tid_, wid = __builtin_amdgcn_readfirstlane(tid >> 6), lane = tid & 63, wr = wid >> 2, wc = wid & 3, fr = lane & 15, fq = lane >> 4;
    int K_ = g.K; asm volatile("" : "+s"(K_)); const int K = K_, nt = K / BK;
    unsigned voffA[2], voffB[2];
#pragma unroll
    for (int i = 0; i < 2; ++i) { int R, C; stage_rc(tid * 16 + i * 8192, R, C); const int Rb = Epi::PERM ? ((R & ~31) + perm32(R & 31)) : R;
        voffA[i] = (unsigned)(R * K + C) * 2u; voffB[i] = (unsigned)(Rb * K + C) * 2u; }
    const size_t kstep = (size_t)(BK * 2);
    const size_t hstep = (size_t)HALF * K * 2;
    const size_t tstep = 2 * hstep;
    const unsigned ldsw = (unsigned)wid * 1024u;
    const int aoff = lds_byte(wr * 64 + fr, fq * 8), boff = lds_byte(wc * 32 + fr, fq * 8);
#define PG8_SA(b, h) (((b) * 2 + (h)) * HTB)
#define PG8_SB(b, h) ((4 + (b) * 2 + (h)) * HTB)
#define PG8_STAGE(bufoff, gbase, voff) do { _Pragma("unroll") for (int _i = 0; _i < 2; ++_i) \
        __builtin_amdgcn_global_load_lds((const unsigned*)((const char*)(gbase) + (voff)[_i]), (PG8_LAS unsigned*)(lds + (bufoff) + ldsw + _i * 8192), 16, 0, 0); } while (0)
#define PG8_LDA(dst, b, h) do { _Pragma("unroll") for (int m = 0; m < 4; ++m) _Pragma("unroll") for (int k = 0; k < 2; ++k) dst[m][k] = *(const PG8_LAS bf16x8*)(lds + PG8_SA(b, h) + aoff + m * 2048 + k * 1024); } while (0)
#define PG8_LDB(dst, b, h) do { _Pragma("unroll") for (int n = 0; n < 2; ++n) _Pragma("unroll") for (int k = 0; k < 2; ++k) dst[n][k] = *(const PG8_LAS bf16x8*)(lds + PG8_SB(b, h) + boff + n * 2048 + k * 1024); } while (0)
#define PG8_MMA(ai, bj, At, Bt) do { __builtin_amdgcn_s_setprio(1); _Pragma("unroll") for (int m = 0; m < 4; ++m) _Pragma("unroll") for (int n = 0; n < 2; ++n) _Pragma("unroll") for (int k = 0; k < 2; ++k) \
        acc[ai][bj][m][n] = __builtin_amdgcn_mfma_f32_16x16x32_bf16(Bt[n][k], At[m][k], acc[ai][bj][m][n], 0, 0, 0); __builtin_amdgcn_s_setprio(0); } while (0)
#define PG8_WAIT_V(n) asm volatile("s_waitcnt vmcnt(" #n ")" ::: "memory")
#define PG8_WAIT_L(n) asm volatile("s_waitcnt lgkmcnt(" #n ")" ::: "memory")
#define PG8_BAR __builtin_amdgcn_s_barrier()
#define PG8_SCHED __builtin_amdgcn_sched_barrier(0)
    Unit cur, nxt; int ui = 0;
    if (!S.next(0, cur)) return;
    f32x4 acc[2][2][4][2];
#pragma unroll
    for (int a = 0; a < 2; ++a)
#pragma unroll
        for (int b = 0; b < 2; ++b)
#pragma unroll
            for (int m = 0; m < 4; ++m)
#pragma unroll
                for (int n = 0; n < 2; ++n) acc[a][b][m][n] = (f32x4){0.f, 0.f, 0.f, 0.f};
    bf16x8 At[4][2], B0[2][2], B1[2][2];
    const char* cA = (const char*)g.A + (size_t)cur.pm * tstep; const char* cB = (const char*)g.Bt + (size_t)cur.pn * tstep;
    S.a_ready(cur);
    if constexpr (SP2) {
        PG8_STAGE(PG8_SB(0, 0), cB, voffB); PG8_STAGE(PG8_SB(0, 1), cB + hstep, voffB); PG8_STAGE(PG8_SA(0, 0), cA, voffA); PG8_STAGE(PG8_SA(0, 1), cA + hstep, voffA);
        if (wr == 1) PG8_BAR;
        PG8_WAIT_V(2); PG8_BAR;
        PG8_STAGE(PG8_SB(1, 0), cB + kstep, voffB); PG8_STAGE(PG8_SA(1, 0), cA + kstep, voffA); PG8_STAGE(PG8_SB(1, 1), cB + hstep + kstep, voffB);
        PG8_WAIT_V(6); PG8_BAR;
    } else {
        PG8_STAGE(PG8_SB(0, 0), cB, voffB); PG8_STAGE(PG8_SA(0, 0), cA, voffA); PG8_STAGE(PG8_SB(0, 1), cB + hstep, voffB); PG8_STAGE(PG8_SA(0, 1), cA + hstep, voffA);
        if (wr == 1) PG8_BAR;
        PG8_WAIT_V(4); PG8_BAR;
        PG8_STAGE(PG8_SB(1, 0), cB + kstep, voffB); PG8_STAGE(PG8_SA(1, 0), cA + kstep, voffA); PG8_STAGE(PG8_SB(1, 1), cB + hstep + kstep, voffB);
        PG8_WAIT_V(6); PG8_BAR;
    }
    for (;;) {
        const bool has_next = S.next(ui + 1, nxt);
        const char* nA = has_next ? (const char*)g.A + (size_t)nxt.pm * tstep : cA; const char* nB = has_next ? (const char*)g.Bt + (size_t)nxt.pn * tstep : cB;
        for (int t = 0; t < nt; t += 2) {
            if constexpr (Epi::HAS_HOOK) { if (t == Epi::T1 || t == Epi::T2) E.hook(acc, cur, t, wr, wc, fr, fq); }
            const bool last = (t == nt - 2);
            const char* a1 = cA + (size_t)(t + 1) * kstep;
            const char* a2 = last ? nA : cA + (size_t)(t + 2) * kstep; const char* b2 = last ? nB : cB + (size_t)(t + 2) * kstep;
            const char* a3 = a2 + kstep; const char* b3 = b2 + kstep;
            if (last && has_next) S.a_ready(nxt);
            if constexpr (SP2) {
            PG8_LDB(B0, 0, 0); PG8_LDB(B1, 0, 1); PG8_SCHED; PG8_LDA(At, 0, 0); PG8_STAGE(PG8_SA(1, 1), a1 + hstep, voffA);
            PG8_WAIT_V(8); PG8_WAIT_L(0); PG8_BAR; PG8_MMA(0, 0, At, B0); PG8_MMA(0, 1, At, B1); PG8_BAR; PG8_SCHED;
            PG8_LDA(At, 0, 1); PG8_STAGE(PG8_SB(0, 0), b2, voffB); PG8_STAGE(PG8_SB(0, 1), b2 + hstep, voffB); PG8_STAGE(PG8_SA(0, 0), a2, voffA);
            PG8_WAIT_V(8); PG8_WAIT_L(0); PG8_BAR; PG8_MMA(1, 0, At, B0); PG8_MMA(1, 1, At, B1); PG8_BAR; PG8_SCHED;
            PG8_LDB(B0, 1, 0); PG8_LDB(B1, 1, 1); PG8_SCHED; PG8_LDA(At, 1, 0); PG8_STAGE(PG8_SA(0, 1), a2 + hstep, voffA);
            PG8_WAIT_V(8); PG8_WAIT_L(0); PG8_BAR; PG8_MMA(0, 0, At, B0); PG8_MMA(0, 1, At, B1); PG8_BAR; PG8_SCHED;
            PG8_LDA(At, 1, 1); PG8_STAGE(PG8_SB(1, 0), b3, voffB); PG8_STAGE(PG8_SB(1, 1), b3 + hstep, voffB); PG8_STAGE(PG8_SA(1, 0), a3, voffA);
            PG8_WAIT_V(8); PG8_WAIT_L(0); PG8_BAR; PG8_MMA(1, 0, At, B0); PG8_MMA(1, 1, At, B1); PG8_BAR; PG8_SCHED;
            } else {
            PG8_LDB(B0, 0, 0); PG8_SCHED; PG8_LDA(At, 0, 0); PG8_STAGE(PG8_SA(1, 1), a1 + hstep, voffA);
            PG8_WAIT_L(8); PG8_BAR; PG8_WAIT_L(0); PG8_MMA(0, 0, At, B0); PG8_BAR; PG8_SCHED;
            PG8_LDB(B1, 0, 1); PG8_STAGE(PG8_SB(0, 0), b2, voffB);
            PG8_BAR; PG8_WAIT_L(0); PG8_MMA(0, 1, At, B1); PG8_BAR;
            PG8_LDA(At, 0, 1); PG8_STAGE(PG8_SA(0, 0), a2, voffA);
            PG8_BAR; PG8_WAIT_L(0); PG8_MMA(1, 0, At, B0); PG8_BAR; PG8_SCHED;
            PG8_STAGE(PG8_SB(0, 1), b2 + hstep, voffB);
            PG8_WAIT_V(6); PG8_BAR; PG8_MMA(1, 1, At, B1); PG8_BAR;
            PG8_LDB(B0, 1, 0); PG8_SCHED; PG8_LDA(At, 1, 0); PG8_STAGE(PG8_SA(0, 1), a2 + hstep, voffA);
            PG8_WAIT_L(8); PG8_BAR; PG8_WAIT_L(0); PG8_MMA(0, 0, At, B0); PG8_BAR; PG8_SCHED;
            PG8_LDB(B1, 1, 1); PG8_STAGE(PG8_SB(1, 0), b3, voffB);
            PG8_BAR; PG8_WAIT_L(0); PG8_MMA(0, 1, At, B1); PG8_BAR;
            PG8_LDA(At, 1, 1); PG8_STAGE(PG8_SA(1, 0), a3, voffA);
            PG8_BAR; PG8_WAIT_L(0); PG8_MMA(1, 0, At, B0); PG8_BAR; PG8_SCHED;
            PG8_STAGE(PG8_SB(1, 1), b3 + hstep, voffB);
            PG8_WAIT_V(6); PG8_BAR; PG8_MMA(1, 1, At, B1); PG8_BAR;
            }
        }
        if constexpr (ALIGN_EPI) { if (wr == 0) PG8_BAR; }
        if constexpr (!Epi::AFTER_DRAIN) { E(acc, cur, wr, wc, fr, fq); S.done(cur); __builtin_amdgcn_s_waitcnt(0x0F70);   }
        if (!has_next) break;
#pragma unroll
        for (int a = 0; a < 2; ++a)
#pragma unroll
            for (int b = 0; b < 2; ++b)
#pragma unroll
                for (int m = 0; m < 4; ++m)
#pragma unroll
                    for (int n = 0; n < 2; ++n) acc[a][b][m][n] = (f32x4){0.f, 0.f, 0.f, 0.f};
        cur = nxt; cA = nA; cB = nB; ++ui;
        if constexpr (ALIGN_EPI) { if (wr == 1) PG8_BAR; }
    }
    PG8_WAIT_V(0);
    if constexpr (!ALIGN_EPI) { if (wr == 0) PG8_BAR; }
    PG8_BAR;
    if constexpr (Epi::AFTER_DRAIN) { E.fused(acc, cur, wr, wc, fr, fq, lds, wid, lane); S.done(cur); }
#undef PG8_SA
#undef PG8_SB
#undef PG8_STAGE
#undef PG8_LDA
#undef PG8_LDB
#undef PG8_MMA
#undef PG8_WAIT_V
#undef PG8_WAIT_L
#undef PG8_BAR
#undef PG8_SCHED
}
}
#include <hip/hip_bf16.h>
#include <cmath>
namespace attn_body {
using bf16=__hip_bfloat16;
using bf16x8=__attribute__((ext_vector_type(8)))short;
using s16x4=__attribute__((ext_vector_type(4)))short;
using f32x16=__attribute__((ext_vector_type(16)))float;
using u32x4=__attribute__((ext_vector_type(4)))unsigned;
constexpr int D=64,QP=512,KP=128,OP=1024;
constexpr int NW=8,QBLK=32,QB=QBLK*NW,KVBLK=64;
constexpr int ATTN_UNIT_ROWS=QB;
__device__ __forceinline__ int crow(int r,int hi){return (r&3)+8*(r>>2)+4*hi;}
#define SBAR() __builtin_amdgcn_sched_barrier(0)
__device__ __forceinline__ void cmask(f32x16&p0,f32x16&p1,int jb,int qrel,int hi){
  const float NEG=-INFINITY; int kb=64*jb+4*hi;
  #pragma unroll
  for(int r=0;r<16;++r){int kv=kb+(r&3)+8*(r>>2); if(kv>qrel)p0[r]=NEG; if(kv+32>qrel)p1[r]=NEG;}
}

constexpr int NSLOT=3, SLOTB=8192;
constexpr int LDS_K=0, LDS_V=NSLOT*SLOTB, LDS_WS=2*NSLOT*SLOTB, LDS_OST=LDS_WS+NW*64*4, LDS_BYTES=LDS_OST+NW*4096;
constexpr float C2=0.125f*1.4426950408889634f;
__device__ __forceinline__ void glds16(const void*gsrc,unsigned lds_dst){unsigned keep;
  asm volatile("s_mov_b32 %0, m0\n\ts_mov_b32 m0, %2\n\ts_nop 0\n\tglobal_load_lds_dwordx4 %1, off\n\ts_mov_b32 m0, %0":"=&s"(keep):"v"(gsrc),"s"(lds_dst):"memory");}
__device__ __forceinline__ float max3f(float a,float b,float c){float r;asm("v_max3_f32 %0, %1, %2, %3":"=v"(r):"v"(a),"v"(b),"v"(c));return r;}
__device__ __forceinline__ float max2f(float a,float b){float r;asm("v_max_f32_e32 %0, %1, %2":"=v"(r):"v"(a),"v"(b));return r;}
__device__ __forceinline__ float fadd_s(float a,float b){float r;asm("v_add_f32_e32 %0, %1, %2":"=v"(r):"v"(a),"v"(b));return r;}
__device__ __forceinline__ float fsub_s(float a,float b){float r;asm("v_sub_f32_e32 %0, %1, %2":"=v"(r):"v"(a),"v"(b));return r;}
typedef float f32x2_t __attribute__((ext_vector_type(2))); typedef __bf16 bf16x2_t __attribute__((ext_vector_type(2)));
__device__ __forceinline__ unsigned cvtpk_s(float lo,float hi){f32x2_t v={lo,hi};bf16x2_t b=__builtin_convertvector(v,bf16x2_t);return __builtin_bit_cast(unsigned,b);}
#define WAIT_BAR(N) asm volatile("s_waitcnt vmcnt(" #N ") lgkmcnt(0)\n\ts_barrier":::"memory")

__device__ __forceinline__ void qkt(f32x16&p0,f32x16&p1,const char*Kslot,const bf16x8*qr,const f32x16&negm,int r32,int hi){
  const char*kb=Kslot+hi*1024+r32*16;
  #pragma unroll
  for(int d0=0;d0<4;++d0){
    const bf16x8 b0=*reinterpret_cast<const bf16x8*>(kb+d0*2048);
    const bf16x8 b1=*reinterpret_cast<const bf16x8*>(kb+d0*2048+512);
    if(d0==0){p0=__builtin_amdgcn_mfma_f32_32x32x16_bf16(b0,qr[0],negm,0,0,0);p1=__builtin_amdgcn_mfma_f32_32x32x16_bf16(b1,qr[0],negm,0,0,0);}
    else{p0=__builtin_amdgcn_mfma_f32_32x32x16_bf16(b0,qr[d0],p0,0,0,0);p1=__builtin_amdgcn_mfma_f32_32x32x16_bf16(b1,qr[d0],p1,0,0,0);}}
}
typedef __attribute__((address_space(3))) const char* lds_cptr;
typedef short v4i16_t __attribute__((ext_vector_type(4)));
__device__ __forceinline__ void kload8(bf16x8*kf,lds_cptr kp){
  kf[0]=*(const __attribute__((address_space(3))) bf16x8*)(kp);      kf[1]=*(const __attribute__((address_space(3))) bf16x8*)(kp+512);
  kf[2]=*(const __attribute__((address_space(3))) bf16x8*)(kp+2048); kf[3]=*(const __attribute__((address_space(3))) bf16x8*)(kp+2560);
  kf[4]=*(const __attribute__((address_space(3))) bf16x8*)(kp+4096); kf[5]=*(const __attribute__((address_space(3))) bf16x8*)(kp+4608);
  kf[6]=*(const __attribute__((address_space(3))) bf16x8*)(kp+6144); kf[7]=*(const __attribute__((address_space(3))) bf16x8*)(kp+6656);
}
__device__ __forceinline__ void kload2(bf16x8*kf,lds_cptr kp,int j){ kf[2*j]=*(const __attribute__((address_space(3))) bf16x8*)(kp+j*2048); kf[2*j+1]=*(const __attribute__((address_space(3))) bf16x8*)(kp+j*2048+512); }
__device__ __forceinline__ s16x4 vtr(lds_cptr p){ return __builtin_bit_cast(s16x4,__builtin_amdgcn_ds_read_tr16_b64_v4i16((__attribute__((address_space(3))) v4i16_t*)p)); }
__device__ __forceinline__ float rowmax(const f32x16&p0,const f32x16&p1){
  float a=max3f(p0[0],p0[1],p1[0]),b=max3f(p0[2],p0[3],p1[1]);a=max3f(a,p1[2],p1[3]);
  #pragma unroll
  for(int r=4;r<16;r+=4){a=max3f(a,p0[r],p0[r+1]);b=max3f(b,p0[r+2],p0[r+3]);a=max3f(a,p1[r],p1[r+1]);b=max3f(b,p1[r+2],p1[r+3]);}
  const float m=max2f(a,b);
  auto rr=__builtin_amdgcn_permlane32_swap(__float_as_uint(m),__float_as_uint(m),false,false);
  return max2f(__uint_as_float(rr[0]),__uint_as_float(rr[1]));
}
__device__ __forceinline__ void pv(f32x16*o,int vb,bf16x8 pa0,bf16x8 pa1,bf16x8 pa2,bf16x8 pa3){
  #pragma unroll
  for(int d0=0;d0<2;++d0){s16x4 lo[4],hi[4];
    #pragma unroll
    for(int ks=0;ks<4;++ks){
      asm volatile("ds_read_b64_tr_b16 %0,%1 offset:%c2":"=&v"(lo[ks]):"v"(vb),"i"(d0*4096+ks*1024):"memory");
      asm volatile("ds_read_b64_tr_b16 %0,%1 offset:%c2":"=&v"(hi[ks]):"v"(vb),"i"(d0*4096+ks*1024+512):"memory");}
    asm volatile("s_waitcnt lgkmcnt(0)":::"memory");SBAR();
    #define PK(k) (bf16x8){lo[k][0],lo[k][1],lo[k][2],lo[k][3],hi[k][0],hi[k][1],hi[k][2],hi[k][3]}
    o[d0]=__builtin_amdgcn_mfma_f32_32x32x16_bf16(pa0,PK(0),o[d0],0,0,0);
    o[d0]=__builtin_amdgcn_mfma_f32_32x32x16_bf16(pa1,PK(1),o[d0],0,0,0);
    o[d0]=__builtin_amdgcn_mfma_f32_32x32x16_bf16(pa2,PK(2),o[d0],0,0,0);
    o[d0]=__builtin_amdgcn_mfma_f32_32x32x16_bf16(pa3,PK(3),o[d0],0,0,0);
    #undef PK
  }
}

#ifndef ATTN_STORE16
#define ATTN_STORE16(p,v) (*(u32x4*)(p)=(v))
#endif
template<int THRL,bool NOMAX> __device__ __forceinline__ void attn_unit(long qrow0,int h,long kvrow0,int NT,const bf16*Q,const bf16*__restrict__ K,const bf16*__restrict__ V,bf16*O,char*shm){
  int tid_=threadIdx.x; asm volatile("":"+v"(tid_)); const int tid=tid_,lane=tid&63,r32=lane&31,hi=lane>>5; const int wid=__builtin_amdgcn_readfirstlane(tid>>6);
  const bf16*Qw=Q+(qrow0+wid*QBLK)*QP+h*D;
  const bf16*Kh=K+kvrow0*KP+(h>>2)*D,*Vh=V+kvrow0*KP+(h>>2)*D;
  const unsigned lds0=(unsigned)(uintptr_t)shm;
  float*wsf=(float*)(shm+LDS_WS)+wid*64;
  const bf16*ksrc=Kh+(long)lane*KP+wid*8;
  const bf16*vsrc=Vh+(long)(16*(wid&3)+(lane>>2))*KP+(wid>>2)*32+(lane&3)*8;
  const unsigned kdst=lds0+LDS_K+wid*1024, vdst=lds0+LDS_V+wid*1024;
  #define DMA_K(t,slot) glds16(ksrc+(long)(t)*KVBLK*KP,(unsigned)__builtin_amdgcn_readfirstlane(kdst+(slot)))
  #define DMA_V(t,slot) glds16(vsrc+(long)(t)*KVBLK*KP,(unsigned)__builtin_amdgcn_readfirstlane(vdst+(slot)))
  const int vb0=(int)(lds0+LDS_V)+((lane>>4)&1)*32+(lane&3)*8+(4*hi+((lane&15)>>2))*64;
  const char*Kbase=shm+LDS_K; bf16x8 kf[8];
  const lds_cptr shm3=(lds_cptr)shm; const lds_cptr kp0=shm3+LDS_K+hi*1024+r32*16; const lds_cptr vp0=shm3+LDS_V+((lane>>4)&1)*32+(lane&3)*8+(4*hi+((lane&15)>>2))*64;
  DMA_K(0,0);DMA_V(0,0);DMA_K(1,SLOTB);
  bf16x8 qr[4];
  #pragma unroll
  for(int d0=0;d0<4;++d0)qr[d0]=*reinterpret_cast<const bf16x8*>(&Qw[(long)r32*QP+d0*16+hi*8]);
  float mhat=0.f,l_reg=0.f;f32x16 o[2];o[0]=f32x16{};o[1]=f32x16{};f32x16 negm=f32x16{};asm volatile("":"+v"(negm));
  #define CMASK(P0,P1,t) do{}while(0)
  bool resc=false;
  #define START(P0,P1) do{ resc=false; if constexpr(!NOMAX) \
    { const float rm=rowmax(P0,P1); const float dl=rm; mhat=fadd_s(mhat,dl); \
      _Pragma("unroll") for(int r=0;r<16;++r){P0[r]=fsub_s(P0[r],dl);P1[r]=fsub_s(P1[r],dl);} \
      _Pragma("unroll") for(int r=0;r<16;++r)negm[r]=-mhat; asm volatile("":"+v"(negm)); } \
    _Pragma("unroll") for(int r=0;r<16;++r)P0[r]=__builtin_amdgcn_exp2f(P0[r]); }while(0)
  #define RESC() do{ if constexpr(!NOMAX) if(resc){ asm volatile("s_waitcnt lgkmcnt(0)":::"memory"); \
      _Pragma("unroll") for(int d_=0;d_<2;++d_) _Pragma("unroll") for(int r=0;r<16;++r)o[d_][r]*=wsf[crow(r,hi)]; } }while(0)
  f32x16 pA0,pA1,pB0,pB1;
  int sl_prev=0,sl_cur=0,sl_next=SLOTB;
  #define ROT() do{sl_prev=sl_cur;sl_cur=sl_next;sl_next=(sl_next==(NSLOT-1)*SLOTB)?0:sl_next+SLOTB;}while(0)
  DMA_K(2,2*SLOTB);
  WAIT_BAR(3);
  qkt(pA0,pA1,Kbase,qr,negm,r32,hi);asm volatile("s_nop 15\n\ts_nop 7":"+v"(pA0),"+v"(pA1));CMASK(pA0,pA1,0);
  START(pA0,pA1);
  _Pragma("unroll") for(int r=0;r<16;++r)pA1[r]=__builtin_amdgcn_exp2f(pA1[r]);
  WAIT_BAR(0);
  DMA_K(3,0);DMA_V(1,SLOTB);
  ROT();
  kload8(kf,kp0+sl_cur);
  WAIT_BAR(2);
  s16x4 vlo[8],vhi[8]; u32x4 pw0,pw1,pw2,pw3;
  #define PKW(P,B) cvtpk_s(P[B],P[B+1])
  #define PAF(k) __builtin_bit_cast(bf16x8,pw##k)
  #define VFR(i) (bf16x8){vlo[i][0],vlo[i][1],vlo[i][2],vlo[i][3],vhi[i][0],vhi[i][1],vhi[i][2],vhi[i][3]}
  #define PIN(x) asm volatile("":"+v"(x))
  #define MX3(a,b,c) __builtin_fmaxf(__builtin_fmaxf((a),(b)),(c))
  #define GAPA(MF,A0,A1,A2,A3,W0,W1,PW) do{ MF; sacc+=A0; sacc+=A1; sacc+=A2; sacc+=A3; PIN(sacc); W0; W1; PIN(PW); SBAR(); }while(0)
  #define EX(v) __builtin_amdgcn_exp2f(v)
  #define GAPB(MF,X,B) do{ MF; X[B]=EX(X[B]); X[B+1]=EX(X[B+1]); X[B+2]=EX(X[B+2]); X[B+3]=EX(X[B+3]); PIN(X); SBAR(); }while(0)
  #define VRD(i) do{ vlo[i]=vtr(vp_+(((i)>>2)*4096+((i)&3)*1024)); vhi[i]=vtr(vp_+(((i)>>2)*4096+((i)&3)*1024+512)); }while(0)
  #define KRD(G,j) do{ if(G){ kload2(kf,kp0+sl_next,j); SBAR(); } }while(0)
  #define STEP(C0,C1,P0,P1,t,GK,GV,GL) do{ SBAR(); \
    const lds_cptr vp_=vp0+sl_prev; \
    VRD(0); SBAR(); float sacc=(P0[0]+P0[1]); \
    GAPA(C0=__builtin_amdgcn_mfma_f32_32x32x16_bf16(kf[0],qr[0],negm,0,0,0), P0[2],P0[3],P0[4],P0[5],     pw0[0]=PKW(P0,0), pw0[1]=PKW(P0,2), pw0); \
    VRD(4); SBAR(); GAPA(C1=__builtin_amdgcn_mfma_f32_32x32x16_bf16(kf[1],qr[0],negm,0,0,0), P0[6],P0[7],P0[8],P0[9],     pw0[2]=PKW(P0,4), pw0[3]=PKW(P0,6), pw0); \
    VRD(1); SBAR(); GAPA(C0=__builtin_amdgcn_mfma_f32_32x32x16_bf16(kf[2],qr[1],C0,0,0,0),   P0[10],P0[11],P0[12],P0[13], pw1[0]=PKW(P0,8), pw1[1]=PKW(P0,10), pw1); \
    VRD(5); SBAR(); GAPA(C1=__builtin_amdgcn_mfma_f32_32x32x16_bf16(kf[3],qr[1],C1,0,0,0),   P0[14],P0[15],P1[0],P1[1],   pw1[2]=PKW(P0,12),pw1[3]=PKW(P0,14), pw1); \
    VRD(2); SBAR(); GAPA(C0=__builtin_amdgcn_mfma_f32_32x32x16_bf16(kf[4],qr[2],C0,0,0,0),   P1[2],P1[3],P1[4],P1[5],     pw2[0]=PKW(P1,0), pw2[1]=PKW(P1,2), pw2); \
    VRD(6); SBAR(); GAPA(C1=__builtin_amdgcn_mfma_f32_32x32x16_bf16(kf[5],qr[2],C1,0,0,0),   P1[6],P1[7],P1[8],P1[9],     pw2[2]=PKW(P1,4), pw2[3]=PKW(P1,6), pw2); \
    VRD(3); SBAR(); GAPA(C0=__builtin_amdgcn_mfma_f32_32x32x16_bf16(kf[6],qr[3],C0,0,0,0),   P1[10],P1[11],P1[12],P1[13], pw3[0]=PKW(P1,8), pw3[1]=PKW(P1,10), pw3); \
    VRD(7); SBAR(); GAPA(C1=__builtin_amdgcn_mfma_f32_32x32x16_bf16(kf[7],qr[3],C1,0,0,0),   P1[14],P1[15],0.f,0.f,       pw3[2]=PKW(P1,12),pw3[3]=PKW(P1,14), pw3); \
    l_reg+=sacc; \
    if(GK){DMA_K((t)+3,sl_cur);} if(GV){DMA_V((t)+1,sl_next);} \
    CMASK(C0,C1,t); \
    if constexpr(!NOMAX){ float a=MX3(C0[0],C0[1],C1[0]),b=MX3(C0[2],C0[3],C1[1]); a=MX3(a,C1[2],C1[3]); \
      _Pragma("unroll") for(int r=4;r<16;r+=4){a=MX3(a,C0[r],C0[r+1]);b=MX3(b,C0[r+2],C0[r+3]);a=MX3(a,C1[r],C1[r+1]);b=MX3(b,C1[r+2],C1[r+3]);} \
      float rm=__builtin_fmaxf(a,b); { auto rr=__builtin_amdgcn_permlane32_swap(__float_as_uint(rm),__float_as_uint(rm),false,false); rm=__builtin_fmaxf(__uint_as_float(rr[0]),__uint_as_float(rr[1])); } \
      resc=false; \
      if(__builtin_expect(__any(rm>(float)THRL),0)){ const float dl=__builtin_fmaxf(rm,0.f); mhat+=dl; \
        _Pragma("unroll") for(int r=0;r<16;++r){C0[r]-=dl;C1[r]-=dl;} \
        _Pragma("unroll") for(int r=0;r<16;++r)negm[r]=-mhat; asm volatile("":"+v"(negm)); \
        const float f=__builtin_amdgcn_exp2f(-dl); l_reg*=f; if(hi==0)wsf[r32]=f; resc=true; } } \
    SBAR(); \
    GAPB(o[0]=__builtin_amdgcn_mfma_f32_32x32x16_bf16(PAF(0),VFR(0),o[0],0,0,0), C0,0); \
    GAPB(o[1]=__builtin_amdgcn_mfma_f32_32x32x16_bf16(PAF(0),VFR(4),o[1],0,0,0), C0,4); \
    KRD(GL,0); GAPB(o[0]=__builtin_amdgcn_mfma_f32_32x32x16_bf16(PAF(1),VFR(1),o[0],0,0,0), C0,8); \
    KRD(GL,1); GAPB(o[1]=__builtin_amdgcn_mfma_f32_32x32x16_bf16(PAF(1),VFR(5),o[1],0,0,0), C0,12); \
    KRD(GL,2); GAPB(o[0]=__builtin_amdgcn_mfma_f32_32x32x16_bf16(PAF(2),VFR(2),o[0],0,0,0), C1,0); \
    KRD(GL,3); GAPB(o[1]=__builtin_amdgcn_mfma_f32_32x32x16_bf16(PAF(2),VFR(6),o[1],0,0,0), C1,4); \
    GAPB(o[0]=__builtin_amdgcn_mfma_f32_32x32x16_bf16(PAF(3),VFR(3),o[0],0,0,0), C1,8); \
    GAPB(o[1]=__builtin_amdgcn_mfma_f32_32x32x16_bf16(PAF(3),VFR(7),o[1],0,0,0), C1,12); \
    }while(0)
  int t=1;
  #undef CMASK
  #define CMASK(P0,P1,t) do{}while(0)
  for(;t+5<NT;t+=2){
    STEP(pB0,pB1,pA0,pA1,t,true,true,true);     WAIT_BAR(2); RESC(); ROT();
    STEP(pA0,pA1,pB0,pB1,t+1,true,true,true);   WAIT_BAR(2); RESC(); ROT();
  }
  #undef CMASK
  #define CMASK(P0,P1,t) do{}while(0)
  #define ENDW(tt) do{ if((tt)+3<NT){WAIT_BAR(2);} else if((tt)+2<NT){WAIT_BAR(1);} else {WAIT_BAR(0);} }while(0)
  for(;t+1<NT;t+=2){
    STEP(pB0,pB1,pA0,pA1,t,(t+3<NT),(t+1<NT),(t+1<NT));       ENDW(t);   RESC(); ROT();
    STEP(pA0,pA1,pB0,pB1,t+1,(t+4<NT),(t+2<NT),(t+2<NT));     ENDW(t+1); RESC(); ROT();
  }
  STEP(pB0,pB1,pA0,pA1,NT-1,false,false,false); RESC();
  { float sacc=pB0[0]+pB0[1]; _Pragma("unroll") for(int r=2;r<16;++r)sacc+=pB0[r]; _Pragma("unroll") for(int r=0;r<16;++r)sacc+=pB1[r]; l_reg+=sacc;
    pw0=(u32x4){PKW(pB0,0),PKW(pB0,2),PKW(pB0,4),PKW(pB0,6)};pw1=(u32x4){PKW(pB0,8),PKW(pB0,10),PKW(pB0,12),PKW(pB0,14)};pw2=(u32x4){PKW(pB1,0),PKW(pB1,2),PKW(pB1,4),PKW(pB1,6)};pw3=(u32x4){PKW(pB1,8),PKW(pB1,10),PKW(pB1,12),PKW(pB1,14)};
    SBAR(); pv(o,vb0+sl_cur,PAF(0),PAF(1),PAF(2),PAF(3)); }
  #undef PKW
  #undef PAF
  #undef VFR
  #undef PIN
  #undef MX3
  #undef GAPA
  #undef GAPB
  #undef EX
  #undef VRD
  #undef KRD
  #undef STEP
  #undef ENDW
  {auto rr=__builtin_amdgcn_permlane32_swap(__float_as_uint(l_reg),__float_as_uint(l_reg),false,false);l_reg=__uint_as_float(rr[0])+__uint_as_float(rr[1]);}
  if(hi==0)wsf[32+r32]=l_reg;asm volatile("s_waitcnt lgkmcnt(0)":::"memory");
  float rli[16];
  #pragma unroll
  for(int r=0;r<16;++r)rli[r]=__builtin_amdgcn_rcpf(wsf[32+crow(r,hi)]);
  bf16*Ow=O+(qrow0+wid*QBLK)*OP+h*D;
  { bf16*stg=(bf16*)(shm+LDS_OST)+wid*2048;
    #pragma unroll
    for(int r=0;r<16;++r){const int orow=crow(r,hi);
      #pragma unroll
      for(int d0=0;d0<2;++d0)stg[orow*64+d0*32+r32]=__float2bfloat16(o[d0][r]*rli[r]);}
    asm volatile("s_waitcnt lgkmcnt(0)":::"memory");
    #pragma unroll
    for(int i=0;i<4;++i){const int row=i*8+(lane>>3),ch=lane&7; const u32x4 v=*(const u32x4*)(stg+row*64+ch*8); ATTN_STORE16(Ow+(long)row*OP+ch*8,v);} }
  asm volatile("s_waitcnt lgkmcnt(0)\n\ts_barrier":::"memory");
  #undef DMA_K
  #undef DMA_V
  #undef CMASK
  #undef START
  #undef RESC
  #undef ROT
}
constexpr int ATTN_LDS_BYTES=LDS_BYTES;
#undef SBAR
#undef WAIT_BAR
}
#define LAS __attribute__((address_space(3)))
#define INP(i) ((const GAS float*)a.in[i])
typedef unsigned short bf16;
typedef unsigned v4u __attribute__((ext_vector_type(4)));
typedef unsigned v2u __attribute__((ext_vector_type(2)));
typedef float f32x4 __attribute__((ext_vector_type(4)));
#ifndef DUP_S
#define DUP_S -1
#endif
#ifndef DUP_ATT
#define DUP_ATT 1
#endif
#ifndef DUP_SG
#define DUP_SG 1
#endif
#ifndef TIME_S
#define TIME_S -1
#endif
#ifndef TIME_MASK
#define TIME_MASK (TIME_S == 10 ? 0x1ff : (1 << (TIME_S < 0 ? 0 : TIME_S)))
#endif
#ifndef MK_MULTI
#define MK_MULTI 0
#endif
constexpr int NWAVES = 8, NTHREADS = 512;
constexpr int DMODEL = 1024, DEPTH = 4, ML = 16384, MC = 512, MT = ML + MC;
constexpr int INW = 5120, DFF = 2816, NMODW = 6144;
constexpr int NPHASE = 1 + 8 * DEPTH;
constexpr size_t MiB = 1u << 20;
constexpr size_t WS_MOD = 0, WS_COS = 1 * MiB, WS_SIN = 2 * MiB, WS_CTX = 3 * MiB, WS_W = 6 * MiB, WS_H = 38 * MiB, WS_Q = 72 * MiB, WS_K = 89 * MiB, WS_V = 94 * MiB,
                 WS_ZA = 99 * MiB, WS_ZB = 108 * MiB, WS_ZC = 125 * MiB, WS_ZF = 134 * MiB, WS_P = 200 * MiB;
constexpr size_t P_CONV = 0, P_SG = (size_t)MT * 768 * 2, P_G = P_SG + (size_t)MT * 512 * 2, WS_END = WS_P + P_G + (size_t)MT * 3072 * 2;
constexpr size_t WS_W2 = 342 * MiB, WS_END2 = WS_W2 + 32 * MiB;
static_assert(WS_END <= WS_W2, "ws map 3");
constexpr size_t WO_IN = 0, WO_A = WO_IN + 5120 * 1024  , WO_O = WO_A + 1024 * 1024, WO_13 = WO_O + 1024 * 1024,
                 WO_2 = WO_13 + 5632 * 1024, WO_END = WO_2 + 1024 * 2816;
static_assert(WO_END * 2 <= 32 * MiB && (size_t)MT * 1024 * 2 <= 34 * MiB && (size_t)MT * 1024 * 4 <= 66 * MiB && (size_t)MT * 2816 * 2 <= WS_END - WS_P, "ws map");
constexpr int LDS_BYTES = 147456;

__device__ __forceinline__ unsigned f2bf(float f) { unsigned u = __builtin_bit_cast(unsigned, f); return (u + 0x7fffu + ((u >> 16) & 1u)) >> 16; }
__device__ __forceinline__ unsigned pk2(float lo, float hi) { unsigned r; asm("v_cvt_pk_bf16_f32 %0, %1, %2" : "=v"(r) : "v"(lo), "v"(hi)); return r; }
__device__ __forceinline__ float bflo(unsigned w) { return __uint_as_float(w << 16); }
__device__ __forceinline__ float bfhi(unsigned w) { return __uint_as_float(w & 0xffff0000u); }
__device__ __forceinline__ float wave_sum(float v) {
#pragma unroll
    for (int o = 1; o < 64; o <<= 1) v += __shfl_xor(v, o);
    return v;
}
__device__ __forceinline__ int inproj_src_col(int nn) {
    if (nn >= 256 && nn < 768) { const int q = nn - 256, tile = q >> 8, p = q & 255; return 256 + (p >> 7) * 256 + tile * 128 + (p & 127); }
    if (nn < 768 || nn >= 1536) return nn;
    const int q = nn - 768, tile = q >> 8, p = q & 255, bj = p >> 7, wc = (p >> 5) & 3, fq = (p >> 3) & 3, n = (p >> 2) & 1, j = p & 3;
    return 768 + tile * 256 + wc * 64 + 32 * bj + 16 * n + 4 * fq + j;
}
template <int MODE> __device__ __forceinline__ void transpose_item(const GAS float* W, const GAS float* W3, int K, int N, GAS bf16* WT, LAS float* scr, int item, int nblk, int lane, int dpitch = 0, int koff = 0) {
    if (dpitch == 0) dpitch = K;
    const int kb = item / nblk, nb = item % nblk, k0 = 64 * kb, n0 = 32 * nb, nn = n0 + 4 * (lane & 7);
    const GAS float* src;
    if (MODE == 0) src = W + nn;
    else if (MODE == 1) src = W + inproj_src_col(nn);
    else { const int tile = nn >> 8, p = nn & 255; src = ((p >> 7) ? W3 : W) + 128 * tile + (p & 127); }
#pragma unroll
    for (int i = 0; i < 8; ++i) { const int kk = 8 * i + (lane >> 3); const f32x4 v = *(const GAS f32x4*)(src + (size_t)(k0 + kk) * N);
        LAS float* d = scr + kk * 33 + 4 * (lane & 7); d[0] = v[0]; d[1] = v[1]; d[2] = v[2]; d[3] = v[3]; }
    asm volatile("s_waitcnt lgkmcnt(0)" ::: "memory");
    const int c = lane & 7;
#pragma unroll
    for (int j = 0; j < 4; ++j) { const int n = (lane >> 3) + 8 * j; const LAS float* s = scr + (8 * c) * 33 + n;
        v4u o; o.x = pk2(s[0 * 33], s[1 * 33]); o.y = pk2(s[2 * 33], s[3 * 33]); o.z = pk2(s[4 * 33], s[5 * 33]); o.w = pk2(s[6 * 33], s[7 * 33]);
        *(GAS v4u*)(WT + (size_t)(n0 + n) * dpitch + koff + k0 + 8 * c) = o; }
    asm volatile("s_waitcnt lgkmcnt(0)" ::: "memory");
}
typedef GAS unsigned gu32;
#define RLX_AGENT __ATOMIC_RELAXED, __HIP_MEMORY_SCOPE_AGENT
#define XB_TMO      128
#define XB_XCNT(j)  (256  + 64 * (j))
#define XB_XSUB(j)  (1280 + 64 * (j))
#define XB_XGEN(j)  (2304 + 64 * (j))
#define XB_TOP      3328
#define XB_TOPGEN   3392
#define XCD_BAR_WORDS 3456
#define XB_SPIN_CAP (1u << 18)

__device__ __forceinline__ unsigned xb_ld(unsigned* p)              { return __hip_atomic_load(p, __ATOMIC_RELAXED, __HIP_MEMORY_SCOPE_AGENT); }
__device__ __forceinline__ unsigned xb_add(unsigned* p, unsigned v) { return __hip_atomic_fetch_add(p, v, __ATOMIC_RELAXED, __HIP_MEMORY_SCOPE_AGENT); }
__device__ __forceinline__ unsigned xb_xcc_id() { return (unsigned)__builtin_amdgcn_s_getreg((3 << 11) | 20) & 0xFu; }
#define XB_SPIN(cond, bar) do { unsigned _sp = 0; while (cond) { __builtin_amdgcn_s_sleep(1); \
    if ((++_sp & 255u) == 0u) { if (xb_ld(&(bar)[XB_TMO])) break; if (_sp > XB_SPIN_CAP) { atomicAdd(&(bar)[XB_TMO], 1u); break; } } } } while (0)

struct XcdBarrier {
    unsigned* bar; unsigned x;
    volatile LAS unsigned* st;
};

__device__ __forceinline__ XcdBarrier xcd_barrier_post(unsigned* bar, volatile LAS unsigned* st) {
    XcdBarrier b; b.bar = bar; b.x = xb_xcc_id(); b.st = st;
    if (threadIdx.x == 0) (void)xb_add(&bar[XB_XCNT(b.x)], 1u);
    return b;
}
__device__ __forceinline__ void xcd_barrier_complete(unsigned* bar, unsigned x, unsigned& nloc, unsigned& nx) {
    const unsigned G = gridDim.x * gridDim.y * gridDim.z;
    unsigned sum, cnt, mine, sp = 0u;
    for (;;) {
        sum = 0u; cnt = 0u; mine = 0u;
#pragma unroll
        for (unsigned j = 0; j < 16; ++j) { const unsigned c = xb_ld(&bar[XB_XCNT(j)]); sum += c; cnt += (c > 0u) ? 1u : 0u; mine = (j == x) ? c : mine; }
        if (sum == G) break;
        __builtin_amdgcn_s_sleep(1);
        if ((++sp & 255u) == 0u) { if (xb_ld(&bar[XB_TMO])) break; if (sp > XB_SPIN_CAP) { atomicAdd(&bar[XB_TMO], 1u); break; } }
    }
    nloc = mine > 0u ? mine : 1u; nx = cnt > 0u ? cnt : 1u;
}

__device__ __forceinline__ void xcd_barrier(const XcdBarrier& b) {
    asm volatile("s_waitcnt vmcnt(0)" ::: "memory");
    __syncthreads();
    if (threadIdx.x == 0) {
        unsigned* bar = b.bar;
        __builtin_amdgcn_s_waitcnt(0);
        unsigned nloc = b.st[0], nx = b.st[1];
        if (nloc == 0u) { xcd_barrier_complete(bar, b.x, nloc, nx); b.st[0] = nloc; b.st[1] = nx; }
        const unsigned old = xb_add(&bar[XB_XSUB(b.x)], 1u);
        const unsigned gen = old / nloc;
        if (old + 1u == (gen + 1u) * nloc) {
            __builtin_amdgcn_fence(__ATOMIC_RELEASE, "agent");
            asm volatile("s_waitcnt vmcnt(0)" ::: "memory");
            const unsigned og = xb_add(&bar[XB_TOP], 1u);
            const unsigned tg = og / nx;
            if (og + 1u == (tg + 1u) * nx) xb_add(&bar[XB_TOPGEN], 1u);
            else XB_SPIN(xb_ld(&bar[XB_TOPGEN]) == tg, bar);
            __builtin_amdgcn_fence(__ATOMIC_ACQUIRE, "agent");
            xb_add(&bar[XB_XGEN(b.x)], 1u);
            asm volatile("s_waitcnt vmcnt(0)" ::: "memory");
        } else {
            XB_SPIN(xb_ld(&bar[XB_XGEN(b.x)]) == gen, bar);
            __builtin_amdgcn_fence(__ATOMIC_ACQUIRE, "agent");
            asm volatile("s_waitcnt vmcnt(0)" ::: "memory");
        }
    }
    __syncthreads();
}

constexpr size_t WS_BAR = 512 * 1024, BAR_BYTES = 16384 + 16384 + 4096;
constexpr size_t WS_XCNT = WS_BAR + 16384, WS_XCNTC = WS_BAR + 32768  , WS_XBUF = 640 * 1024, WS_XBUFC = 896 * 1024  ;
static_assert(WS_XBUFC + 512 * 32 * 4 <= MiB, "ws map 5");
static_assert(WS_XBUF + (size_t)ML * 16 <= MiB, "ws map 4");
constexpr int LDS_BARST = 131072 + 64;

typedef short cbf16x8 __attribute__((ext_vector_type(8)));
typedef float cf32x16 __attribute__((ext_vector_type(16)));
__device__ __forceinline__ cf32x16 ctx_seg(const GAS bf16* Arow, const GAS bf16* Brow, int kbeg, int kend) {
    cf32x16 acc; for (int r = 0; r < 16; ++r) acc[r] = 0.f;
#pragma unroll 8
    for (int k = kbeg; k < kend; k += 16) { const cbf16x8 av = *(const GAS cbf16x8*)(Arow + k), bv = *(const GAS cbf16x8*)(Brow + k);
        acc = __builtin_amdgcn_mfma_f32_32x32x16_bf16(bv, av, acc, 0, 0, 0); }
    return acc;
}
__device__ __forceinline__ void ctx_reduce(cf32x16& tot, LAS float* red, int wave, int lane) {
    const int q = wave & 3, tsel = wave >> 2;
    LAS float* mine = red + ((tsel * 4 + q) * 64 + lane) * 16;
    if (q != 0) {
#pragma unroll
        for (int r = 0; r < 16; r += 4) *(LAS f32x4*)(mine + r) = (f32x4){tot[r], tot[r + 1], tot[r + 2], tot[r + 3]}; }
    __syncthreads();
    if (q == 0) {
#pragma unroll
        for (int p = 1; p < 4; ++p)
#pragma unroll
            for (int r = 0; r < 16; r += 4) { const f32x4 v = *(const LAS f32x4*)(red + ((tsel * 4 + p) * 64 + lane) * 16 + r); tot[r] += v[0]; tot[r + 1] += v[1]; tot[r + 2] += v[2]; tot[r + 3] += v[3]; } }
    __syncthreads();
}
struct Args { const float* in[22]; float* out; unsigned char* ws; int ph_lo, ph_hi; };

__global__ void __launch_bounds__(NTHREADS, 2) fwd_kernel(Args a) {
    extern __shared__ __attribute__((aligned(16))) unsigned char lds[];
#define PTRS() \
    int tid_ = threadIdx.x; asm volatile("" : "+v"(tid_)); const int tid = tid_, lane = tid & 63, wave = __builtin_amdgcn_readfirstlane(tid >> 6); \
    int bx = blockIdx.x, G = gridDim.x; asm volatile("" : "+s"(bx), "+s"(G)); const int vcu = (G % 8 == 0) ? (bx % 8) * (G / 8) + bx / 8 : bx; (void)vcu; (void)tid; \
    const int gw = bx * NWAVES + wave, NGW = G * NWAVES; (void)gw; (void)NGW; (void)lane; \
    GAS unsigned char* wsr_ = (GAS unsigned char*)a.ws; asm volatile("" : "+s"(wsr_)); GAS unsigned char* const ws = (GAS unsigned char*)wsr_; \
    GAS float* const modv = (GAS float*)(ws + WS_MOD); GAS float* const cosT = (GAS float*)(ws + WS_COS); GAS float* const sinT = (GAS float*)(ws + WS_SIN); GAS float* const xctx = (GAS float*)(ws + WS_CTX); \
    GAS bf16* const Wb = (GAS bf16*)(ws + ((((ph - 1) >> 3) & 1) ? WS_W2 : WS_W)); GAS bf16* const Wn = (GAS bf16*)(ws + ((((ph - 1) >> 3) & 1) ? WS_W : WS_W2)); (void)Wn; GAS bf16* const H = (GAS bf16*)(ws + WS_H); GAS bf16* const Qb = (GAS bf16*)(ws + WS_Q); GAS bf16* const Kb = (GAS bf16*)(ws + WS_K); GAS bf16* const Vb = (GAS bf16*)(ws + WS_V); \
    GAS bf16* const Zcat = (GAS bf16*)(ws + WS_ZA);      GAS float* const ZF = (GAS float*)(ws + WS_ZF); \
    GAS bf16* const PCONV = (GAS bf16*)(ws + WS_P + P_CONV); GAS bf16* const PSG = (GAS bf16*)(ws + WS_P + P_SG); GAS bf16* const PG = (GAS bf16*)(ws + WS_P + P_G); GAS bf16* const HFF = (GAS bf16*)(ws + WS_P); \
    GAS bf16* const Zb = H; GAS float* const xlat = (GAS float*)a.out; LAS unsigned char* const ldsl = (LAS unsigned char*)lds; \
    (void)modv; (void)cosT; (void)sinT; (void)xctx; (void)Wb; (void)Qb; (void)Kb; (void)Vb; (void)Zcat; (void)ZF; (void)PCONV; (void)PSG; (void)PG; (void)HFF; (void)Zb; (void)xlat; (void)ldsl; \
    const int l = (ph - 1) >> 3; const bool last = (l == DEPTH - 1); const GAS float* const modl = modv + (size_t)l * 3 * NMODW; const int Mrows = last ? ML : MT; (void)modl; (void)Mrows; (void)last;

#define CONVERT_WEIGHTS(l, Wd, gw0_, ngw_) do { \
        LAS float* scr = (LAS float*)ldsl + wave * (64 * 33); \
        for (int it = (gw0_); it < 7808; it += (ngw_)) { int r = it; \
            if (r < 2560) { transpose_item<1>(INP(7) + (size_t)(l) * 1024 * INW, nullptr, 1024, INW, (Wd) + WO_IN, scr, r, 160, lane); continue; } r -= 2560; \
            if (r < 128) { transpose_item<0>(INP(14) + (size_t)(l) * 256 * 1024, nullptr, 256, 1024, (Wd) + WO_A, scr, r, 32, lane, 1024, 0); continue; } r -= 128; \
            if (r < 256) { transpose_item<0>(INP(15) + (size_t)(l) * 512 * 1024, nullptr, 512, 1024, (Wd) + WO_A, scr, r, 32, lane, 1024, 256); continue; } r -= 256; \
            if (r < 128) { transpose_item<0>(INP(16) + (size_t)(l) * 256 * 1024, nullptr, 256, 1024, (Wd) + WO_A, scr, r, 32, lane, 1024, 768); continue; } r -= 128; \
            if (r < 512) { transpose_item<0>(INP(17) + (size_t)(l) * 1024 * 1024, nullptr, 1024, 1024, (Wd) + WO_O, scr, r, 32, lane); continue; } r -= 512; \
            if (r < 2816) { transpose_item<2>(INP(19) + (size_t)(l) * 1024 * DFF, INP(20) + (size_t)(l) * 1024 * DFF, 1024, DFF, (Wd) + WO_13, scr, r, 176, lane); continue; } r -= 2816; \
            transpose_item<0>(INP(21) + (size_t)(l) * DFF * 1024, nullptr, DFF, 1024, (Wd) + WO_2, scr, r, 32, lane); } \
        __syncthreads(); } while (0)

#define NORM_ROWS(xsrc_, normw, modl, shidx, scidx, r0_, nrows) do { \
        for (int rb_ = (r0_) + gw; rb_ < (nrows); rb_ += 4 * NGW) {     \
            f32x4 v[4][4]; float ssq[4]; \
            _Pragma("unroll") for (int u_ = 0; u_ < 4; ++u_) { const int r = rb_ + u_ * NGW; ssq[u_] = 0.f; \
                if (r < (nrows)) { const GAS float* xrow = (r < ML) ? (xsrc_) + (size_t)r * 1024 : xctx + (size_t)(r - ML) * 1024; \
                    _Pragma("unroll") for (int j = 0; j < 4; ++j) v[u_][j] = *((const GAS f32x4*)xrow + lane + 64 * j); } \
                else { _Pragma("unroll") for (int j = 0; j < 4; ++j) v[u_][j] = (f32x4){0.f, 0.f, 0.f, 0.f}; } } \
            _Pragma("unroll") for (int u_ = 0; u_ < 4; ++u_) { _Pragma("unroll") for (int j = 0; j < 4; ++j) ssq[u_] += (v[u_][j][0] * v[u_][j][0] + v[u_][j][1] * v[u_][j][1]) + (v[u_][j][2] * v[u_][j][2] + v[u_][j][3] * v[u_][j][3]); } \
            _Pragma("unroll") for (int o_ = 1; o_ < 64; o_ <<= 1) { _Pragma("unroll") for (int u_ = 0; u_ < 4; ++u_) ssq[u_] += __shfl_xor(ssq[u_], o_); } \
            _Pragma("unroll") for (int u_ = 0; u_ < 4; ++u_) { const int r = rb_ + u_ * NGW; \
                if (r < (nrows)) { const int src = (r < ML) ? (r >> 13) : 2; const GAS float* shp = (modl) + src * NMODW + (shidx) * 1024; const GAS float* scp = (modl) + src * NMODW + (scidx) * 1024; \
                    const float rinv = 1.0f / sqrtf(ssq[u_] * (1.0f / 1024.0f) + 1e-6f); \
                    _Pragma("unroll") for (int j = 0; j < 4; ++j) { const f32x4 gg = *((const GAS f32x4*)(normw) + lane + 64 * j), s4 = *((const GAS f32x4*)scp + lane + 64 * j), h4 = *((const GAS f32x4*)shp + lane + 64 * j); \
                        const f32x4 o = v[u_][j] * rinv * gg * (s4 + 1.0f) + h4; v2u w; w.x = pk2(o[0], o[1]); w.y = pk2(o[2], o[3]); *((GAS v2u*)(H + (size_t)r * 1024) + lane + 64 * j) = w; } } } } } while (0)


#define CTX_MERGE() do { \
        for (int tile0 = bx * 2; tile0 < 512; tile0 += 2 * G) { const int tile = tile0 + (wave >> 2), q = wave & 3, r32 = lane & 31, hi = lane >> 5; \
            const int row0 = ML + (tile >> 5) * 32, col0 = (tile & 31) * 32; const size_t arow = (size_t)(row0 + r32); \
            cf32x16 tot; \
            { const cf32x16 sa = ctx_seg(Zcat + arow * 1024 + 8 * hi, Wb + WO_A + (size_t)(col0 + r32) * 1024 + 8 * hi, q * 64, q * 64 + 64); \
              const cf32x16 sb = ctx_seg(Zcat + arow * 1024 + 256 + 8 * hi, Wb + WO_A + (size_t)(col0 + r32) * 1024 + 256 + 8 * hi, q * 128, q * 128 + 128); \
              const cf32x16 sc = ctx_seg(Zcat + arow * 1024 + 768 + 8 * hi, Wb + WO_A + (size_t)(col0 + r32) * 1024 + 768 + 8 * hi, q * 64, q * 64 + 64); \
              _Pragma("unroll") for (int qq = 0; qq < 4; ++qq) { const GAS bf16* gp = PG + arow * 3072 + col0 + 8 * qq + 4 * hi; \
                  const v2u ga = *(const GAS v2u*)gp, gb = *(const GAS v2u*)(gp + 1024), gc = *(const GAS v2u*)(gp + 2048); \
                  tot[4 * qq + 0] = bflo(ga.x) * sa[4 * qq + 0] + bflo(gb.x) * sb[4 * qq + 0] + bflo(gc.x) * sc[4 * qq + 0]; \
                  tot[4 * qq + 1] = bfhi(ga.x) * sa[4 * qq + 1] + bfhi(gb.x) * sb[4 * qq + 1] + bfhi(gc.x) * sc[4 * qq + 1]; \
                  tot[4 * qq + 2] = bflo(ga.y) * sa[4 * qq + 2] + bflo(gb.y) * sb[4 * qq + 2] + bflo(gc.y) * sc[4 * qq + 2]; \
                  tot[4 * qq + 3] = bfhi(ga.y) * sa[4 * qq + 3] + bfhi(gb.y) * sb[4 * qq + 3] + bfhi(gc.y) * sc[4 * qq + 3]; } } \
            ctx_reduce(tot, (LAS float*)ldsl, wave, lane); \
            if (q == 0) { _Pragma("unroll") for (int qq = 0; qq < 4; ++qq) { v2u o; o.x = pk2(tot[4 * qq], tot[4 * qq + 1]); o.y = pk2(tot[4 * qq + 2], tot[4 * qq + 3]); \
                *(GAS v2u*)(Zb + arow * 1024 + col0 + 8 * qq + 4 * hi) = o; } } } } while (0)
#define CTX_RESID(Aptr, lda_, Woff, gidx_, NRM_, normw_, modn_, shidx_, scidx_, want_) do { \
        for (int tile0 = bx * 2; tile0 < 512; tile0 += 2 * G) { const int tile = tile0 + (wave >> 2), q = wave & 3, r32 = lane & 31, hi = lane >> 5; \
            const int row0 = ML + (tile >> 5) * 32, col0 = (tile & 31) * 32; const size_t arow = (size_t)(row0 + r32); \
            cf32x16 tot = ctx_seg((Aptr) + arow * (lda_) + 8 * hi, Wb + (Woff) + (size_t)(col0 + r32) * (lda_) + 8 * hi, q * ((lda_) / 4), (q + 1) * ((lda_) / 4)); \
            ctx_reduce(tot, (LAS float*)ldsl, wave, lane); \
            if (q == 0) { float ss = 0.f; \
                _Pragma("unroll") for (int qq = 0; qq < 4; ++qq) { const int c = col0 + 8 * qq + 4 * hi; const f32x4 gt = *(const GAS f32x4*)(modl + 2 * NMODW + (gidx_) * 1024 + c); \
                    GAS f32x4* xp = (GAS f32x4*)(xctx + (arow - ML) * 1024 + c); const f32x4 xn = *xp + gt * (f32x4){tot[4 * qq], tot[4 * qq + 1], tot[4 * qq + 2], tot[4 * qq + 3]}; *xp = xn; \
                    tot[4 * qq] = xn[0]; tot[4 * qq + 1] = xn[1]; tot[4 * qq + 2] = xn[2]; tot[4 * qq + 3] = xn[3]; ss += (xn[0] * xn[0] + xn[1] * xn[1]) + (xn[2] * xn[2] + xn[3] * xn[3]); } \
                if (NRM_) {     \
                    unsigned* slots = (unsigned*)(ws + WS_XBUFC); unsigned* cntc = (unsigned*)(ws + WS_XCNTC) + 64 * (tile >> 5); \
                    ss += __shfl_xor(ss, 32); \
                    if (hi == 0) __hip_atomic_store(slots + (arow - ML) * 32 + (tile & 31), __float_as_uint(ss), __ATOMIC_RELAXED, __HIP_MEMORY_SCOPE_AGENT); \
                    asm volatile("s_waitcnt vmcnt(0)" ::: "memory"); \
                    if (lane == 0) __hip_atomic_fetch_add(cntc, 1u, __ATOMIC_RELAXED, __HIP_MEMORY_SCOPE_AGENT); \
                    { unsigned sp = 0; while ((unsigned)__builtin_amdgcn_readfirstlane(__hip_atomic_load(cntc, __ATOMIC_RELAXED, __HIP_MEMORY_SCOPE_AGENT)) < (want_)) { __builtin_amdgcn_s_sleep(1); if (++sp > (1u << 22)) break; } } \
                    __builtin_amdgcn_fence(__ATOMIC_ACQUIRE, "agent"); \
                    float tsum = 0.f; \
                    _Pragma("unroll 8") for (int k = 0; k < 32; ++k) tsum += __uint_as_float(__hip_atomic_load(slots + (arow - ML) * 32 + k, __ATOMIC_RELAXED, __HIP_MEMORY_SCOPE_AGENT)); \
                    const float rinv = 1.0f / sqrtf(tsum * (1.0f / 1024.0f) + 1e-6f); \
                    _Pragma("unroll") for (int qq = 0; qq < 4; ++qq) { const int c = col0 + 8 * qq + 4 * hi; \
                        const f32x4 gm = *(const GAS f32x4*)((normw_) + c) * (*(const GAS f32x4*)((modn_) + 2 * NMODW + (scidx_) * 1024 + c) + 1.0f), sh = *(const GAS f32x4*)((modn_) + 2 * NMODW + (shidx_) * 1024 + c); \
                        const f32x4 hh = (f32x4){tot[4 * qq], tot[4 * qq + 1], tot[4 * qq + 2], tot[4 * qq + 3]} * rinv * gm + sh; \
                        v2u w; w.x = pk2(hh[0], hh[1]); w.y = pk2(hh[2], hh[3]); *(GAS v2u*)(H + arow * 1024 + c) = w; } } } } } while (0)

    const bool fused_ = (a.ph_hi - a.ph_lo) > 1;
    { volatile LAS unsigned* st_ = (volatile LAS unsigned*)((LAS unsigned char*)lds + LDS_BARST); if (threadIdx.x == 0) { st_[0] = 0u; st_[1] = 0u; } __syncthreads(); }
    XcdBarrier bar; bar.bar = (unsigned*)(a.ws + WS_BAR); bar.x = 0; bar.st = (volatile LAS unsigned*)((LAS unsigned char*)lds + LDS_BARST);
    if (fused_) bar = xcd_barrier_post((unsigned*)(a.ws + WS_BAR), (volatile LAS unsigned*)((LAS unsigned char*)lds + LDS_BARST));
    unsigned long long tacc_ = 0ull, tph_ = 0ull; (void)tph_;
#if DUP_S >= 0 && DUP_S != 9
    for (int it_ = a.ph_lo * 2; it_ < a.ph_hi * 2; ++it_) { const int ph = it_ >> 1;
      const bool dupm_ = (ph == 0 && DUP_S == 8) || (ph >= 1 && ((ph - 1) & 7) == DUP_S);
      if (!(it_ & 1) || dupm_) {
#else
    for (int ph = a.ph_lo; ph < a.ph_hi; ++ph) { const int it_ = (gridDim.x == 256 && ph >= 1 && (((ph - 1) & 7) == 5 || (((ph - 1) & 7) == 0 && ph > 1))) ? 0 : 1; if (it_) {
#endif
        if (TIME_S >= 0) { tph_ = __builtin_amdgcn_s_memrealtime(); asm volatile("s_waitcnt lgkmcnt(0)" : "+s"(tph_) :: "memory"); }
        if (ph == 0) { PTRS();
            if (bx < 192) {
                typedef float f32x2_ __attribute__((ext_vector_type(2)));
                LAS float* sil = (LAS float*)ldsl + 8 * 64 * 33; LAS float* red = sil + 3072;
                for (int i = tid; i < 3072; i += NTHREADS) { const int src = i >> 10, k = i & 1023; const float v = src < 2 ? INP(1)[src * 1024 + k] : INP(3)[k]; sil[i] = v / (1.0f + expf(-v)); }
                __syncthreads();
                const int j0 = bx * 128, l = j0 / NMODW, jj = j0 % NMODW;
                const GAS float* Wm = INP(4) + (size_t)l * 1024 * NMODW + jj + 2 * lane;
                f32x2_ a0 = {0.f, 0.f}, a1 = a0, a2 = a0;
#pragma unroll 8
                for (int k = wave * 128; k < wave * 128 + 128; ++k) { const f32x2_ w = *(const GAS f32x2_*)(Wm + (size_t)k * NMODW); a0 += w * sil[k]; a1 += w * sil[1024 + k]; a2 += w * sil[2048 + k]; }
#pragma unroll
                for (int j = 0; j < 2; ++j) { red[(wave * 3 + 0) * 128 + 2 * lane + j] = a0[j]; red[(wave * 3 + 1) * 128 + 2 * lane + j] = a1[j]; red[(wave * 3 + 2) * 128 + 2 * lane + j] = a2[j]; }
                __syncthreads();
                for (int i = tid; i < 384; i += NTHREADS) { const int src = i >> 7, ci = i & 127; float s = INP(5)[l * NMODW + jj + ci];
#pragma unroll
                    for (int w = 0; w < 8; ++w) s += red[(w * 3 + src) * 128 + ci];
                    modv[(l * 3 + src) * NMODW + jj + ci] = s; }
                __syncthreads();
            }
            CONVERT_WEIGHTS(0, (GAS bf16*)(ws + WS_W), gw, NGW);
            { const int gt = bx * NTHREADS + tid, NT_ = G * NTHREADS;
              const GAS f32x4* c4 = (const GAS f32x4*)INP(2); GAS f32x4* oc4 = (GAS f32x4*)xctx;
              for (int i = gt; i < MC * 1024 / 4; i += NT_) oc4[i] = c4[i];
              for (int i = gt; i < 8192 * 32; i += NT_) { const int t = i >> 5, ax = (i >> 4) & 1, f = i & 15; const float pos = (float)(ax ? (t & 63) : (t >> 6));
                  const float invf = powf(10000.0f, -(float)(2 * f) / 32.0f); const float ang = pos * invf; cosT[i] = cosf(ang); sinT[i] = sinf(ang); } }
        } else {
            const int s = (ph - 1) & 7;
            if (s == 0) { PTRS();
                NORM_ROWS((l == 0 ? INP(0) : (const GAS float*)xlat), INP(6) + l * 1024, modl, 0, 1, ((l > 0 && G == 256) ? ML : 0), MT);
            } else if (s == 1) { PTRS();
                pg8::Gemm g{(const pg8::bf16_t*)H, (const pg8::bf16_t*)(Wb + WO_IN), MT, INW, 1024}; pg8::StaticOrder S; S.init(MT, INW, G, bx);
                pg8::EpiInProj E{PCONV, Qb, Kb, Vb, PSG, PG, INP(8) + l * 64, INP(9) + l * 64, cosT, sinT};
                pg8::gemm_phase<pg8::EpiInProj, pg8::StaticOrder, true, true>(ldsl, g, S, E);
                if (!last) { const int nbusy = (MT / 256) * (INW / 256) - ((MT / 256) * (INW / 256) / G) * G;
                    if (G - nbusy >= G / 2) { if (bx >= nbusy) CONVERT_WEIGHTS(l + 1, Wn, (bx - nbusy) * NWAVES + wave, (G - nbusy) * NWAVES); } else CONVERT_WEIGHTS(l + 1, Wn, gw, NGW); }
            } else if (s == 2) { PTRS();
                for (int ra_ = 0; ra_ < DUP_ATT; ++ra_) {
                const int upb = (512 + G - 1) / G;
                float mq_ = __builtin_fabsf(INP(8)[l * 64 + lane]), mk_ = __builtin_fabsf(INP(9)[l * 64 + lane]);
#pragma unroll
                for (int o = 1; o < 64; o <<= 1) { mq_ = __builtin_fmaxf(mq_, __shfl_xor(mq_, o)); mk_ = __builtin_fmaxf(mk_, __shfl_xor(mk_, o)); }
                const bool nomax = __builtin_amdgcn_readfirstlane((int)(64.0f * attn_body::C2 * mq_ * mk_ < 48.0f)) != 0;
                for (int i = 0;; ++i) { long qrow0_, kvrow0_; int h_, nt_;
                    if (i < upb) { const int uid = vcu * upb + i; if (uid >= 512) continue;
                        const int bhk = uid >> 7, rem = uid & 127, hg = rem >> 5, qb = rem & 31, b = bhk >> 1; h_ = (bhk & 1) * 4 + hg; qrow0_ = (long)b * 8192 + qb * 256; kvrow0_ = (long)b * 8448; nt_ = 132; }
                    else { const int uid = vcu + (i - upb) * G; if (last || uid >= 16) break; const int b = uid >> 3; h_ = uid & 7; qrow0_ = (long)ML + b * 256; kvrow0_ = (long)b * 8448 + 8192; nt_ = 4; }
                    if (nomax) attn_body::attn_unit<8, true>(qrow0_, h_, kvrow0_, nt_, (const attn_body::bf16*)Qb, (const attn_body::bf16*)Kb, (const attn_body::bf16*)Vb, (attn_body::bf16*)(Zcat + 256), (char*)lds);
                    else attn_body::attn_unit<8, false>(qrow0_, h_, kvrow0_, nt_, (const attn_body::bf16*)Qb, (const attn_body::bf16*)Kb, (const attn_body::bf16*)Vb, (attn_body::bf16*)(Zcat + 256), (char*)lds); }
                }
                __syncthreads();
                for (int rs_ = 0; rs_ < DUP_SG; ++rs_) {
                { const GAS float* cw = INP(10) + l * 768 + 4 * lane; const f32x4 w0 = *(const GAS f32x4*)cw, w1 = *(const GAS f32x4*)(cw + 256), w2 = *(const GAS f32x4*)(cw + 512);
                  for (int r = gw; r < Mrows; r += NGW) { const bool latent = r < ML; const int pos = latent ? (r & 8191) : ((r - ML) & 255), len = latent ? 8192 : 256;
                      const GAS bf16* p = PCONV + (size_t)r * 512 + 4 * lane;
                      const v2u ab = *(const GAS v2u*)p, q0 = *(const GAS v2u*)(p + 256);
                      v2u qm = {0u, 0u}, qp = qm;
                      if (pos > 0) qm = *(const GAS v2u*)(p - 512 + 256);
                      if (pos < len - 1) qp = *(const GAS v2u*)(p + 512 + 256);
                      const f32x4 pm = {bflo(qm.x), bfhi(qm.x), bflo(qm.y), bfhi(qm.y)}, p0 = {bflo(q0.x), bfhi(q0.x), bflo(q0.y), bfhi(q0.y)}, pp = {bflo(qp.x), bfhi(qp.x), bflo(qp.y), bfhi(qp.y)};
                      const f32x4 av = {bflo(ab.x), bfhi(ab.x), bflo(ab.y), bfhi(ab.y)};
                      const f32x4 o = av * (w0 * pm + w1 * p0 + w2 * pp);
                      v2u w; w.x = pk2(o[0], o[1]); w.y = pk2(o[2], o[3]); *(GAS v2u*)(Zcat + (size_t)r * 1024 + 4 * lane) = w; } }
                { typedef short bf16x8_t __attribute__((ext_vector_type(8))); typedef float f32x16_t __attribute__((ext_vector_type(16)));
                  LAS unsigned short* VT = (LAS unsigned short*)ldsl;
                  const int nitems = (Mrows / 128) * 4;
                  for (int item = bx; item < nitems; item += G) { const int chunk = item >> 2, g = item & 3, rb = chunk * 128;
                      { const int sub = lane >> 4, li = lane & 15;
#pragma unroll
                        for (int i = 0; i < 4; ++i) { const int srow = 16 * wave + 4 * i + sub; const GAS bf16* sp = PSG + (size_t)(rb + srow) * 512 + 256 + 16 * li;
                            const v4u r0 = *(const GAS v4u*)sp, r1 = *(const GAS v4u*)(sp + 8);
                            const float fv[16] = {bflo(r0.x), bfhi(r0.x), bflo(r0.y), bfhi(r0.y), bflo(r0.z), bfhi(r0.z), bflo(r0.w), bfhi(r0.w), bflo(r1.x), bfhi(r1.x), bflo(r1.y), bfhi(r1.y), bflo(r1.z), bfhi(r1.z), bflo(r1.w), bfhi(r1.w)};
                            float ss = 0.f;
#pragma unroll
                            for (int j = 0; j < 16; ++j) ss += fv[j] * fv[j];
                            ss += __shfl_xor(ss, 1); ss += __shfl_xor(ss, 2); ss += __shfl_xor(ss, 4); ss += __shfl_xor(ss, 8);
                            const float rinv = 1.0f / sqrtf(ss * (1.0f / 256.0f) + 1e-6f);
                            if ((li >> 2) == g) { const int d0 = 16 * (li & 3); const GAS float* gp_ = INP(11) + l * 256 + g * 64 + d0;
#pragma unroll
                                for (int j4 = 0; j4 < 4; ++j4) { const f32x4 gn = *(const GAS f32x4*)(gp_ + 4 * j4);
#pragma unroll
                                    for (int j = 0; j < 4; ++j) VT[(d0 + 4 * j4 + j) * 136 + srow] = (unsigned short)f2bf(fv[4 * j4 + j] * rinv * gn[j]); } } } }
                      __syncthreads();
                      const int tm = wave >> 1, tn = wave & 1, r32 = lane & 31, hi = lane >> 5;
                      const GAS float* Wrow = INP(12) + (size_t)(l * 4 + g) * 128 * 128 + (size_t)(32 * tm + r32) * 128 + 8 * hi;
                      const LAS unsigned short* Vrow = VT + (32 * tn + r32) * 136 + 8 * hi;
                      f32x16_t acc; for (int r = 0; r < 16; ++r) acc[r] = 0.f;
#pragma unroll
                      for (int k0 = 0; k0 < 8; ++k0) { const f32x4 w0 = *(const GAS f32x4*)(Wrow + 16 * k0), w1 = *(const GAS f32x4*)(Wrow + 16 * k0 + 4);
                          const v4u wp = {pk2(w0[0], w0[1]), pk2(w0[2], w0[3]), pk2(w1[0], w1[1]), pk2(w1[2], w1[3])};
                          const bf16x8_t af = *(const LAS bf16x8_t*)(Vrow + 16 * k0);
                          acc = __builtin_amdgcn_mfma_f32_32x32x16_bf16(af, __builtin_bit_cast(bf16x8_t, wp), acc, 0, 0, 0); }
                      const int t = 32 * tm + r32; const float bias = INP(13)[(l * 4 + g) * 128 + t]; const size_t row = (size_t)(rb + t);
#pragma unroll
                      for (int q = 0; q < 4; ++q) { const int dcol = g * 64 + 32 * tn + 8 * q + 4 * hi;
                          const v2u uu = *(const GAS v2u*)(PSG + row * 512 + dcol);
                          v2u o; o.x = pk2(bflo(uu.x) * (acc[4 * q + 0] + bias), bfhi(uu.x) * (acc[4 * q + 1] + bias)); o.y = pk2(bflo(uu.y) * (acc[4 * q + 2] + bias), bfhi(uu.y) * (acc[4 * q + 3] + bias));
                          *(GAS v2u*)(Zcat + row * 1024 + 768 + dcol) = o; }
                      __syncthreads(); } }
                }
            } else if (s == 3) { PTRS();
                pg8::StaticOrder S; S.init(ML, 1024, G, bx);
                { pg8::Gemm g{(const pg8::bf16_t*)Zcat, (const pg8::bf16_t*)(Wb + WO_A), ML, 1024, 1024}; pg8::EpiMergeFused E{PG, Zb}; pg8::gemm_phase<pg8::EpiMergeFused, pg8::StaticOrder, true, true>(ldsl, g, S, E); }
                if (!last) CTX_MERGE();
            } else if (s == 4) { PTRS();
                pg8::Gemm g{(const pg8::bf16_t*)Zb, (const pg8::bf16_t*)(Wb + WO_O), ML, 1024, 1024}; pg8::StaticOrder S; S.init(ML, 1024, G, bx);
                if (G == 256) { pg8::EpiResidNorm E{(l == 0 ? INP(0) : (const GAS float*)xlat), xlat, modl, 2, H, INP(18) + l * 1024, modl, 3, 4, (unsigned*)(ws + WS_XBUF), (unsigned*)(ws + WS_XCNT), 32u * (unsigned)(2 * l + 1)};
                    pg8::gemm_phase<pg8::EpiResidNorm, pg8::StaticOrder, false, true>(ldsl, g, S, E); }
                else { pg8::EpiResid E{(l == 0 ? INP(0) : (const GAS float*)xlat), xlat, xctx, modl, 2}; pg8::gemm_phase<pg8::EpiResid, pg8::StaticOrder, true, true>(ldsl, g, S, E); }
                if (!last) { if (G == 256) CTX_RESID(Zb, 1024, WO_O, 2, 1, INP(18) + l * 1024, modl, 3, 4, 32u * (unsigned)(2 * l + 1)); else CTX_RESID(Zb, 1024, WO_O, 2, 0, INP(18), modl, 3, 4, 0u); }
            } else if (s == 5) { PTRS();
                NORM_ROWS((const GAS float*)xlat, INP(18) + l * 1024, modl, 3, 4, (G == 256 ? ML : 0), Mrows);
            } else if (s == 6) { PTRS();
                pg8::Gemm g{(const pg8::bf16_t*)H, (const pg8::bf16_t*)(Wb + WO_13), Mrows, 2 * DFF, 1024}; pg8::StaticOrder S; S.init(Mrows, 2 * DFF, G, bx);
                pg8::EpiSwiGLU E{HFF}; pg8::gemm_phase<pg8::EpiSwiGLU, pg8::StaticOrder, true, true>(ldsl, g, S, E);
            } else { PTRS();
                pg8::Gemm g{(const pg8::bf16_t*)HFF, (const pg8::bf16_t*)(Wb + WO_2), ML, 1024, DFF}; pg8::StaticOrder S; S.init(ML, 1024, G, bx);
                if (G == 256 && !last) { pg8::EpiResidNorm E{(const GAS float*)xlat, xlat, modl, 5, H, INP(6) + (l + 1) * 1024, modv + (size_t)(l + 1) * 3 * NMODW, 0, 1, (unsigned*)(ws + WS_XBUF), (unsigned*)(ws + WS_XCNT), 32u * (unsigned)(2 * l + 2)};
                    pg8::gemm_phase<pg8::EpiResidNorm, pg8::StaticOrder, false, true>(ldsl, g, S, E); }
                else { pg8::EpiResid E{(const GAS float*)xlat, xlat, xctx, modl, 5}; pg8::gemm_phase<pg8::EpiResid, pg8::StaticOrder, true, true>(ldsl, g, S, E); }
                if (!last) { if (G == 256) CTX_RESID(HFF, DFF, WO_2, 5, 1, INP(6) + (l + 1) * 1024, modv + (size_t)(l + 1) * 3 * NMODW, 0, 1, 32u * (unsigned)(2 * l + 2)); else CTX_RESID(HFF, DFF, WO_2, 5, 0, INP(6), modl, 0, 1, 0u); }
            }
        }
      }
        if ((it_ & 1) && ph + 1 < a.ph_hi) { if (a.ph_hi > NPHASE) { asm volatile("s_waitcnt vmcnt(0)" ::: "memory"); cg::this_grid().sync(); } xcd_barrier(bar); if (DUP_S == 9) xcd_barrier(bar); }
        if (TIME_S >= 0 && (((TIME_MASK) >> (ph == 0 ? 8 : ((ph - 1) & 7))) & 1)) tacc_ += __builtin_amdgcn_s_memrealtime() - tph_;
    }
    if (TIME_S >= 0 && blockIdx.x == 0) { const unsigned long long te_ = __builtin_amdgcn_s_memrealtime() + tacc_; while (__builtin_amdgcn_s_memrealtime() < te_) __builtin_amdgcn_s_sleep(8); }
}

extern "C" void kernel_launch(void* const* d_in, const int* in_sizes, int n_in, void* d_out, int out_size, void* d_ws, size_t ws_size, hipStream_t stream) {
    static int grid = 0;
    if (grid == 0) {
        if (n_in != 22 || ws_size < WS_END) { fprintf(stderr, "kernel_launch: unexpected n_in %d / ws %zu (need %zu)\n", n_in, ws_size, (size_t)WS_END); grid = -1; return; }
        int dev = 0, cus = 0, per_cu = 0;
        (void)hipGetDevice(&dev); (void)hipDeviceGetAttribute(&cus, hipDeviceAttributeMultiprocessorCount, dev);
        if (hipFuncSetAttribute((const void*)fwd_kernel, hipFuncAttributeMaxDynamicSharedMemorySize, LDS_BYTES) != hipSuccess) { fprintf(stderr, "kernel_launch: hipFuncSetAttribute failed\n"); grid = -1; return; }
        if (hipOccupancyMaxActiveBlocksPerMultiprocessor(&per_cu, (const void*)fwd_kernel, NTHREADS, LDS_BYTES) != hipSuccess || per_cu < 1) { (void)hipGetLastError(); per_cu = 1; }
        grid = cus * per_cu; if (grid <= 0) grid = 256;
    }
    if (grid < 0) return;
    (void)hipMemsetAsync((char*)d_ws + WS_BAR, 0, BAR_BYTES, stream);
    Args a{};
    for (int i = 0; i < 22; ++i) a.in[i] = (const float*)d_in[i];
    a.out = (float*)d_out; a.ws = (unsigned char*)d_ws;
#if MK_MULTI
    for (int ph = 0; ph < NPHASE; ++ph) { a.ph_lo = ph; a.ph_hi = ph + 1; hipLaunchKernelGGL(fwd_kernel, dim3(grid), dim3(NTHREADS), LDS_BYTES, stream, a); }
#else
    a.ph_lo = 0; a.ph_hi = NPHASE;
    void* args[] = {&a};
    hipError_t e = hipLaunchCooperativeKernel((const void*)fwd_kernel, dim3(grid), dim3(NTHREADS), args, LDS_BYTES, stream);
    if (e != hipSuccess) fprintf(stderr, "cooperative launch failed: %s (grid %d)\n", hipGetErrorString(e), grid);
#endif
}
```
